# Optimizing an MI355X kernel written in HIP

```python
import math
import jax
import jax.numpy as jnp
from jax import lax
import numpy as np

D_MODEL = 1024
BATCH = 4
SEQ = 4096
DEPTH = 4

GRID_W = 64
CTX_LEN = 256
EPS = 1e-6
ROPE_BASE = 10000.0
QBLK = 128

A_HEADS = 4
A_KV_HEADS = 2
A_HEAD_DIM = 64
A_WINDOW = 128
B_D_INNER = 512
B_HEADDIM = 64
B_HEADS = B_D_INNER // B_HEADDIM
B_GROUPS = 2
B_STATE = 64
B_CONV = 5
B_CHUNK = 128
C_HEADS = 4
C_QK_DIM = 32
C_V_DIM = 64

A_WIDTH = A_HEADS * A_HEAD_DIM
C_WIDTH = C_HEADS * C_V_DIM
MIX_WIDTH = A_WIDTH + B_D_INNER + C_WIDTH

A_Q = A_HEADS * A_HEAD_DIM
A_KV = A_KV_HEADS * A_HEAD_DIM
B_XBC = B_D_INNER + 2 * B_GROUPS * B_STATE
B_DT = 2 * B_HEADS
C_QK = C_HEADS * 2 * C_QK_DIM
OFF_AK = A_Q
OFF_AV = OFF_AK + A_KV
OFF_BZ = OFF_AV + A_KV
OFF_BX = OFF_BZ + B_D_INNER
OFF_BDT = OFF_BX + B_XBC
OFF_CQ = OFF_BDT + B_DT
OFF_CK = OFF_CQ + C_QK
OFF_CV = OFF_CK + C_QK
IN_COLS = OFF_CV + C_WIDTH
IN_SPLITS = (OFF_AK, OFF_AV, OFF_BZ, OFF_BX, OFF_BDT, OFF_CQ, OFF_CK, OFF_CV)

N_GROUPS = 4
EXPERTS_PER_GROUP = 8
N_EXPERTS = N_GROUPS * EXPERTS_PER_GROUP
TOP_K = 2
D_EXPERT = 512
MOE_BLK = 256

kernel_name = 'hybrid_flow_backbone'

F32 = jnp.float32


def rmsnorm(x, w):
    xf = x.astype(F32)
    y = xf * lax.rsqrt(jnp.mean(xf * xf, axis=-1, keepdims=True) + EPS)
    return (y * w.astype(F32)).astype(x.dtype)


def modulate(h, shift, scale):
    return h * (1 + scale) + shift


def axial_rope(x, row_pos, col_pos):
    dim = x.shape[-1]
    half = dim // 2
    nf = half // 2
    freqs = ROPE_BASE ** (-jnp.arange(nf, dtype=F32) / nf)

    def rot(u, pos):
        ang = pos.astype(F32)[:, None] * freqs
        cos = jnp.cos(ang)[None, :, None, :].astype(u.dtype)
        sin = jnp.sin(ang)[None, :, None, :].astype(u.dtype)
        u1, u2 = u[..., :nf], u[..., nf:]
        return jnp.concatenate([u1 * cos - u2 * sin, u1 * sin + u2 * cos], axis=-1)

    return jnp.concatenate([rot(x[..., :half], row_pos), rot(x[..., half:], col_pos)], axis=-1)


def window_attention_sink(q, k, v, k_ctx, v_ctx, sink):
    Bsz, L, H, d = q.shape
    G = H // A_KV_HEADS
    nb = L // QBLK
    Lc = k_ctx.shape[1]
    qb = q.reshape(Bsz, nb, QBLK, A_KV_HEADS, G, d)

    def band(u):
        up = jnp.pad(u, ((0, 0), (QBLK, QBLK), (0, 0), (0, 0))).reshape(Bsz, nb + 2, QBLK, A_KV_HEADS, d)
        return jnp.concatenate([up[:, :-2], up[:, 1:-1], up[:, 2:]], axis=2)

    kb, vb = band(k), band(v)
    scale = d ** -0.5
    s_loc = jnp.einsum('bnqhgd,bnkhd->bnhgqk', qb, kb).astype(F32) * scale
    s_ctx = jnp.einsum('bnqhgd,bkhd->bnhgqk', qb, k_ctx).astype(F32) * scale
    blk = jnp.arange(nb)[:, None, None]
    qpos = blk * QBLK + jnp.arange(QBLK)[None, :, None]
    kpos = (blk - 1) * QBLK + jnp.arange(3 * QBLK)[None, None, :]
    mask = (jnp.abs(kpos - qpos) <= A_WINDOW) & (kpos >= 0) & (kpos < L)
    s_loc = jnp.where(mask[None, :, None, None], s_loc, -jnp.inf)
    s_sink = jnp.broadcast_to(sink.astype(F32).reshape(1, 1, A_KV_HEADS, G, 1, 1), s_loc.shape[:-1] + (1,))
    p = jax.nn.softmax(jnp.concatenate([s_loc, s_ctx, s_sink], axis=-1), axis=-1).astype(v.dtype)
    nk = 3 * QBLK
    out = (jnp.einsum('bnhgqk,bnkhd->bnqhgd', p[..., :nk], vb)
           + jnp.einsum('bnhgqk,bkhd->bnqhgd', p[..., nk:nk + Lc], v_ctx))
    return out.reshape(Bsz, L, H * d)


def ctx_attention_sink(q, k, v, sink):
    Bsz, Lq, H, d = q.shape
    G = H // A_KV_HEADS
    qg = q.reshape(Bsz, Lq, A_KV_HEADS, G, d)
    s = jnp.einsum('bqhgd,bkhd->bhgqk', qg, k).astype(F32) * d ** -0.5
    s_sink = jnp.broadcast_to(sink.astype(F32).reshape(1, A_KV_HEADS, G, 1, 1), s.shape[:-1] + (1,))
    p = jax.nn.softmax(jnp.concatenate([s, s_sink], axis=-1), axis=-1)[..., :-1].astype(v.dtype)
    return jnp.einsum('bhgqk,bkhd->bqhgd', p, v).reshape(Bsz, Lq, H * d)


def depthwise_conv_centred(u, w, b):
    out = lax.conv_general_dilated(u, w[:, None, :].astype(u.dtype), window_strides=(1,),
                                   padding=[(B_CONV // 2, B_CONV // 2)],
                                   dimension_numbers=('NWC', 'WIO', 'NWC'),
                                   feature_group_count=u.shape[-1])
    return out + b.astype(u.dtype)


def ssd_chunked(x, dt, a, bm, cm, h0, want_y):
    Bsz, L, H, P = x.shape
    nc = L // B_CHUNK
    rep = H // B_GROUPS
    bh = jnp.repeat(bm, rep, axis=2).astype(F32).reshape(Bsz, nc, B_CHUNK, H, B_STATE)
    xdt = (x.astype(F32) * dt[..., None]).reshape(Bsz, nc, B_CHUNK, H, P)
    a_cum = jnp.cumsum((dt * a).reshape(Bsz, nc, B_CHUNK, H), axis=2)
    a_end = a_cum[:, :, -1]
    states = jnp.einsum('bclhn,bclh,bclhp->bchpn', bh, jnp.exp(a_end[:, :, None] - a_cum), xdt)

    def step(h, inp):
        dec, st = inp
        return dec[..., None, None] * h + st, h

    h_final, h_start = lax.scan(step, h0, (jnp.moveaxis(jnp.exp(a_end), 1, 0), jnp.moveaxis(states, 1, 0)))
    if not want_y:
        return None, h_final
    h_start = jnp.moveaxis(h_start, 0, 1)
    ch = jnp.repeat(cm, rep, axis=2).astype(F32).reshape(Bsz, nc, B_CHUNK, H, B_STATE)
    tri = jnp.tril(jnp.ones((B_CHUNK, B_CHUNK), bool))[None, None, :, :, None]
    seg = a_cum[:, :, :, None, :] - a_cum[:, :, None, :, :]
    decay = jnp.where(tri, jnp.exp(jnp.where(tri, seg, 0.0)), 0.0)
    scores = jnp.einsum('bclhn,bcshn->bclsh', ch, bh) * decay
    y_diag = jnp.einsum('bclsh,bcshp->bclhp', scores, xdt)
    y_off = jnp.einsum('bclhn,bchpn,bclh->bclhp', ch, h_start, jnp.exp(a_cum))
    return (y_diag + y_off).reshape(Bsz, L, H, P), h_final


def ssd_bidirectional(z, xbc, dt_raw, z_ctx, xbc_ctx, dt_raw_ctx, conv_w, conv_b, dt_bias, a_log,
                      d_skip, norm_w, need_ctx):
    a = -jnp.exp(a_log.astype(F32))

    def prep(xbc_, dt_raw_):
        Bsz, L, _ = xbc_.shape
        u = jax.nn.silu(depthwise_conv_centred(xbc_, conv_w, conv_b))
        xs, bm, cm = jnp.split(u, [B_D_INNER, B_D_INNER + B_GROUPS * B_STATE], axis=-1)
        xs = xs.reshape(Bsz, L, B_HEADS, B_HEADDIM)
        bm = bm.reshape(Bsz, L, B_GROUPS, B_STATE)
        cm = cm.reshape(Bsz, L, B_GROUPS, B_STATE)
        dt = jax.nn.softplus(dt_raw_.astype(F32).reshape(Bsz, L, 2, B_HEADS) + dt_bias.astype(F32))
        return xs, bm, cm, dt

    def scan_dir(xs, bm, cm, dt, dirn, h0, want_y):
        dt_d = dt[:, :, dirn]
        if dirn == 1:
            xs, bm, cm, dt_d = (jnp.flip(xs, 1), jnp.flip(bm, 1), jnp.flip(cm, 1), jnp.flip(dt_d, 1))
        y, h_t = ssd_chunked(xs, dt_d, a[dirn], bm, cm, h0, want_y)
        if dirn == 1 and y is not None:
            y = jnp.flip(y, 1)
        return y, h_t

    def finish(y_f, y_b, xs, z_):
        Bsz, L = xs.shape[:2]
        y = y_f + y_b + xs.astype(F32) * (d_skip[0] + d_skip[1]).astype(F32)[:, None]
        g = y.reshape(Bsz, L, B_D_INNER) * jax.nn.silu(z_.astype(F32))
        g = g.reshape(Bsz, L, B_GROUPS, B_D_INNER // B_GROUPS)
        g = g * lax.rsqrt(jnp.mean(g * g, axis=-1, keepdims=True) + EPS)
        return (g.reshape(Bsz, L, B_D_INNER) * norm_w.astype(F32)).astype(z_.dtype)

    xs_c, bm_c, cm_c, dt_c = prep(xbc_ctx, dt_raw_ctx)
    h0 = jnp.zeros((xs_c.shape[0], B_HEADS, B_HEADDIM, B_STATE), F32)
    yc_f, hc_f = scan_dir(xs_c, bm_c, cm_c, dt_c, 0, h0, need_ctx)
    yc_b, hc_b = scan_dir(xs_c, bm_c, cm_c, dt_c, 1, h0, need_ctx)
    xs, bm, cm, dt = prep(xbc, dt_raw)
    y_f, _ = scan_dir(xs, bm, cm, dt, 0, hc_f, True)
    y_b, _ = scan_dir(xs, bm, cm, dt, 1, hc_b, True)
    out = finish(y_f, y_b, xs, z)
    out_ctx = finish(yc_f, yc_b, xs_c, z_ctx) if need_ctx else None
    return out, out_ctx


def diff_attend(q, k, v, lam):
    s = jnp.einsum('bqhmd,bkhmd->bhmqk', q, k).astype(F32) * q.shape[-1] ** -0.5
    p = jax.nn.softmax(s, axis=-1)
    w = (p[:, :, 0] - lam * p[:, :, 1]).astype(v.dtype)
    return jnp.einsum('bhqk,bkhd->bqhd', w, v)


def diff_attention_latent(q, k, v, k_ctx, v_ctx, lam):
    Bsz, L = q.shape[:2]
    nb = L // QBLK
    k_all = jnp.concatenate([k, k_ctx], axis=1)
    v_all = jnp.concatenate([v, v_ctx], axis=1)
    qb = jnp.moveaxis(q.reshape(Bsz, nb, QBLK, C_HEADS, 2, C_QK_DIM), 1, 0)
    out = lax.map(lambda qblk: diff_attend(qblk, k_all, v_all, lam), qb)
    return jnp.moveaxis(out, 0, 1).reshape(Bsz, L, C_HEADS, C_V_DIM)


def diff_post(o, subln_w, lambda_init):
    return (rmsnorm(o, subln_w) * (1.0 - lambda_init)).reshape(o.shape[0], o.shape[1], C_WIDTH)


def token_mixing(h, h_ctx, w_in, w_out, a_sink, conv_w, conv_b, dt_bias, a_log, d_skip, b_norm_w,
                 c_lambda, c_subln_w, lambda_init, row_pos, col_pos, need_ctx):
    Bsz, L, _ = h.shape
    Lc = h_ctx.shape[1]
    aq, ak, av, bz, bx, bdt, cq, ck, cv = jnp.split(jnp.dot(h, w_in), IN_SPLITS, axis=-1)
    aq_c, ak_c, av_c, bz_c, bx_c, bdt_c, cq_c, ck_c, cv_c = jnp.split(jnp.dot(h_ctx, w_in), IN_SPLITS, axis=-1)
    q = axial_rope(aq.reshape(Bsz, L, A_HEADS, A_HEAD_DIM), row_pos, col_pos)
    k = axial_rope(ak.reshape(Bsz, L, A_KV_HEADS, A_HEAD_DIM), row_pos, col_pos)
    v = av.reshape(Bsz, L, A_KV_HEADS, A_HEAD_DIM)
    k_c = ak_c.reshape(Bsz, Lc, A_KV_HEADS, A_HEAD_DIM)
    v_c = av_c.reshape(Bsz, Lc, A_KV_HEADS, A_HEAD_DIM)
    out_a = window_attention_sink(q, k, v, k_c, v_c, a_sink)
    out_b, out_b_c = ssd_bidirectional(bz, bx, bdt, bz_c, bx_c, bdt_c, conv_w, conv_b, dt_bias, a_log,
                                       d_skip, b_norm_w, need_ctx)
    lq1, lk1, lq2, lk2 = c_lambda.astype(F32)
    lam = jnp.exp(jnp.sum(lq1 * lk1)) - jnp.exp(jnp.sum(lq2 * lk2)) + lambda_init
    qd = axial_rope(cq.reshape(Bsz, L, 2 * C_HEADS, C_QK_DIM), row_pos, col_pos).reshape(Bsz, L, C_HEADS, 2, C_QK_DIM)
    kd = axial_rope(ck.reshape(Bsz, L, 2 * C_HEADS, C_QK_DIM), row_pos, col_pos).reshape(Bsz, L, C_HEADS, 2, C_QK_DIM)
    vd = cv.reshape(Bsz, L, C_HEADS, C_V_DIM)
    kd_c = ck_c.reshape(Bsz, Lc, C_HEADS, 2, C_QK_DIM)
    vd_c = cv_c.reshape(Bsz, Lc, C_HEADS, C_V_DIM)
    out_c = diff_post(diff_attention_latent(qd, kd, vd, kd_c, vd_c, lam), c_subln_w, lambda_init)
    out = jnp.dot(jnp.concatenate([out_a, out_b, out_c], axis=-1), w_out)
    if not need_ctx:
        return out, None
    out_a_c = ctx_attention_sink(aq_c.reshape(Bsz, Lc, A_HEADS, A_HEAD_DIM), k_c, v_c, a_sink)
    qd_c = cq_c.reshape(Bsz, Lc, C_HEADS, 2, C_QK_DIM)
    out_c_c = diff_post(diff_attend(qd_c, kd_c, vd_c, lam), c_subln_w, lambda_init)
    out_ctx = jnp.dot(jnp.concatenate([out_a_c, out_b_c, out_c_c], axis=-1), w_out)
    return out, out_ctx


def grouped_expert_mlp(t, e_idx, gate, w_gate, w_up, w_down):
    N, D = t.shape
    A = N * TOP_K
    flat_e = e_idx.reshape(-1)
    order = jnp.argsort(flat_e)
    sorted_e = flat_e[order]
    counts = jnp.bincount(flat_e, length=N_EXPERTS)
    padded = (counts + MOE_BLK - 1) // MOE_BLK * MOE_BLK
    pad_end = jnp.cumsum(padded)
    pad_start = pad_end - padded
    start = jnp.cumsum(counts) - counts
    dest = pad_start[sorted_e] + jnp.arange(A) - start[sorted_e]
    n_blocks = -(-A // MOE_BLK) + N_EXPERTS
    tok = order // TOP_K
    buf = jnp.zeros((n_blocks * MOE_BLK, D), t.dtype).at[dest].set(t[tok])
    block_e = jnp.minimum(jnp.searchsorted(pad_end, jnp.arange(n_blocks) * MOE_BLK, side='right'), N_EXPERTS - 1)

    def run(args):
        xb, e = args
        hid = jax.nn.silu(jnp.dot(xb, w_gate[e])) * jnp.dot(xb, w_up[e])
        return jnp.dot(hid, w_down[e])

    out = lax.map(run, (buf.reshape(n_blocks, MOE_BLK, D), block_e)).reshape(-1, D)
    w_sorted = gate.reshape(-1)[order].astype(t.dtype)
    return jnp.zeros_like(t).at[tok].add(out[dest] * w_sorted[:, None])


def hier_moe(t, w_group_router, w_router, w_gate, w_up, w_down):
    N = t.shape[0]
    g_prob = jax.nn.softmax(jnp.dot(t, w_group_router).astype(F32), axis=-1)
    g_p, g_sel = lax.top_k(g_prob, 1)
    e_logits = jnp.dot(t, w_router).astype(F32).reshape(N, N_GROUPS, EXPERTS_PER_GROUP)
    in_grp = jnp.take_along_axis(e_logits, g_sel[:, :, None], axis=1)[:, 0]
    e_val, e_loc = lax.top_k(in_grp, TOP_K)
    gate = g_p * jax.nn.softmax(e_val, axis=-1)
    e_idx = g_sel * EXPERTS_PER_GROUP + e_loc
    return grouped_expert_mlp(t, e_idx, gate, w_gate, w_up, w_down)


def setup_inputs(seed: int = 0) -> dict:
    key = jax.random.key(seed)
    ks = jax.random.split(key, 26)

    def nrm(k, shape, scale):
        return jax.random.normal(k, shape, F32) * scale

    dt0 = jnp.exp(jax.random.uniform(ks[12], (DEPTH, 2, B_HEADS), F32, math.log(1e-3), math.log(1e-1)))
    return {
        'x': nrm(ks[0], (BATCH, SEQ, D_MODEL), 1.0),
        'c': nrm(ks[1], (BATCH, D_MODEL), 1.0),
        'ctx': nrm(ks[2], (BATCH, CTX_LEN, D_MODEL), 1.0),
        'c_ctx': nrm(ks[3], (D_MODEL,), 1.0),
        'w_mod': nrm(ks[4], (DEPTH, D_MODEL, 6 * D_MODEL), 0.3 * D_MODEL ** -0.5),
        'b_mod': nrm(ks[5], (DEPTH, 6 * D_MODEL), 0.01),
        'norm1_w': 1.0 + nrm(ks[6], (DEPTH, D_MODEL), 0.02),
        'norm2_w': 1.0 + nrm(ks[7], (DEPTH, D_MODEL), 0.02),
        'w_in': nrm(ks[8], (DEPTH, D_MODEL, IN_COLS), D_MODEL ** -0.5),
        'w_out': nrm(ks[9], (DEPTH, MIX_WIDTH, D_MODEL), MIX_WIDTH ** -0.5),
        'a_sink': nrm(ks[10], (DEPTH, A_HEADS), 0.5),
        'b_conv_w': nrm(ks[11], (DEPTH, B_CONV, B_XBC), B_CONV ** -0.5),
        'b_conv_b': nrm(ks[13], (DEPTH, B_XBC), 0.01),
        'b_dt_bias': dt0 + jnp.log(-jnp.expm1(-dt0)),
        'b_a_log': jnp.log(jax.random.uniform(ks[14], (DEPTH, 2, B_HEADS), F32, 1.0, 16.0)),
        'b_d': 0.5 + nrm(ks[15], (DEPTH, 2, B_HEADS), 0.1),
        'b_norm_w': 1.0 + nrm(ks[16], (DEPTH, B_D_INNER), 0.02),
        'c_lambda': nrm(ks[17], (DEPTH, 4, C_QK_DIM), 0.1),
        'c_subln_w': 1.0 + nrm(ks[18], (DEPTH, C_V_DIM), 0.02),
        'moe_group_router': nrm(ks[19], (DEPTH, D_MODEL, N_GROUPS), D_MODEL ** -0.5),
        'moe_router': nrm(ks[20], (DEPTH, D_MODEL, N_EXPERTS), D_MODEL ** -0.5),
        'moe_w_gate': nrm(ks[21], (DEPTH, N_EXPERTS, D_MODEL, D_EXPERT), D_MODEL ** -0.5),
        'moe_w_up': nrm(ks[22], (DEPTH, N_EXPERTS, D_MODEL, D_EXPERT), D_MODEL ** -0.5),
        'moe_w_down': nrm(ks[23], (DEPTH, N_EXPERTS, D_EXPERT, D_MODEL), D_EXPERT ** -0.5),
        'final_norm_w': 1.0 + nrm(ks[24], (D_MODEL,), 0.02),
    }


def reference(x, c, ctx, c_ctx, w_mod, b_mod, norm1_w, norm2_w, w_in, w_out, a_sink, b_conv_w, b_conv_b,
              b_dt_bias, b_a_log, b_d, b_norm_w, c_lambda, c_subln_w, moe_group_router, moe_router,
              moe_w_gate, moe_w_up, moe_w_down, final_norm_w):
    Bsz, L, D = x.shape
    rows = L // GRID_W
    row_pos = jnp.repeat(jnp.arange(rows, dtype=jnp.int32), GRID_W)
    col_pos = jnp.tile(jnp.arange(GRID_W, dtype=jnp.int32), rows)
    x_ctx = ctx
    for l in range(DEPTH):
        last = l == DEPTH - 1
        mod = jnp.dot(jax.nn.silu(c), w_mod[l]) + b_mod[l]
        mod_ctx = jnp.dot(jax.nn.silu(c_ctx), w_mod[l]) + b_mod[l]
        sh1, sc1, g1, sh2, sc2, g2 = jnp.split(mod[:, None, :], 6, axis=-1)
        sh1c, sc1c, g1c, sh2c, sc2c, g2c = jnp.split(mod_ctx, 6, axis=-1)
        h = modulate(rmsnorm(x, norm1_w[l]), sh1, sc1)
        h_ctx = modulate(rmsnorm(x_ctx, norm1_w[l]), sh1c, sc1c)
        lambda_init = 0.8 - 0.6 * math.exp(-0.3 * l)
        mix, mix_ctx = token_mixing(h, h_ctx, w_in[l], w_out[l], a_sink[l], b_conv_w[l], b_conv_b[l],
                                    b_dt_bias[l], b_a_log[l], b_d[l], b_norm_w[l], c_lambda[l], c_subln_w[l],
                                    lambda_init, row_pos, col_pos, not last)
        x = x + g1 * mix
        h2 = modulate(rmsnorm(x, norm2_w[l]), sh2, sc2).reshape(-1, D)
        if last:
            y = hier_moe(h2, moe_group_router[l], moe_router[l], moe_w_gate[l], moe_w_up[l], moe_w_down[l])
            x = x + g2 * y.reshape(Bsz, L, D)
        else:
            x_ctx = x_ctx + g1c * mix_ctx
            h2c = modulate(rmsnorm(x_ctx, norm2_w[l]), sh2c, sc2c).reshape(-1, D)
            y = hier_moe(jnp.concatenate([h2, h2c], axis=0), moe_group_router[l], moe_router[l],
                         moe_w_gate[l], moe_w_up[l], moe_w_down[l])
            x = x + g2 * y[:Bsz * L].reshape(Bsz, L, D)
            x_ctx = x_ctx + g2c * y[Bsz * L:].reshape(Bsz, -1, D)
    return rmsnorm(x, final_norm_w)
```

```cpp
#include <hip/hip_runtime.h>
#include <cstdio>
#include <cstdint>

typedef unsigned short bf16_t;
typedef short bf16x8 __attribute__((ext_vector_type(8)));
typedef float f32x4 __attribute__((ext_vector_type(4)));
typedef unsigned u32x4 __attribute__((ext_vector_type(4)));

constexpr int D = 1024, NB = 4, L = 4096, LC = 256, NLAT = NB * L, NCTX = NB * LC, NTOK = NLAT + NCTX, DEPTH = 4;
constexpr int IN_COLS = 2576, OLD_BDT = 1792;
constexpr int PC = 2560;
constexpr int P_AQ = 0, P_AK = 256, P_AV = 384, P_BZ = 512, P_BX = 1024, P_CQ = 1792, P_CK = 2048, P_CV = 2304;
constexpr int NEXP = 32, DEXP = 512;
constexpr float EPS = 1e-6f;

__device__ __forceinline__ bf16_t f2bf(float f) { unsigned u = __float_as_uint(f); u += 0x7fffu + ((u >> 16) & 1u); return (bf16_t)(u >> 16); }
__device__ __forceinline__ float bf2f(bf16_t h) { return __uint_as_float(((unsigned)h) << 16); }
__device__ __forceinline__ float wave_sum(float v) {
#pragma unroll
    for (int o = 32; o > 0; o >>= 1) v += __shfl_xor(v, o);
    return v;
}
__device__ __forceinline__ float siluf(float v) { return v / (1.f + __expf(-v)); }
__device__ __forceinline__ int tok_modrow(int tok) { return tok < NLAT ? tok / L : NB; }

struct P {
    const float *x, *c, *ctx, *c_ctx, *w_mod, *b_mod, *norm1_w, *norm2_w, *w_in, *w_out, *a_sink, *conv_w, *conv_b, *dt_bias, *a_log, *d_skip,
        *b_norm_w, *c_lambda, *c_subln_w, *w_grouter, *w_router, *w_gate, *w_up, *w_down, *final_w;
    float* out;
    float* X; float* MOD; float* DT; float* XBC; float* Y; float* gatew;
    bf16_t *H, *PROJ, *WT_IN, *WT_OUT, *WT_G, *WT_U, *WT_D, *MIXO, *HID, *YS;
    int *cnt, *list, *pos;
};

__global__ void __launch_bounds__(256) k_convT(const float* __restrict__ src, bf16_t* __restrict__ dst, int K, int ld_src, int c0, int ncols, int n_dst0,
                                               long src_bstride, long dst_bstride) {
    __shared__ float t[32][33];
    src += (long)blockIdx.z * src_bstride; dst += (long)blockIdx.z * dst_bstride;
    const int kb = blockIdx.y * 32, nb = blockIdx.x * 32, tx = threadIdx.x & 31, ty = threadIdx.x >> 5;
    for (int i = ty; i < 32; i += 8) { const int k = kb + i, n = nb + tx; t[i][tx] = (n < ncols) ? src[(long)k * ld_src + c0 + n] : 0.f; }
    __syncthreads();
    for (int i = ty; i < 32; i += 8) { const int n = nb + i, k = kb + tx; if (n < ncols) dst[(long)(n_dst0 + n) * K + k] = f2bf(t[tx][i]); }
}

__global__ void __launch_bounds__(256) k_mod(P p) {
    const int idx = blockIdx.x * 256 + threadIdx.x;
    if (idx >= DEPTH * 6 * D) return;
    const int l = idx / (6 * D), n = idx % (6 * D);
    float acc[5] = {0.f, 0.f, 0.f, 0.f, 0.f};
    const float* w = p.w_mod + (long)l * D * 6 * D + n;
    for (int k = 0; k < D; ++k) {
        const float wv = w[(long)k * 6 * D];
#pragma unroll
        for (int r = 0; r < 5; ++r) { const float cv = (r < 4) ? p.c[r * D + k] : p.c_ctx[k]; acc[r] += siluf(cv) * wv; }
    }
    const float bv = p.b_mod[l * 6 * D + n];
#pragma unroll
    for (int r = 0; r < 5; ++r) p.MOD[((long)l * 5 + r) * 6 * D + n] = acc[r] + bv;
}

__global__ void __launch_bounds__(256) k_norm1(P p, int l) {
    const int wave = threadIdx.x >> 6, lane = threadIdx.x & 63;
    const int tok = blockIdx.x * 4 + wave;
    if (tok >= NTOK) return;
    float v[16];
    const float* src = (l == 0) ? (tok < NLAT ? p.x + (long)tok * D : p.ctx + (long)(tok - NLAT) * D) : p.X + (long)tok * D;
#pragma unroll
    for (int i = 0; i < 4; ++i) { const float4 t = *(const float4*)(src + i * 256 + lane * 4); v[i * 4 + 0] = t.x; v[i * 4 + 1] = t.y; v[i * 4 + 2] = t.z; v[i * 4 + 3] = t.w; }
    if (l > 0) {
#pragma unroll
        for (int k = 0; k < 2; ++k) {
            const int slot = p.pos[tok * 2 + k];
            const bf16_t* ys = p.YS + (long)slot * D;
#pragma unroll
            for (int i = 0; i < 4; ++i) { const uint2 t = *(const uint2*)(ys + i * 256 + lane * 4);
                v[i * 4 + 0] += bf2f((bf16_t)(t.x & 0xffff)); v[i * 4 + 1] += bf2f((bf16_t)(t.x >> 16)); v[i * 4 + 2] += bf2f((bf16_t)(t.y & 0xffff)); v[i * 4 + 3] += bf2f((bf16_t)(t.y >> 16)); }
        }
    }
    float* xo = p.X + (long)tok * D;
#pragma unroll
    for (int i = 0; i < 4; ++i) *(float4*)(xo + i * 256 + lane * 4) = make_float4(v[i * 4 + 0], v[i * 4 + 1], v[i * 4 + 2], v[i * 4 + 3]);
    float ss = 0.f;
#pragma unroll
    for (int i = 0; i < 16; ++i) ss += v[i] * v[i];
    ss = wave_sum(ss);
    const float r = rsqrtf(ss * (1.f / D) + EPS);
    const float* m = p.MOD + ((long)l * 5 + tok_modrow(tok)) * 6 * D;
    const float* nw = p.norm1_w + l * D;
    float dacc[16];
#pragma unroll
    for (int j = 0; j < 16; ++j) dacc[j] = 0.f;
    bf16_t* ho = p.H + (long)tok * D;
#pragma unroll
    for (int i = 0; i < 4; ++i) {
        float h[4];
#pragma unroll
        for (int e = 0; e < 4; ++e) { const int k = i * 256 + lane * 4 + e; h[e] = v[i * 4 + e] * r * nw[k] * (1.f + m[D + k]) + m[k]; }
        uint2 o; o.x = (unsigned)f2bf(h[0]) | ((unsigned)f2bf(h[1]) << 16); o.y = (unsigned)f2bf(h[2]) | ((unsigned)f2bf(h[3]) << 16);
        *(uint2*)(ho + i * 256 + lane * 4) = o;
#pragma unroll
        for (int e = 0; e < 4; ++e) { const int k = i * 256 + lane * 4 + e; const float* wr = p.w_in + ((long)l * D + k) * IN_COLS + OLD_BDT;
#pragma unroll
            for (int j4 = 0; j4 < 4; ++j4) { const float4 w4 = *(const float4*)(wr + j4 * 4);
                dacc[j4 * 4 + 0] += h[e] * w4.x; dacc[j4 * 4 + 1] += h[e] * w4.y; dacc[j4 * 4 + 2] += h[e] * w4.z; dacc[j4 * 4 + 3] += h[e] * w4.w; } }
    }
#pragma unroll
    for (int j = 0; j < 16; ++j) { const float s = wave_sum(dacc[j]); if (lane == j) p.DT[tok * 16 + j] = s; }
}

constexpr int LDS_STRIDE = 72;
constexpr int GEMM_LDS_BYTES = 2 * 128 * LDS_STRIDE * 2;
template <class RowA, class RowB, class Epi>
__device__ __forceinline__ void gemm_tile(const RowA& ra, const RowB& rb, int K, bf16_t* As, bf16_t* Bs, const Epi& epi) {
    const int tid = threadIdx.x, lane = tid & 63, w = tid >> 6, wm = w >> 1, wn = w & 1, lr = lane & 15, lq = lane >> 4;
    f32x4 acc[4][4];
#pragma unroll
    for (int i = 0; i < 4; ++i)
#pragma unroll
        for (int j = 0; j < 4; ++j) acc[i][j] = (f32x4){0.f, 0.f, 0.f, 0.f};
    const bf16_t* pa[4]; const bf16_t* pb[4];
    const int r0 = tid >> 3, kc = (tid & 7) * 8;
#pragma unroll
    for (int i = 0; i < 4; ++i) { pa[i] = ra(r0 + i * 32); pb[i] = rb(r0 + i * 32); }
    u32x4 va[4], vb[4];
#pragma unroll
    for (int i = 0; i < 4; ++i) { va[i] = *(const u32x4*)(pa[i] + kc); vb[i] = *(const u32x4*)(pb[i] + kc); }
    for (int k0 = 0; k0 < K; k0 += 64) {
        __syncthreads();
#pragma unroll
        for (int i = 0; i < 4; ++i) { *(u32x4*)(As + (r0 + i * 32) * LDS_STRIDE + kc) = va[i]; *(u32x4*)(Bs + (r0 + i * 32) * LDS_STRIDE + kc) = vb[i]; }
        __syncthreads();
        if (k0 + 64 < K) {
#pragma unroll
            for (int i = 0; i < 4; ++i) { va[i] = *(const u32x4*)(pa[i] + k0 + 64 + kc); vb[i] = *(const u32x4*)(pb[i] + k0 + 64 + kc); }
        }
#pragma unroll
        for (int ks = 0; ks < 2; ++ks) {
            bf16x8 xa[4], wb[4];
#pragma unroll
            for (int i = 0; i < 4; ++i) { xa[i] = *(const bf16x8*)(As + (wm * 64 + i * 16 + lr) * LDS_STRIDE + ks * 32 + lq * 8);
                                          wb[i] = *(const bf16x8*)(Bs + (wn * 64 + i * 16 + lr) * LDS_STRIDE + ks * 32 + lq * 8); }
#pragma unroll
            for (int mi = 0; mi < 4; ++mi)
#pragma unroll
                for (int ni = 0; ni < 4; ++ni) acc[mi][ni] = __builtin_amdgcn_mfma_f32_16x16x32_bf16(wb[ni], xa[mi], acc[mi][ni], 0, 0, 0);
        }
    }
    epi(acc, wm, wn, lr, lq);
}

struct RowLin { const bf16_t* base; long ld; __device__ __forceinline__ const bf16_t* operator()(int r) const { return base + (long)r * ld; } };

__global__ void __launch_bounds__(256) k_inproj(P p, int l) {
    __shared__ __attribute__((aligned(16))) bf16_t smem[2 * 128 * LDS_STRIDE];
    const int mt = blockIdx.x, nt = blockIdx.y;
    RowLin ra{p.H + (long)mt * 128 * D, D}, rb{p.WT_IN + ((long)l * PC + nt * 128) * D, D};
    bf16_t* out = p.PROJ + (long)mt * 128 * PC + nt * 128;
    auto epi = [&](const f32x4 (&acc)[4][4], int wm, int wn, int lr, int lq) {
#pragma unroll
        for (int mi = 0; mi < 4; ++mi)
#pragma unroll
            for (int ni = 0; ni < 4; ++ni) {
                const f32x4 a = acc[mi][ni];
                uint2 o; o.x = (unsigned)f2bf(a[0]) | ((unsigned)f2bf(a[1]) << 16); o.y = (unsigned)f2bf(a[2]) | ((unsigned)f2bf(a[3]) << 16);
                *(uint2*)(out + (long)(wm * 64 + mi * 16 + lr) * PC + wn * 64 + ni * 16 + lq * 4) = o;
            }
    };
    gemm_tile(ra, rb, D, smem, smem + 128 * LDS_STRIDE, epi);
}

__global__ void __launch_bounds__(256) k_outproj(P p, int l) {
    __shared__ __attribute__((aligned(16))) bf16_t smem[2 * 128 * LDS_STRIDE];
    const int mt = blockIdx.x, nt = blockIdx.y;
    RowLin ra{p.MIXO + (long)mt * 128 * D, D}, rb{p.WT_OUT + ((long)l * D + nt * 128) * D, D};
    auto epi = [&](const f32x4 (&acc)[4][4], int wm, int wn, int lr, int lq) {
#pragma unroll
        for (int mi = 0; mi < 4; ++mi) {
            const int tok = mt * 128 + wm * 64 + mi * 16 + lr;
            const float* g1 = p.MOD + ((long)l * 5 + tok_modrow(tok)) * 6 * D + 2 * D;
#pragma unroll
            for (int ni = 0; ni < 4; ++ni) {
                const int n = nt * 128 + wn * 64 + ni * 16 + lq * 4;
                const float4 g = *(const float4*)(g1 + n);
                float4* xp = (float4*)(p.X + (long)tok * D + n);
                float4 xv = *xp; const f32x4 a = acc[mi][ni];
                xv.x += g.x * a[0]; xv.y += g.y * a[1]; xv.z += g.z * a[2]; xv.w += g.w * a[3];
                *xp = xv;
            }
        }
    };
    gemm_tile(ra, rb, D, smem, smem + 128 * LDS_STRIDE, epi);
}

__global__ void __launch_bounds__(256) k_rope(P p) {
    const long idx = (long)blockIdx.x * 256 + threadIdx.x;
    if (idx >= (long)NLAT * 448) return;
    const int tok = (int)(idx / 448), pr = (int)(idx % 448);
    const int i = tok % L, rowp = i >> 6, colp = i & 63;
    int i1, i2; float ang;
    if (pr < 192) {
        const int hh = pr >> 5, q = pr & 31, half = q >> 4, f = q & 15;
        const int base = (hh < 4 ? P_AQ + hh * 64 : P_AK + (hh - 4) * 64) + half * 32;
        i1 = base + f; i2 = base + f + 16;
        ang = (float)(half ? colp : rowp) * __expf(-(float)f * (1.f / 16.f) * 9.210340371976184f);
    } else {
        const int q0 = pr - 192, hh = q0 >> 4, q = q0 & 15, half = q >> 3, f = q & 7;
        const int base = (hh < 8 ? P_CQ + hh * 32 : P_CK + (hh - 8) * 32) + half * 16;
        i1 = base + f; i2 = base + f + 8;
        ang = (float)(half ? colp : rowp) * __expf(-(float)f * (1.f / 8.f) * 9.210340371976184f);
    }
    float sn, cs; sincosf(ang, &sn, &cs);
    bf16_t* row = p.PROJ + (long)tok * PC;
    const float u1 = bf2f(row[i1]), u2 = bf2f(row[i2]);
    row[i1] = f2bf(u1 * cs - u2 * sn); row[i2] = f2bf(u1 * sn + u2 * cs);
}

__global__ void __launch_bounds__(256) k_attnA_naive(P p, int l, int ctxq) {
    const int nq = ctxq ? LC : L;
    const int idx = blockIdx.x * 256 + threadIdx.x;
    if (idx >= NB * 4 * nq) return;
    const int i = idx % nq, h = (idx / nq) % 4, b = idx / (nq * 4), kvh = h >> 1;
    const int tokq = ctxq ? NLAT + b * LC + i : b * L + i;
    float q[64], o[64];
    const bf16_t* qp = p.PROJ + (long)tokq * PC + P_AQ + h * 64;
#pragma unroll
    for (int d = 0; d < 64; ++d) { q[d] = bf2f(qp[d]) * 0.125f; o[d] = 0.f; }
    float m = p.a_sink[l * 4 + h], s = 1.f;
    const int j0 = ctxq ? 0 : max(0, i - 128), j1 = ctxq ? -1 : min(L - 1, i + 128);
    const int nloc = j1 - j0 + 1;
    for (int jj = 0; jj < nloc + LC; ++jj) {
        const int tok = jj < nloc ? b * L + j0 + jj : NLAT + b * LC + (jj - nloc);
        const bf16_t* kp = p.PROJ + (long)tok * PC + P_AK + kvh * 64;
        const bf16_t* vp = p.PROJ + (long)tok * PC + P_AV + kvh * 64;
        float sc = 0.f;
#pragma unroll
        for (int d = 0; d < 64; ++d) sc += q[d] * bf2f(kp[d]);
        const float mn = fmaxf(m, sc), al = __expf(m - mn), pe = __expf(sc - mn);
        s = s * al + pe; m = mn;
#pragma unroll
        for (int d = 0; d < 64; ++d) o[d] = o[d] * al + pe * bf2f(vp[d]);
    }
    const float inv = 1.f / s;
    bf16_t* op = p.MIXO + (long)tokq * D + h * 64;
#pragma unroll
    for (int d = 0; d < 64; ++d) op[d] = f2bf(o[d] * inv);
}

__global__ void __launch_bounds__(256) k_attnC_naive(P p, int l, int ctxq) {
    const int nq = ctxq ? LC : L;
    const int idx = blockIdx.x * 256 + threadIdx.x;
    if (idx >= NB * 4 * nq) return;
    const int i = idx % nq, hh = (idx / nq) % 4, b = idx / (nq * 4);
    const int tokq = ctxq ? NLAT + b * LC + i : b * L + i;
    const float lambda_init = 0.8f - 0.6f * expf(-0.3f * (float)l);
    float d1 = 0.f, d2 = 0.f;
    for (int d = 0; d < 32; ++d) { d1 += p.c_lambda[(l * 4 + 0) * 32 + d] * p.c_lambda[(l * 4 + 1) * 32 + d]; d2 += p.c_lambda[(l * 4 + 2) * 32 + d] * p.c_lambda[(l * 4 + 3) * 32 + d]; }
    const float lam = expf(d1) - expf(d2) + lambda_init;
    float of[64];
#pragma unroll
    for (int d = 0; d < 64; ++d) of[d] = 0.f;
    const int nlat = ctxq ? 0 : L;
#pragma unroll 1
    for (int mm = 0; mm < 2; ++mm) {
        float q[32], o[64];
        const bf16_t* qp = p.PROJ + (long)tokq * PC + P_CQ + (hh * 2 + mm) * 32;
#pragma unroll
        for (int d = 0; d < 32; ++d) q[d] = bf2f(qp[d]) * 0.17677669529663687f;
#pragma unroll
        for (int d = 0; d < 64; ++d) o[d] = 0.f;
        float m = -1e30f, s = 0.f;
        for (int jj = 0; jj < nlat + LC; ++jj) {
            const int tok = jj < nlat ? b * L + jj : NLAT + b * LC + (jj - nlat);
            const bf16_t* kp = p.PROJ + (long)tok * PC + P_CK + (hh * 2 + mm) * 32;
            const bf16_t* vp = p.PROJ + (long)tok * PC + P_CV + hh * 64;
            float sc = 0.f;
#pragma unroll
            for (int d = 0; d < 32; ++d) sc += q[d] * bf2f(kp[d]);
            const float mn = fmaxf(m, sc), al = __expf(m - mn), pe = __expf(sc - mn);
            s = s * al + pe; m = mn;
#pragma unroll
            for (int d = 0; d < 64; ++d) o[d] = o[d] * al + pe * bf2f(vp[d]);
        }
        const float cf = (mm == 0 ? 1.f : -lam) / s;
#pragma unroll
        for (int d = 0; d < 64; ++d) of[d] += cf * o[d];
    }
    float ss = 0.f;
#pragma unroll
    for (int d = 0; d < 64; ++d) ss += of[d] * of[d];
    const float r = rsqrtf(ss * (1.f / 64.f) + EPS) * (1.f - lambda_init);
    bf16_t* op = p.MIXO + (long)tokq * D + 768 + hh * 64;
#pragma unroll
    for (int d = 0; d < 64; ++d) op[d] = f2bf(of[d] * r * p.c_subln_w[l * 64 + d]);
}

__global__ void __launch_bounds__(256) k_conv(P p, int l) {
    const long idx = (long)blockIdx.x * 256 + threadIdx.x;
    if (idx >= (long)NTOK * 768) return;
    const int tok = (int)(idx / 768), c = (int)(idx % 768);
    int pos, len; if (tok < NLAT) { pos = tok % L; len = L; } else { pos = (tok - NLAT) % LC; len = LC; }
    float acc = p.conv_b[l * 768 + c];
#pragma unroll
    for (int t = 0; t < 5; ++t) { const int pp = pos + t - 2; if (pp >= 0 && pp < len) acc += p.conv_w[(l * 5 + t) * 768 + c] * bf2f(p.PROJ[(long)(tok + t - 2) * PC + P_BX + c]); }
    p.XBC[(long)tok * 768 + c] = siluf(acc);
}

__global__ void __launch_bounds__(64) k_scan_naive(P p, int l, int write_ctx) {
    const int pp = threadIdx.x, head = blockIdx.x & 7, dir = (blockIdx.x >> 3) & 1, b = blockIdx.x >> 4, g = head >> 2;
    float h[64];
#pragma unroll
    for (int n = 0; n < 64; ++n) h[n] = 0.f;
    const float a = -expf(p.a_log[(l * 2 + dir) * 8 + head]), dtb = p.dt_bias[(l * 2 + dir) * 8 + head];
    float* Yd = p.Y + (long)dir * NTOK * 512;
    for (int step = 0; step < LC + L; ++step) {
        int tok; bool wr;
        if (step < LC) { const int j = dir ? LC - 1 - step : step; tok = NLAT + b * LC + j; wr = write_ctx != 0; }
        else { const int j = dir ? L - 1 - (step - LC) : (step - LC); tok = b * L + j; wr = true; }
        const float dtr = p.DT[tok * 16 + dir * 8 + head] + dtb;
        const float dt = fmaxf(dtr, 0.f) + log1pf(expf(-fabsf(dtr)));
        const float dec = expf(dt * a);
        const float* xr = p.XBC + (long)tok * 768;
        const float xv = xr[head * 64 + pp] * dt;
        const float* Bv = xr + 512 + g * 64; const float* Cv = xr + 640 + g * 64;
        float y = 0.f;
#pragma unroll
        for (int n = 0; n < 64; ++n) { h[n] = dec * h[n] + xv * Bv[n]; y += h[n] * Cv[n]; }
        if (wr) Yd[(long)tok * 512 + head * 64 + pp] = y;
    }
}

__global__ void __launch_bounds__(256) k_ssd_finish(P p, int l, int ntok) {
    const int wave = threadIdx.x >> 6, lane = threadIdx.x & 63;
    const int tok = blockIdx.x * 4 + wave;
    if (tok >= ntok) return;
    float g[8]; float ss = 0.f;
#pragma unroll
    for (int e = 0; e < 8; ++e) {
        const int ch = lane * 8 + e, head = ch >> 6;
        const float dsk = p.d_skip[(l * 2 + 0) * 8 + head] + p.d_skip[(l * 2 + 1) * 8 + head];
        const float y = p.Y[(long)tok * 512 + ch] + p.Y[(long)NTOK * 512 + (long)tok * 512 + ch] + p.XBC[(long)tok * 768 + ch] * dsk;
        const float z = bf2f(p.PROJ[(long)tok * PC + P_BZ + ch]);
        g[e] = y * siluf(z); ss += g[e] * g[e];
    }
#pragma unroll
    for (int o = 16; o > 0; o >>= 1) ss += __shfl_xor(ss, o);
    const float r = rsqrtf(ss * (1.f / 256.f) + EPS);
#pragma unroll
    for (int e = 0; e < 8; ++e) { const int ch = lane * 8 + e; p.MIXO[(long)tok * D + 256 + ch] = f2bf(g[e] * r * p.b_norm_w[l * 512 + ch]); }
}

__global__ void __launch_bounds__(256) k_norm2_route(P p, int l, int ntok) {
    const int wave = threadIdx.x >> 6, lane = threadIdx.x & 63;
    const int tok = blockIdx.x * 4 + wave;
    if (tok >= ntok) return;
    float v[16];
    const float* src = p.X + (long)tok * D;
#pragma unroll
    for (int i = 0; i < 4; ++i) { const float4 t = *(const float4*)(src + i * 256 + lane * 4); v[i * 4 + 0] = t.x; v[i * 4 + 1] = t.y; v[i * 4 + 2] = t.z; v[i * 4 + 3] = t.w; }
    float ss = 0.f;
#pragma unroll
    for (int i = 0; i < 16; ++i) ss += v[i] * v[i];
    ss = wave_sum(ss);
    const float r = rsqrtf(ss * (1.f / D) + EPS);
    const float* m = p.MOD + ((long)l * 5 + tok_modrow(tok)) * 6 * D;
    const float* nw = p.norm2_w + l * D;
    float lg[36];
#pragma unroll
    for (int j = 0; j < 36; ++j) lg[j] = 0.f;
    bf16_t* ho = p.H + (long)tok * D;
#pragma unroll
    for (int i = 0; i < 4; ++i) {
        float h[4];
#pragma unroll
        for (int e = 0; e < 4; ++e) { const int k = i * 256 + lane * 4 + e; h[e] = v[i * 4 + e] * r * nw[k] * (1.f + m[4 * D + k]) + m[3 * D + k]; }
        uint2 o; o.x = (unsigned)f2bf(h[0]) | ((unsigned)f2bf(h[1]) << 16); o.y = (unsigned)f2bf(h[2]) | ((unsigned)f2bf(h[3]) << 16);
        *(uint2*)(ho + i * 256 + lane * 4) = o;
#pragma unroll
        for (int e = 0; e < 4; ++e) {
            const int k = i * 256 + lane * 4 + e;
            const float4 wg = *(const float4*)(p.w_grouter + ((long)l * D + k) * 4);
            lg[0] += h[e] * wg.x; lg[1] += h[e] * wg.y; lg[2] += h[e] * wg.z; lg[3] += h[e] * wg.w;
            const float* wr = p.w_router + ((long)l * D + k) * 32;
#pragma unroll
            for (int j4 = 0; j4 < 8; ++j4) { const float4 w4 = *(const float4*)(wr + j4 * 4);
                lg[4 + j4 * 4 + 0] += h[e] * w4.x; lg[4 + j4 * 4 + 1] += h[e] * w4.y; lg[4 + j4 * 4 + 2] += h[e] * w4.z; lg[4 + j4 * 4 + 3] += h[e] * w4.w; }
        }
    }
#pragma unroll
    for (int j = 0; j < 36; ++j) lg[j] = wave_sum(lg[j]);
    if (lane == 0) {
        int gs = 0; float gm = lg[0];
#pragma unroll
        for (int j = 1; j < 4; ++j) if (lg[j] > gm) { gm = lg[j]; gs = j; }
        float den = 0.f;
#pragma unroll
        for (int j = 0; j < 4; ++j) den += expf(lg[j] - gm);
        const float gp = 1.f / den;
        float e0 = -3.4e38f, e1 = -3.4e38f; int i0 = 0, i1 = 0;
#pragma unroll
        for (int gsel = 0; gsel < 4; ++gsel) {
            if (gsel == gs) {
#pragma unroll
                for (int j = 0; j < 8; ++j) {
                    const float val = lg[4 + gsel * 8 + j];
                    if (val > e0) { e1 = e0; i1 = i0; e0 = val; i0 = j; }
                    else if (val > e1) { e1 = val; i1 = j; }
                }
            }
        }
        const float x1 = expf(e1 - e0), w0 = gp / (1.f + x1), w1 = gp * x1 / (1.f + x1);
        const int ex0 = gs * 8 + i0, ex1 = gs * 8 + i1;
        int* cnt = p.cnt + l * NEXP;
        const int rk0 = atomicAdd(&cnt[ex0], 1); p.list[(long)ex0 * NTOK + rk0] = tok * 2 + 0; p.gatew[tok * 2 + 0] = w0;
        const int rk1 = atomicAdd(&cnt[ex1], 1); p.list[(long)ex1 * NTOK + rk1] = tok * 2 + 1; p.gatew[tok * 2 + 1] = w1;
    }
}

struct MoeTile { int e, mt, cnt, off; };
__device__ __forceinline__ MoeTile moe_find_tile(const int* cnt, int tile) {
    MoeTile t; t.e = -1; t.mt = 0; t.cnt = 0; t.off = 0;
    int acc_t = 0, off = 0;
    for (int e = 0; e < NEXP; ++e) {
        const int c = cnt[e], nt = (c + 127) >> 7;
        if (t.e < 0 && tile < acc_t + nt) { t.e = e; t.mt = tile - acc_t; t.cnt = c; t.off = off; }
        acc_t += nt; off += c;
    }
    return t;
}
struct RowGather { const bf16_t* base; const int* lst; int n; __device__ __forceinline__ const bf16_t* operator()(int r) const { return base + (long)(lst[r < n ? r : n - 1] >> 1) * D; } };
struct RowLimit { const bf16_t* base; long ld; int n; __device__ __forceinline__ const bf16_t* operator()(int r) const { return base + (long)(r < n ? r : n - 1) * ld; } };
struct RowGateUp { const bf16_t* wg; const bf16_t* wu; __device__ __forceinline__ const bf16_t* operator()(int n) const {
    const int wn = n >> 6, f = (n >> 4) & 3, j = n & 15, col = wn * 32 + (f & 1) * 16 + j; return (f >> 1 ? wu : wg) + (long)col * D; } };

__global__ void __launch_bounds__(256) k_moe_up(P p, int l) {
    __shared__ __attribute__((aligned(16))) bf16_t smem[2 * 128 * LDS_STRIDE];
    const MoeTile t = moe_find_tile(p.cnt + l * NEXP, blockIdx.x);
    if (t.e < 0) return;
    const int h0 = blockIdx.y * 64;
    const int nrow = min(128, t.cnt - t.mt * 128);
    RowGather ra{p.H, p.list + (long)t.e * NTOK + t.mt * 128, nrow};
    const long wofs = (((long)l * NEXP + t.e) * DEXP + h0) * D;
    RowGateUp rb{p.WT_G + wofs, p.WT_U + wofs};
    bf16_t* out = p.HID + (long)(t.off + t.mt * 128) * DEXP + h0;
    auto epi = [&](const f32x4 (&acc)[4][4], int wm, int wn, int lr, int lq) {
#pragma unroll
        for (int mi = 0; mi < 4; ++mi) {
            const int r = wm * 64 + mi * 16 + lr;
            if (r < nrow) {
#pragma unroll
                for (int f = 0; f < 2; ++f) {
                    const f32x4 gt = acc[mi][f], up = acc[mi][2 + f];
                    float hv[4];
#pragma unroll
                    for (int e = 0; e < 4; ++e) hv[e] = siluf(gt[e]) * up[e];
                    uint2 o; o.x = (unsigned)f2bf(hv[0]) | ((unsigned)f2bf(hv[1]) << 16); o.y = (unsigned)f2bf(hv[2]) | ((unsigned)f2bf(hv[3]) << 16);
                    *(uint2*)(out + (long)r * DEXP + wn * 32 + f * 16 + lq * 4) = o;
                }
            }
        }
    };
    gemm_tile(ra, rb, D, smem, smem + 128 * LDS_STRIDE, epi);
}

__global__ void __launch_bounds__(256) k_moe_down(P p, int l) {
    __shared__ __attribute__((aligned(16))) bf16_t smem[2 * 128 * LDS_STRIDE];
    const MoeTile t = moe_find_tile(p.cnt + l * NEXP, blockIdx.x);
    if (t.e < 0) return;
    const int n0 = blockIdx.y * 128;
    const int nrow = min(128, t.cnt - t.mt * 128);
    const int slot0 = t.off + t.mt * 128;
    RowLimit ra{p.HID + (long)slot0 * DEXP, DEXP, nrow};
    RowLin rb{p.WT_D + (((long)l * NEXP + t.e) * D + n0) * DEXP, DEXP};
    const int* lst = p.list + (long)t.e * NTOK + t.mt * 128;
    auto epi = [&](const f32x4 (&acc)[4][4], int wm, int wn, int lr, int lq) {
#pragma unroll
        for (int mi = 0; mi < 4; ++mi) {
            const int r = wm * 64 + mi * 16 + lr;
            if (r < nrow) {
                const int asg = lst[r], tok = asg >> 1;
                const float gw = p.gatew[asg];
                const float* g2 = p.MOD + ((long)l * 5 + tok_modrow(tok)) * 6 * D + 5 * D;
                if (blockIdx.y == 0 && wn == 0 && lq == 0) p.pos[asg] = slot0 + r;
#pragma unroll
                for (int ni = 0; ni < 4; ++ni) {
                    const int n = n0 + wn * 64 + ni * 16 + lq * 4;
                    const float4 g = *(const float4*)(g2 + n); const f32x4 a = acc[mi][ni];
                    uint2 o; o.x = (unsigned)f2bf(a[0] * gw * g.x) | ((unsigned)f2bf(a[1] * gw * g.y) << 16);
                    o.y = (unsigned)f2bf(a[2] * gw * g.z) | ((unsigned)f2bf(a[3] * gw * g.w) << 16);
                    *(uint2*)(p.YS + (long)(slot0 + r) * D + n) = o;
                }
            }
        }
    };
    gemm_tile(ra, rb, DEXP, smem, smem + 128 * LDS_STRIDE, epi);
}

__global__ void __launch_bounds__(256) k_final(P p) {
    const int wave = threadIdx.x >> 6, lane = threadIdx.x & 63;
    const int tok = blockIdx.x * 4 + wave;
    if (tok >= NLAT) return;
    float v[16];
    const float* src = p.X + (long)tok * D;
#pragma unroll
    for (int i = 0; i < 4; ++i) { const float4 t = *(const float4*)(src + i * 256 + lane * 4); v[i * 4 + 0] = t.x; v[i * 4 + 1] = t.y; v[i * 4 + 2] = t.z; v[i * 4 + 3] = t.w; }
#pragma unroll
    for (int k = 0; k < 2; ++k) {
        const int slot = p.pos[tok * 2 + k];
        const bf16_t* ys = p.YS + (long)slot * D;
#pragma unroll
        for (int i = 0; i < 4; ++i) { const uint2 t = *(const uint2*)(ys + i * 256 + lane * 4);
            v[i * 4 + 0] += bf2f((bf16_t)(t.x & 0xffff)); v[i * 4 + 1] += bf2f((bf16_t)(t.x >> 16)); v[i * 4 + 2] += bf2f((bf16_t)(t.y & 0xffff)); v[i * 4 + 3] += bf2f((bf16_t)(t.y >> 16)); }
    }
    float ss = 0.f;
#pragma unroll
    for (int i = 0; i < 16; ++i) ss += v[i] * v[i];
    ss = wave_sum(ss);
    const float r = rsqrtf(ss * (1.f / D) + EPS);
    float* o = p.out + (long)tok * D;
#pragma unroll
    for (int i = 0; i < 4; ++i) { const float4 w = *(const float4*)(p.final_w + i * 256 + lane * 4);
        *(float4*)(o + i * 256 + lane * 4) = make_float4(v[i * 4 + 0] * r * w.x, v[i * 4 + 1] * r * w.y, v[i * 4 + 2] * r * w.z, v[i * 4 + 3] * r * w.w); }
}

extern "C" void kernel_launch(void* const* d_in, const int* in_sizes, int n_in, void* d_out, int out_size, void* d_ws, size_t ws_size, hipStream_t stream) {
    P p{};
    const float** f = (const float**)&p;
    for (int i = 0; i < 25; ++i) f[i] = (const float*)d_in[i];
    p.out = (float*)d_out;
    char* w = (char*)d_ws; size_t off = 0;
    auto take = [&](size_t bytes) { char* r = w + off; off += (bytes + 255) & ~(size_t)255; return r; };
    p.X = (float*)take((size_t)NTOK * D * 4);
    p.MOD = (float*)take((size_t)DEPTH * 5 * 6 * D * 4);
    p.DT = (float*)take((size_t)NTOK * 16 * 4);
    p.XBC = (float*)take((size_t)NTOK * 768 * 4);
    p.Y = (float*)take((size_t)2 * NTOK * 512 * 4);
    p.gatew = (float*)take((size_t)NTOK * 2 * 4);
    p.H = (bf16_t*)take((size_t)NTOK * D * 2);
    p.PROJ = (bf16_t*)take((size_t)NTOK * PC * 2);
    p.WT_IN = (bf16_t*)take((size_t)DEPTH * PC * D * 2);
    p.WT_OUT = (bf16_t*)take((size_t)DEPTH * D * D * 2);
    p.WT_G = (bf16_t*)take((size_t)DEPTH * NEXP * DEXP * D * 2);
    p.WT_U = (bf16_t*)take((size_t)DEPTH * NEXP * DEXP * D * 2);
    p.WT_D = (bf16_t*)take((size_t)DEPTH * NEXP * DEXP * D * 2);
    p.MIXO = (bf16_t*)take((size_t)NTOK * D * 2);
    p.HID = (bf16_t*)take((size_t)(NTOK * 2 + 128) * DEXP * 2);
    p.YS = (bf16_t*)take((size_t)(NTOK * 2 + 128) * D * 2);
    p.cnt = (int*)take((size_t)DEPTH * NEXP * 4);
    p.list = (int*)take((size_t)NEXP * NTOK * 4);
    p.pos = (int*)take((size_t)NTOK * 2 * 4);
    if (off > ws_size) { fprintf(stderr, "workspace too small: need %zu have %zu\n", off, ws_size); return; }

    hipMemsetAsync(p.cnt, 0, DEPTH * NEXP * 4, stream);
    k_convT<<<dim3(56, 32, DEPTH), 256, 0, stream>>>(p.w_in, p.WT_IN, D, IN_COLS, 0, 1792, 0, (long)D * IN_COLS, (long)PC * D);
    k_convT<<<dim3(24, 32, DEPTH), 256, 0, stream>>>(p.w_in, p.WT_IN, D, IN_COLS, 1808, 768, 1792, (long)D * IN_COLS, (long)PC * D);
    k_convT<<<dim3(32, 32, DEPTH), 256, 0, stream>>>(p.w_out, p.WT_OUT, D, D, 0, D, 0, (long)D * D, (long)D * D);
    k_convT<<<dim3(16, 32, DEPTH * NEXP), 256, 0, stream>>>(p.w_gate, p.WT_G, D, DEXP, 0, DEXP, 0, (long)D * DEXP, (long)D * DEXP);
    k_convT<<<dim3(16, 32, DEPTH * NEXP), 256, 0, stream>>>(p.w_up, p.WT_U, D, DEXP, 0, DEXP, 0, (long)D * DEXP, (long)D * DEXP);
    k_convT<<<dim3(32, 16, DEPTH * NEXP), 256, 0, stream>>>(p.w_down, p.WT_D, DEXP, D, 0, D, 0, (long)D * DEXP, (long)D * DEXP);
    k_mod<<<(DEPTH * 6 * D + 255) / 256, 256, 0, stream>>>(p);

    for (int l = 0; l < DEPTH; ++l) {
        const bool last = (l == DEPTH - 1);
        k_norm1<<<NTOK / 4, 256, 0, stream>>>(p, l);
        k_inproj<<<dim3(NTOK / 128, PC / 128), 256, 0, stream>>>(p, l);
        k_rope<<<(int)(((long)NLAT * 448 + 255) / 256), 256, 0, stream>>>(p);
        k_attnA_naive<<<NB * 4 * L / 256, 256, 0, stream>>>(p, l, 0);
        k_attnC_naive<<<NB * 4 * L / 256, 256, 0, stream>>>(p, l, 0);
        if (!last) {
            k_attnA_naive<<<NB * 4 * LC / 256, 256, 0, stream>>>(p, l, 1);
            k_attnC_naive<<<NB * 4 * LC / 256, 256, 0, stream>>>(p, l, 1);
        }
        k_conv<<<(int)(((long)NTOK * 768 + 255) / 256), 256, 0, stream>>>(p, l);
        k_scan_naive<<<NB * 16, 64, 0, stream>>>(p, l, last ? 0 : 1);
        const int ntok = last ? NLAT : NTOK;
        k_ssd_finish<<<ntok / 4, 256, 0, stream>>>(p, l, ntok);
        k_outproj<<<dim3(ntok / 128, D / 128), 256, 0, stream>>>(p, l);
        k_norm2_route<<<ntok / 4, 256, 0, stream>>>(p, l, ntok);
        k_moe_up<<<dim3(NTOK * 2 / 128 + NEXP, DEXP / 64), 256, 0, stream>>>(p, l);
        k_moe_down<<<dim3(NTOK * 2 / 128 + NEXP, D / 128), 256, 0, stream>>>(p, l);
    }
    k_final<<<NLAT / 4, 256, 0, stream>>>(p);
}
```

```cpp
#include <hip/hip_runtime.h>
#include <cstdio>
#include <cstdint>

typedef unsigned short bf16_t;
typedef short bf16x8 __attribute__((ext_vector_type(8)));
typedef float f32x4 __attribute__((ext_vector_type(4)));
typedef unsigned u32x4 __attribute__((ext_vector_type(4)));
typedef float f32x16 __attribute__((ext_vector_type(16)));

constexpr int D = 1024, NB = 4, L = 4096, LC = 256, NLAT = NB * L, NCTX = NB * LC, NTOK = NLAT + NCTX, DEPTH = 4;
constexpr int IN_COLS = 2576, OLD_BDT = 1792;
constexpr int PC = 2560;
constexpr int PCW = 2688;
constexpr int P_AQ = 0, P_AK = 256, P_AV = 384, P_BZ = 512, P_BX = 1024, P_CQ = 1792, P_CK = 2048, P_CV = 2304;
constexpr int NEXP = 32, DEXP = 512;
constexpr int NKEY = L + LC;
constexpr int NKT = NKEY / 64;
constexpr float EPS = 1e-6f;

__device__ __forceinline__ int otid() { int t = threadIdx.x; asm volatile("" : "+v"(t)); return t; }
typedef __bf16 bf16n2 __attribute__((ext_vector_type(2)));
__device__ __forceinline__ bf16_t f2bf(float f) { return __builtin_bit_cast(bf16_t, (__bf16)f); }
__device__ __forceinline__ unsigned pack_bf16(float a, float b) { const bf16n2 v = {(__bf16)a, (__bf16)b}; return __builtin_bit_cast(unsigned, v); }
__device__ __forceinline__ float bf2f(bf16_t h) { return __uint_as_float(((unsigned)h) << 16); }
__device__ __forceinline__ float wave_sum(float v) {
#pragma unroll
    for (int o = 32; o > 0; o >>= 1) v += __shfl_xor(v, o);
    return v;
}
__device__ __forceinline__ float siluf(float v) { return v * __builtin_amdgcn_rcpf(1.f + __expf(-v)); }
__device__ __forceinline__ int tok_modrow(int tok) { return tok < NLAT ? tok / L : NB; }

struct P {
    const float *x, *c, *ctx, *c_ctx, *w_mod, *b_mod, *norm1_w, *norm2_w, *w_in, *w_out, *a_sink, *conv_w, *conv_b, *dt_bias, *a_log, *d_skip,
        *b_norm_w, *c_lambda, *c_subln_w, *w_grouter, *w_router, *w_gate, *w_up, *w_down, *final_w;
    float* out;
    float* X; float* MOD; float* DT; float* SSQ; float* gatew; float* ST; float* DEC; float* ROPE;
    bf16_t *H, *PROJ, *WT_IN, *WT_OUT, *WT_G, *WT_U, *WT_D, *MIXO, *HID, *YS, *VT, *VTA, *HS, *WT_R;
    int *cnt, *list, *pos;
    unsigned* bar; unsigned* cuslot;
    unsigned* SYNC;
    unsigned* KMAX;
};

__device__ __forceinline__ void b_convT(float (*t)[65], int bx, int by, int bz, const float* __restrict__ src, bf16_t* __restrict__ dst, int K, int ld_src, int c0, int ncols, int n_dst0,
                                        long src_bstride, long dst_bstride) {
    src += (long)bz * src_bstride; dst += (long)bz * dst_bstride;
    const int kb = by * 64, nb = bx * 64, tid = otid();
    const int c4 = (tid & 15) * 4, kr0 = tid >> 4;
#pragma unroll
    for (int i = 0; i < 4; ++i) {
        const int kr = kr0 + i * 16;
        float4 v = make_float4(0.f, 0.f, 0.f, 0.f);
        if (nb + c4 < ncols) v = *(const float4*)(src + (long)(kb + kr) * ld_src + c0 + nb + c4);
        t[kr][c4] = v.x; t[kr][c4 + 1] = v.y; t[kr][c4 + 2] = v.z; t[kr][c4 + 3] = v.w;
    }
    __syncthreads();
    const int n = tid >> 2, kq = (tid & 3) * 16;
    if (nb + n < ncols) {
        unsigned o[8];
#pragma unroll
        for (int j = 0; j < 8; ++j) o[j] = (unsigned)f2bf(t[kq + 2 * j][n]) | ((unsigned)f2bf(t[kq + 2 * j + 1][n]) << 16);
        bf16_t* d = dst + (long)(n_dst0 + nb + n) * K + kb + kq;
        *(u32x4*)d = (u32x4){o[0], o[1], o[2], o[3]};
        *(u32x4*)(d + 8) = (u32x4){o[4], o[5], o[6], o[7]};
    }
    __syncthreads();
}

__device__ __forceinline__ void b_convT_stream(int vb, const float* __restrict__ src, bf16_t* __restrict__ dst, int K, int N, const float* rowscale = nullptr,
                                               int ld_src = 0, int c0 = 0, int n_dst0 = 0, long src_ms = 0, long dst_ms = 0) {
    const int tid = otid(), lane = tid & 63;
    const int gw = vb * 4 + (tid >> 6);
    const int nbs = N >> 6, kbs = K >> 6;
    const int mat = gw / (nbs * kbs), r = gw % (nbs * kbs), kb = r / nbs, nb = r % nbs;
    const int kq = lane & 3, n4l = lane >> 2;
    if (ld_src == 0) { ld_src = N; src_ms = (long)K * N; dst_ms = (long)K * N; }
    const float* sp = src + mat * src_ms + (long)(kb * 64 + kq * 8) * ld_src + c0 + nb * 64 + n4l * 4;
    float4 v[16];
#pragma unroll
    for (int j = 0; j < 16; ++j) v[j] = *(const float4*)(sp + (long)((j & 7) + (j >> 3) * 32) * ld_src);
    if (rowscale) {
        const int k0 = kb * 64 + kq * 8;
        if (k0 >= 256 && k0 < 768) {
#pragma unroll
            for (int j = 0; j < 16; ++j) { const float sc = rowscale[mat * 512 + k0 - 256 + (j & 7) + (j >> 3) * 32]; v[j].x *= sc; v[j].y *= sc; v[j].z *= sc; v[j].w *= sc; }
        }
    }
    bf16_t* dp = dst + mat * dst_ms + (long)(n_dst0 + nb * 64 + n4l * 4) * K + kb * 64 + kq * 8;
    u32x4 o0, o1;
#pragma unroll
    for (int j = 0; j < 4; ++j) { o0[j] = pack_bf16(v[2 * j].x, v[2 * j + 1].x); o1[j] = pack_bf16(v[8 + 2 * j].x, v[8 + 2 * j + 1].x); }
    *(u32x4*)dp = o0; *(u32x4*)(dp + 32) = o1;
#pragma unroll
    for (int j = 0; j < 4; ++j) { o0[j] = pack_bf16(v[2 * j].y, v[2 * j + 1].y); o1[j] = pack_bf16(v[8 + 2 * j].y, v[8 + 2 * j + 1].y); }
    *(u32x4*)(dp + K) = o0; *(u32x4*)(dp + K + 32) = o1;
#pragma unroll
    for (int j = 0; j < 4; ++j) { o0[j] = pack_bf16(v[2 * j].z, v[2 * j + 1].z); o1[j] = pack_bf16(v[8 + 2 * j].z, v[8 + 2 * j + 1].z); }
    *(u32x4*)(dp + 2 * K) = o0; *(u32x4*)(dp + 2 * K + 32) = o1;
#pragma unroll
    for (int j = 0; j < 4; ++j) { o0[j] = pack_bf16(v[2 * j].w, v[2 * j + 1].w); o1[j] = pack_bf16(v[8 + 2 * j].w, v[8 + 2 * j + 1].w); }
    *(u32x4*)(dp + 3 * K) = o0; *(u32x4*)(dp + 3 * K + 32) = o1;
}

__device__ __forceinline__ void b_rope_table(const P& p, int vb) {
    const int idx = vb * 256 + otid();
    if (idx >= 64 * 24) return;
    const int pos = idx / 24, f = idx % 24;
    const float fr = f < 16 ? __expf(-(float)f * (1.f / 16.f) * 9.210340371976184f) : __expf(-(float)(f - 16) * (1.f / 8.f) * 9.210340371976184f);
    float sn, cs; sincosf((float)pos * fr, &sn, &cs);
    p.ROPE[idx * 2] = cs; p.ROPE[idx * 2 + 1] = sn;
}

__device__ __forceinline__ void b_mod(const P& p, int vb, float* red) {
    const int tid = otid(), lane = tid & 63, kq = tid >> 6, ks = lane >> 4, c4 = (lane & 15) * 4;
    const int idx = vb * 64 + c4;
    const int l = idx / (6 * D), n = idx % (6 * D);
    float acc[5][4];
#pragma unroll
    for (int r = 0; r < 5; ++r)
#pragma unroll
        for (int e = 0; e < 4; ++e) acc[r][e] = 0.f;
    const float* w = p.w_mod + (long)l * D * 6 * D + n;
#pragma unroll 16
    for (int k = kq * 256 + ks; k < kq * 256 + 256; k += 4) {
        const float4 wv = *(const float4*)(w + (long)k * 6 * D);
#pragma unroll
        for (int r = 0; r < 5; ++r) {
            const float cv = siluf((r < 4) ? p.c[r * D + k] : p.c_ctx[k]);
            acc[r][0] += cv * wv.x; acc[r][1] += cv * wv.y; acc[r][2] += cv * wv.z; acc[r][3] += cv * wv.w;
        }
    }
#pragma unroll
    for (int r = 0; r < 5; ++r)
#pragma unroll
        for (int e = 0; e < 4; ++e) { float v = acc[r][e]; v += __shfl_xor(v, 16); v += __shfl_xor(v, 32); acc[r][e] = v; }
    __syncthreads();
    if (ks == 0) {
#pragma unroll
        for (int r = 0; r < 5; ++r) *(float4*)(red + (kq * 5 + r) * 64 + c4) = make_float4(acc[r][0], acc[r][1], acc[r][2], acc[r][3]);
    }
    __syncthreads();
    if (tid < 64) {
        const int col = tid, i2 = vb * 64 + col, n2 = i2 % (6 * D);
        const float bv = p.b_mod[l * 6 * D + n2];
#pragma unroll
        for (int r = 0; r < 5; ++r) p.MOD[((long)l * 5 + r) * 6 * D + n2] = ((red[(0 * 5 + r) * 64 + col] + red[(1 * 5 + r) * 64 + col]) + (red[(2 * 5 + r) * 64 + col] + red[(3 * 5 + r) * 64 + col])) + bv;
    }
}

__device__ __forceinline__ void wt_store(float* ptr, float v) { __hip_atomic_store(ptr, v, __ATOMIC_RELAXED, __HIP_MEMORY_SCOPE_AGENT); }
__device__ __forceinline__ void wt_store(unsigned* ptr, unsigned v) { __hip_atomic_store(ptr, v, __ATOMIC_RELAXED, __HIP_MEMORY_SCOPE_AGENT); }
__device__ __forceinline__ void wt_store8(void* ptr, unsigned lo, unsigned hi) { __hip_atomic_store((unsigned long long*)ptr, ((unsigned long long)hi << 32) | lo, __ATOMIC_RELAXED, __HIP_MEMORY_SCOPE_AGENT); }
__device__ __forceinline__ void unit_publish(unsigned* cnt) {
    asm volatile("s_waitcnt vmcnt(0)" ::: "memory");
    __syncthreads();
    if (threadIdx.x == 0) (void)__hip_atomic_fetch_add(cnt, 1u, __ATOMIC_RELAXED, __HIP_MEMORY_SCOPE_AGENT);
}
__device__ __forceinline__ void unit_wait(unsigned* cnt, unsigned target) {
    if (threadIdx.x == 0) {
        unsigned sp = 0;
        while (__hip_atomic_load(cnt, __ATOMIC_RELAXED, __HIP_MEMORY_SCOPE_AGENT) < target) { __builtin_amdgcn_s_sleep(2); if (++sp > (1u << 24)) break; }
        __builtin_amdgcn_fence(__ATOMIC_ACQUIRE, "agent");
        asm volatile("s_waitcnt vmcnt(0)" ::: "memory");
    }
    __syncthreads();
}

__device__ __forceinline__ void unit_wait_nf(unsigned* cnt, unsigned target) {
    if (threadIdx.x == 0) {
        unsigned sp = 0;
        while (__hip_atomic_load(cnt, __ATOMIC_RELAXED, __HIP_MEMORY_SCOPE_AGENT) < target) { __builtin_amdgcn_s_sleep(2); if (++sp > (1u << 24)) break; }
    }
    __syncthreads();
    asm volatile("" ::: "memory");
}
constexpr int SY_LAYER = 64, SY_STRIDE = 1024, SY_N1 = 0, SY_OP = 136, SY_N2 = 272, SY_UP = 408;
__device__ __forceinline__ unsigned* sync_ctr(const P& p, int l, int which, int idx) { return p.SYNC + SY_LAYER + l * SY_STRIDE + which + idx; }

__device__ __forceinline__ void b_norm1(const P& p, int l, int vb) {
    const int wave = otid() >> 6, lane = otid() & 63;
#pragma unroll 1
    for (int i4 = 0; i4 < 4; ++i4) {
        const int tok = vb * 16 + wave * 4 + i4;
        float v[16];
        const float* src = (l == 0) ? (tok < NLAT ? p.x + (long)tok * D : p.ctx + (long)(tok - NLAT) * D) : p.X + (long)tok * D;
#pragma unroll
        for (int i = 0; i < 4; ++i) { const float4 t = *(const float4*)(src + i * 256 + lane * 4); v[i * 4 + 0] = t.x; v[i * 4 + 1] = t.y; v[i * 4 + 2] = t.z; v[i * 4 + 3] = t.w; }
        if (l > 0) {
            const bf16_t* ys0 = p.YS + (long)p.pos[tok * 2 + 0] * D; const bf16_t* ys1 = p.YS + (long)p.pos[tok * 2 + 1] * D;
            const float* g2 = p.MOD + ((long)(l - 1) * 5 + tok_modrow(tok)) * 6 * D + 5 * D;
#pragma unroll
            for (int i = 0; i < 4; ++i) {
                const uint2 t = *(const uint2*)(ys0 + i * 256 + lane * 4), u = *(const uint2*)(ys1 + i * 256 + lane * 4);
                const float4 g = *(const float4*)(g2 + i * 256 + lane * 4);
                v[i * 4 + 0] += (bf2f((bf16_t)(t.x & 0xffff)) + bf2f((bf16_t)(u.x & 0xffff))) * g.x; v[i * 4 + 1] += (bf2f((bf16_t)(t.x >> 16)) + bf2f((bf16_t)(u.x >> 16))) * g.y;
                v[i * 4 + 2] += (bf2f((bf16_t)(t.y & 0xffff)) + bf2f((bf16_t)(u.y & 0xffff))) * g.z; v[i * 4 + 3] += (bf2f((bf16_t)(t.y >> 16)) + bf2f((bf16_t)(u.y >> 16))) * g.w;
            }
        }
        float* xo = p.X + (long)tok * D;
#pragma unroll
        for (int i = 0; i < 4; ++i) *(float4*)(xo + i * 256 + lane * 4) = make_float4(v[i * 4 + 0], v[i * 4 + 1], v[i * 4 + 2], v[i * 4 + 3]);
        float ss = 0.f;
#pragma unroll
        for (int i = 0; i < 16; ++i) ss += v[i] * v[i];
        ss = wave_sum(ss);
        const float r = rsqrtf(ss * (1.f / D) + EPS);
        const float* m = p.MOD + ((long)l * 5 + tok_modrow(tok)) * 6 * D;
        const float* nw = p.norm1_w + l * D;
        bf16_t* ho = p.H + (long)tok * D;
#pragma unroll
        for (int i = 0; i < 4; ++i) {
            const int k = i * 256 + lane * 4;
            const float4 w4 = *(const float4*)(nw + k), sc = *(const float4*)(m + D + k), sh = *(const float4*)(m + k);
            wt_store8(ho + k, pack_bf16(v[i * 4 + 0] * r * w4.x * (1.f + sc.x) + sh.x, v[i * 4 + 1] * r * w4.y * (1.f + sc.y) + sh.y),
                              pack_bf16(v[i * 4 + 2] * r * w4.z * (1.f + sc.z) + sh.z, v[i * 4 + 3] * r * w4.w * (1.f + sc.w) + sh.w));
        }
    }
    unit_publish(sync_ctr(p, l, SY_N1, vb >> 3));
}

#define LAS __attribute__((address_space(3)))
constexpr int LDS_STRIDE = 72;
constexpr int SMEM_BYTES = 65536;
constexpr int LDS_BYTES = SMEM_BYTES + 256;
struct NoHook { template <class A> __device__ __forceinline__ void operator()(int, A&) const {} };
template <int MI = 4, int NI = 4, class RowA, class RowB, class Epi, class Hook = NoHook>
__device__ __forceinline__ void gemm_tile(const RowA& ra, const RowB& rb, int K, bf16_t* smem, const Epi& epi, const Hook& hook = Hook()) {
    LAS unsigned char* lds = (LAS unsigned char*)smem;
    const int tid = otid(), lane = tid & 63, w = __builtin_amdgcn_readfirstlane(tid >> 6), wm = w >> 1, wn = w & 1, lr = lane & 15, lq = lane >> 4;
    f32x4 acc[MI][NI];
#pragma unroll
    for (int i = 0; i < MI; ++i)
#pragma unroll
        for (int j = 0; j < NI; ++j) acc[i][j] = (f32x4){0.f, 0.f, 0.f, 0.f};
    const bf16_t* pa[MI]; const bf16_t* pb[NI];
    const int kcs = ((lane & 7) ^ ((lane >> 3) & 7)) * 8;
#pragma unroll
    for (int i = 0; i < MI; ++i) pa[i] = ra((i * 4 + w) * 8 + (lane >> 3)) + kcs;
#pragma unroll
    for (int i = 0; i < NI; ++i) pb[i] = rb((i * 4 + w) * 8 + (lane >> 3)) + kcs;
    auto stage = [&](int buf, int k0) {
#pragma unroll
        for (int i = 0; i < MI; ++i) __builtin_amdgcn_global_load_lds((const unsigned*)(pa[i] + k0), (LAS unsigned*)(lds + buf * 32768 + (i * 4 + w) * 1024), 16, 0, 0);
#pragma unroll
        for (int i = 0; i < NI; ++i) __builtin_amdgcn_global_load_lds((const unsigned*)(pb[i] + k0), (LAS unsigned*)(lds + buf * 32768 + 16384 + (i * 4 + w) * 1024), 16, 0, 0);
    };
    const int aoff = (wm * MI * 16 + lr) * 128 + ((lq ^ (lr & 7)) << 4), boff = 16384 + (wn * NI * 16 + lr) * 128 + ((lq ^ (lr & 7)) << 4);
    const int nk = K >> 6;
    __syncthreads();
    stage(0, 0);
    for (int kt = 0; kt < nk; ++kt) {
        asm volatile("s_waitcnt vmcnt(0)" ::: "memory");
        __syncthreads();
        if (kt + 1 < nk) stage((kt + 1) & 1, (kt + 1) * 64);
        hook(kt, acc);
        const LAS unsigned char* bs = lds + (kt & 1) * 32768;
#pragma unroll
        for (int ks = 0; ks < 2; ++ks) {
            bf16x8 xa[MI], wb[NI];
#pragma unroll
            for (int i = 0; i < MI; ++i) xa[i] = *(const LAS bf16x8*)(bs + (aoff ^ (ks << 6)) + i * 2048);
#pragma unroll
            for (int i = 0; i < NI; ++i) wb[i] = *(const LAS bf16x8*)(bs + (boff ^ (ks << 6)) + i * 2048);
#pragma unroll
            for (int mi = 0; mi < MI; ++mi)
#pragma unroll
                for (int ni = 0; ni < NI; ++ni) acc[mi][ni] = __builtin_amdgcn_mfma_f32_16x16x32_bf16(wb[ni], xa[mi], acc[mi][ni], 0, 0, 0);
        }
    }
    epi(acc, wm, wn, lr, lq);
}

template <int MI, int NI, class RowA, class RowB, class Epi>
__device__ __forceinline__ void gemm_tile32(const RowA& ra, const RowB& rb, int K, bf16_t* smem, const Epi& epi) {
    LAS unsigned char* lds = (LAS unsigned char*)smem;
    const int tid = otid(), lane = tid & 63, w = __builtin_amdgcn_readfirstlane(tid >> 6), wm = w >> 1, wn = w & 1, lr = lane & 15, lq = lane >> 4;
    constexpr int ABYTES = MI * 32 * 64, STG = (MI + NI) * 32 * 64, PA = MI / 2, PB = NI / 2;
    f32x4 acc[MI][NI];
#pragma unroll
    for (int i = 0; i < MI; ++i)
#pragma unroll
        for (int j = 0; j < NI; ++j) acc[i][j] = (f32x4){0.f, 0.f, 0.f, 0.f};
    const bf16_t* pa[PA]; const bf16_t* pb[PB];
    const int kcs = ((lane & 3) ^ ((4 - ((lane >> 4) & 3)) & 3)) * 8;
#pragma unroll
    for (int i = 0; i < PA; ++i) pa[i] = ra((i * 4 + w) * 16 + (lane >> 2)) + kcs;
#pragma unroll
    for (int i = 0; i < PB; ++i) pb[i] = rb((i * 4 + w) * 16 + (lane >> 2)) + kcs;
    auto stage = [&](int buf, int k0) {
#pragma unroll
        for (int i = 0; i < PA; ++i) __builtin_amdgcn_global_load_lds((const unsigned*)(pa[i] + k0), (LAS unsigned*)(lds + buf * STG + (i * 4 + w) * 1024), 16, 0, 0);
#pragma unroll
        for (int i = 0; i < PB; ++i) __builtin_amdgcn_global_load_lds((const unsigned*)(pb[i] + k0), (LAS unsigned*)(lds + buf * STG + ABYTES + (i * 4 + w) * 1024), 16, 0, 0);
    };
    const int fsw = (lq ^ ((4 - ((lr >> 2) & 3)) & 3)) << 4;
    const int aoff = (wm * MI * 16 + lr) * 64 + fsw, boff = ABYTES + (wn * NI * 16 + lr) * 64 + fsw;
    const int nk = K >> 5;
    __syncthreads();
    stage(0, 0);
    for (int kt = 0; kt < nk; ++kt) {
        asm volatile("s_waitcnt vmcnt(0)" ::: "memory");
        __syncthreads();
        if (kt + 1 < nk) stage((kt + 1) & 1, (kt + 1) * 32);
        const LAS unsigned char* bs = lds + (kt & 1) * STG;
        bf16x8 xa[MI], wb[NI];
#pragma unroll
        for (int i = 0; i < MI; ++i) xa[i] = *(const LAS bf16x8*)(bs + aoff + i * 1024);
#pragma unroll
        for (int i = 0; i < NI; ++i) wb[i] = *(const LAS bf16x8*)(bs + boff + i * 1024);
#pragma unroll
        for (int mi = 0; mi < MI; ++mi)
#pragma unroll
            for (int ni = 0; ni < NI; ++ni) acc[mi][ni] = __builtin_amdgcn_mfma_f32_16x16x32_bf16(wb[ni], xa[mi], acc[mi][ni], 0, 0, 0);
    }
    epi(acc, wm, wn, lr, lq);
}

struct RowLin { const bf16_t* base; long ld; __device__ __forceinline__ const bf16_t* operator()(int r) const { return base + (long)r * ld; } };

__device__ __forceinline__ void b_inproj(const P& p, int l, int vb, bf16_t* smem) {
    const int mt = vb / (PCW / 128), nt = vb % (PCW / 128);
    RowLin ra{p.H + (long)mt * 128 * D, D}, rb{p.WT_IN + ((long)l * PCW + nt * 128) * D, D};
    unit_wait_nf(sync_ctr(p, l, SY_N1, mt), 8u);
    const bool latent = mt < NLAT / 128;
    const int kind = (nt == 20) ? 3 : (nt == 3 || nt == 18 || nt == 19) ? 2 : (latent && nt <= 2) ? 0 : (latent && nt >= 14 && nt <= 17) ? 1 : 4;
    constexpr int OS = 136;
    auto epi = [&](f32x4 (&acc)[4][4], int wm, int wn, int lr, int lq) {
        if (kind == 3) {
            if (wn == 0) {
#pragma unroll
                for (int mi = 0; mi < 4; ++mi) *(f32x4*)(p.DT + (long)(mt * 128 + wm * 64 + mi * 16 + lr) * 16 + lq * 4) = acc[mi][0];
            }
            return;
        }
        if (nt == 2 || nt == 16 || nt == 17) {
            const int b = latent ? mt / (L / 128) : (mt - NLAT / 128) / (LC / 128);
#pragma unroll
            for (int half = 0; half < 2; ++half) {
                float mxv = 0.f;
#pragma unroll
                for (int mi = 0; mi < 4; ++mi) {
                    float ssq = 0.f;
#pragma unroll
                    for (int n2 = 0; n2 < 2; ++n2)
#pragma unroll
                        for (int e = 0; e < 4; ++e) { const float v = acc[mi][2 * half + n2][e]; ssq += v * v; }
                    ssq += __shfl_xor(ssq, 16); ssq += __shfl_xor(ssq, 32);
                    mxv = fmaxf(mxv, ssq);
                }
                if (nt == 2) {
                    const float other = mxv;
                    (void)other;
                }
                if (nt != 2) {
#pragma unroll
                    for (int o = 1; o < 16; o <<= 1) mxv = fmaxf(mxv, __shfl_xor(mxv, o));
                    if ((otid() & 63) == 0) atomicMax(&p.KMAX[(l * NB + b) * 10 + (nt - 16) * 4 + wn * 2 + half], __float_as_uint(mxv));
                }
            }
            if (nt == 2) {
                float mxv = 0.f;
#pragma unroll
                for (int mi = 0; mi < 4; ++mi) {
                    float ssq = 0.f;
#pragma unroll
                    for (int ni = 0; ni < 4; ++ni)
#pragma unroll
                        for (int e = 0; e < 4; ++e) { const float v = acc[mi][ni][e]; ssq += v * v; }
                    ssq += __shfl_xor(ssq, 16); ssq += __shfl_xor(ssq, 32);
                    mxv = fmaxf(mxv, ssq);
                }
#pragma unroll
                for (int o = 1; o < 16; o <<= 1) mxv = fmaxf(mxv, __shfl_xor(mxv, o));
                if ((otid() & 63) == 0) atomicMax(&p.KMAX[(l * NB + b) * 10 + 8 + wn], __float_as_uint(mxv));
            }
        }
        if (kind == 0) {
#pragma unroll
            for (int mi = 0; mi < 4; ++mi) {
                const int i = (mt * 128 + wm * 64 + mi * 16 + lr) & (L - 1);
#pragma unroll
                for (int hf = 0; hf < 2; ++hf) {
                    const int pos = hf ? (i & 63) : (i >> 6);
                    const float* tb = p.ROPE + (pos * 24 + lq * 4) * 2;
                    const f32x4 t0 = *(const f32x4*)tb, t1 = *(const f32x4*)(tb + 4);
                    const float cs[4] = {t0[0], t0[2], t1[0], t1[2]}, sn[4] = {t0[1], t0[3], t1[1], t1[3]};
#pragma unroll
                    for (int e = 0; e < 4; ++e) {
                        const float u1 = acc[mi][2 * hf][e], u2 = acc[mi][2 * hf + 1][e];
                        acc[mi][2 * hf][e] = u1 * cs[e] - u2 * sn[e]; acc[mi][2 * hf + 1][e] = u1 * sn[e] + u2 * cs[e];
                    }
                }
            }
        } else if (kind == 1) {
#pragma unroll
            for (int mi = 0; mi < 4; ++mi) {
                const int i = (mt * 128 + wm * 64 + mi * 16 + lr) & (L - 1);
#pragma unroll
                for (int hf = 0; hf < 2; ++hf) {
                    const int pos = hf ? (i & 63) : (i >> 6);
                    const float* tb = p.ROPE + (pos * 24 + 16 + (lq & 1) * 4) * 2;
                    const f32x4 t0 = *(const f32x4*)tb, t1 = *(const f32x4*)(tb + 4);
                    const float cs[4] = {t0[0], t0[2], t1[0], t1[2]}, sn[4] = {t0[1], t0[3], t1[1], t1[3]};
#pragma unroll
                    for (int n2 = 0; n2 < 2; ++n2) {
                        const int ni = 2 * n2 + hf;
#pragma unroll
                        for (int e = 0; e < 4; ++e) {
                            const float v = acc[mi][ni][e], pv = __shfl_xor(v, 32);
                            acc[mi][ni][e] = lq < 2 ? v * cs[e] - pv * sn[e] : pv * sn[e] + v * cs[e];
                        }
                    }
                }
            }
        }
        __syncthreads();
        if (kind == 2) {
#pragma unroll
            for (int mi = 0; mi < 4; ++mi) {
                const int m = wm * 64 + mi * 16 + lr, mp = (m & ~12) | ((m & 4) << 1) | ((m & 8) >> 1);
#pragma unroll
                for (int ni = 0; ni < 4; ++ni)
#pragma unroll
                    for (int e = 0; e < 4; ++e) smem[(wn * 64 + ni * 16 + lq * 4 + e) * OS + mp] = f2bf(acc[mi][ni][e]);
            }
        } else {
#pragma unroll
            for (int mi = 0; mi < 4; ++mi)
#pragma unroll
                for (int ni = 0; ni < 4; ++ni) {
                    const f32x4 a = acc[mi][ni];
                    uint2 o; o.x = pack_bf16(a[0], a[1]); o.y = pack_bf16(a[2], a[3]);
                    *(uint2*)(smem + (wm * 64 + mi * 16 + lr) * OS + wn * 64 + ni * 16 + lq * 4) = o;
                }
        }
        __syncthreads();
        const int tid = otid();
        if (kind == 2) {
            const int nh = nt == 3 ? 2 : 4, hbase = nt == 3 ? 0 : (nt - 18) * 2;
            bf16_t* vtb = nt == 3 ? p.VTA : p.VT;
            const int b = latent ? mt / (L / 128) : (mt - NLAT / 128) / (LC / 128);
            const int key0 = latent ? (mt % (L / 128)) * 128 : L + ((mt - NLAT / 128) % (LC / 128)) * 128;
#pragma unroll
            for (int i2 = 0; i2 < 8; ++i2) {
                const int idx = tid + i2 * 256, n = idx >> 4, mc = (idx & 15) * 8;
                const u32x4 v = *(const u32x4*)(smem + n * OS + mc);
                *(u32x4*)(vtb + ((long)(b * nh + hbase + (n >> 6)) * 64 + (n & 63)) * NKEY + key0 + mc) = v;
            }
        } else {
            bf16_t* out = p.PROJ + (long)mt * 128 * PC + nt * 128;
#pragma unroll
            for (int i2 = 0; i2 < 8; ++i2) {
                const int idx = tid + i2 * 256, m = idx >> 4, nc = (idx & 15) * 8;
                *(u32x4*)(out + (long)m * PC + nc) = *(const u32x4*)(smem + m * OS + nc);
            }
        }
    };
    gemm_tile(ra, rb, D, smem, epi);
}

template <int MI, int NI>
__device__ __forceinline__ void b_outproj(const P& p, int l, int row0, int col0, bf16_t* smem) {
    RowLin ra{p.MIXO + (long)row0 * D, D}, rb{p.WT_OUT + ((long)l * D + col0) * D, D};
    auto epi = [&](const f32x4 (&acc)[MI][NI], int wm, int wn, int lr, int lq) {
#pragma unroll
        for (int mi = 0; mi < MI; ++mi) {
            const int tok = row0 + wm * MI * 16 + mi * 16 + lr;
            const float* g1 = p.MOD + ((long)l * 5 + tok_modrow(tok)) * 6 * D + 2 * D;
#pragma unroll
            for (int ni = 0; ni < NI; ++ni) {
                const int n = col0 + wn * NI * 16 + ni * 16 + lq * 4;
                const float4 g = *(const float4*)(g1 + n);
                float4* xp = (float4*)(p.X + (long)tok * D + n);
                float4 xv = *xp; const f32x4 a = acc[mi][ni];
                xv.x += g.x * a[0]; xv.y += g.y * a[1]; xv.z += g.z * a[2]; xv.w += g.w * a[3];
                *xp = xv;
            }
        }
    };
    float rs0[MI], rs1[MI];
    {
        const int lane = otid() & 63, w = otid() >> 6, wm0 = w >> 1, lr0 = lane & 15;
#pragma unroll
        for (int mi = 0; mi < MI; ++mi) {
            const float* sq = p.SSQ + (long)(row0 + wm0 * MI * 16 + mi * 16 + lr0) * 8;
            const f32x4 s0 = *(const f32x4*)sq, s1 = *(const f32x4*)(sq + 4);
            rs0[mi] = rsqrtf(((s0[0] + s0[1]) + (s0[2] + s0[3])) * (1.f / 256.f) + EPS); rs1[mi] = rsqrtf(((s1[0] + s1[1]) + (s1[2] + s1[3])) * (1.f / 256.f) + EPS);
        }
    }
    auto hook = [&](int kt, f32x4 (&acc)[MI][NI]) {
        if (kt == 4 || kt == 8 || kt == 12) {
#pragma unroll
            for (int mi = 0; mi < MI; ++mi) {
                const float f = kt == 4 ? 1.f / rs0[mi] : kt == 8 ? rs0[mi] / rs1[mi] : rs1[mi];
#pragma unroll
                for (int ni = 0; ni < NI; ++ni) acc[mi][ni] *= f;
            }
        }
    };
    gemm_tile<MI, NI>(ra, rb, D, smem, epi, hook);
}


__device__ __forceinline__ void b_attnC(const P& p, int l, int unit, bf16_t* smem) {
    const int tid = otid(), lane = tid & 63, w = tid >> 6, c = lane & 31, h = lane >> 5;
    const bool ctxq = unit >= NB * 4 * (L / 128);
    int b, hh, qb;
    if (!ctxq) { qb = unit & 31; hh = (unit >> 5) & 3; b = unit >> 7; }
    else { const int u = unit - NB * 4 * (L / 128); qb = u & 1; hh = (u >> 1) & 3; b = u >> 3; }
    const int tokq = (ctxq ? NLAT + b * LC : b * L) + qb * 128 + w * 32 + c;
    const int t0 = ctxq ? 64 : 0, nt = ctxq ? 4 : NKT;
    const float lambda_init = 0.8f - 0.6f * expf(-0.3f * (float)l);
    const float* cl = p.c_lambda + l * 128;
    const float d1 = wave_sum(h == 0 ? cl[c] * cl[32 + c] : 0.f), d2 = wave_sum(h == 0 ? cl[64 + c] * cl[96 + c] : 0.f);
    const float lam = expf(d1) - expf(d2) + lambda_init;
    bf16x8 qf[2][2];
    {
        const float qs = 0.17677669529663687f * 1.4426950408889634f;
        const bf16_t* qp = p.PROJ + (long)tokq * PC + P_CQ + hh * 64;
#pragma unroll
        for (int m = 0; m < 2; ++m)
#pragma unroll
            for (int s2 = 0; s2 < 2; ++s2) {
                const u32x4 raw = *(const u32x4*)(qp + m * 32 + s2 * 16 + h * 8);
                u32x4 sc;
#pragma unroll
                for (int e = 0; e < 4; ++e) sc[e] = pack_bf16(bf2f((bf16_t)(raw[e] & 0xffff)) * qs, bf2f((bf16_t)(raw[e] >> 16)) * qs);
                qf[m][s2] = __builtin_bit_cast(bf16x8, sc);
            }
    }
    LAS unsigned char* lds = (LAS unsigned char*)smem;
    const bf16_t* vtb = p.VT + (long)(b * 4 + hh) * 64 * NKEY;
    const int wu = __builtin_amdgcn_readfirstlane(w);
    int srow[2], schk[2];
#pragma unroll
    for (int i = 0; i < 2; ++i) { srow[i] = (wu * 2 + i) * 8 + (lane >> 3); schk[i] = ((lane & 7) ^ ((srow[i] >> 1) & 7)) * 8; }
    auto dma = [&](int buf, int t) {
        const int tok0 = t < 64 ? b * L + t * 64 : NLAT + b * LC + (t - 64) * 64;
#pragma unroll
        for (int i = 0; i < 2; ++i) {
            __builtin_amdgcn_global_load_lds((const unsigned*)(p.PROJ + (long)(tok0 + srow[i]) * PC + P_CK + hh * 64 + schk[i]), (LAS unsigned*)(lds + buf * 16384 + (wu * 2 + i) * 1024), 16, 0, 0);
            __builtin_amdgcn_global_load_lds((const unsigned*)(vtb + (long)srow[i] * NKEY + t * 64 + schk[i]), (LAS unsigned*)(lds + buf * 16384 + 8192 + (wu * 2 + i) * 1024), 16, 0, 0);
        }
    };
    f32x16 o[2][2];
#pragma unroll
    for (int m = 0; m < 2; ++m)
#pragma unroll
        for (int dt = 0; dt < 2; ++dt)
#pragma unroll
            for (int e = 0; e < 16; ++e) o[m][dt][e] = 0.f;
    float negm[2];
    float lsum[2] = {0.f, 0.f};
#pragma unroll
    for (int m = 0; m < 2; ++m) {
        float qn = 0.f;
#pragma unroll
        for (int s2 = 0; s2 < 2; ++s2) { const u32x4 qq = __builtin_bit_cast(u32x4, qf[m][s2]);
#pragma unroll
            for (int e = 0; e < 4; ++e) { const float a = bf2f((bf16_t)(qq[e] & 0xffff)), bq = bf2f((bf16_t)(qq[e] >> 16)); qn += a * a + bq * bq; } }
        qn += __shfl_xor(qn, 32);
        const float km = __uint_as_float(p.KMAX[(l * NB + b) * 10 + hh * 2 + m]);
        negm[m] = -sqrtf(qn * km);
    }
    f32x16 negv;
    { const float nm = fminf(negm[0], negm[1]);
#pragma unroll
      for (int e = 0; e < 16; ++e) negv[e] = nm; }
    const int swz = (c >> 1) & 7;
    const int krow = c * 128, fo0 = ((0 + h) ^ swz) << 4, fo1 = ((2 + h) ^ swz) << 4, fo2 = ((4 + h) ^ swz) << 4, fo3 = ((6 + h) ^ swz) << 4;
    __syncthreads();
    dma(0, t0);
    for (int it = 0; it < nt; ++it) {
        asm volatile("s_waitcnt vmcnt(0)" ::: "memory");
        __syncthreads();
        if (it + 1 < nt) dma((it + 1) & 1, t0 + it + 1);
        const LAS unsigned char* Ks = lds + (it & 1) * 16384; const LAS unsigned char* Vs = Ks + 8192;
        auto qk = [&](int sub, int m) -> f32x16 {
            const LAS unsigned char* kr = Ks + sub * 4096 + krow;
            const bf16x8 k0 = *(const LAS bf16x8*)(kr + (m ? fo2 : fo0)), k1 = *(const LAS bf16x8*)(kr + (m ? fo3 : fo1));
            const f32x16 sa = __builtin_amdgcn_mfma_f32_32x32x16_bf16(k0, qf[m][0], negv, 0, 0, 0);
            return __builtin_amdgcn_mfma_f32_32x32x16_bf16(k1, qf[m][1], sa, 0, 0, 0);
        };
        f32x16 sa = qk(0, 0);
        bf16x8 vf[2][2];
#pragma unroll
        for (int j = 0; j < 4; ++j) {
            const int sub = j >> 1, m = j & 1;
            if (m == 0) {
#pragma unroll
                for (int dt = 0; dt < 2; ++dt) {
                    const LAS unsigned char* vr = Vs + dt * 4096 + krow;
                    vf[dt][0] = *(const LAS bf16x8*)(vr + (sub ? fo2 : fo0)); vf[dt][1] = *(const LAS bf16x8*)(vr + (sub ? fo3 : fo1));
                }
            }
            f32x16 san;
            if (j < 3) san = qk((j + 1) >> 1, (j + 1) & 1);
            float ps = 0.f;
            u32x4 a0, a1;
#pragma unroll
            for (int e = 0; e < 4; ++e) {
                const float p0 = __builtin_amdgcn_exp2f(sa[2 * e]), p1 = __builtin_amdgcn_exp2f(sa[2 * e + 1]);
                const float p2 = __builtin_amdgcn_exp2f(sa[8 + 2 * e]), p3 = __builtin_amdgcn_exp2f(sa[8 + 2 * e + 1]);
                ps = (((ps + p0) + p1) + p2) + p3;
                a0[e] = pack_bf16(p0, p1); a1[e] = pack_bf16(p2, p3);
            }
            lsum[m] += ps; asm volatile("" : "+v"(lsum[m]));
            const bf16x8 pk0 = __builtin_bit_cast(bf16x8, a0), pk1 = __builtin_bit_cast(bf16x8, a1);
#pragma unroll
            for (int dt = 0; dt < 2; ++dt) {
                o[m][dt] = __builtin_amdgcn_mfma_f32_32x32x16_bf16(vf[dt][0], pk0, o[m][dt], 0, 0, 0);
                o[m][dt] = __builtin_amdgcn_mfma_f32_32x32x16_bf16(vf[dt][1], pk1, o[m][dt], 0, 0, 0);
            }
            if (j < 3) sa = san;
            __builtin_amdgcn_sched_barrier(0);
        }
    }
    __syncthreads();
    const float l0 = lsum[0] + __shfl_xor(lsum[0], 32), l1 = lsum[1] + __shfl_xor(lsum[1], 32);
    const float c0 = 1.f / l0, c1 = -lam / l1;
    float ss = 0.f;
#pragma unroll
    for (int dt = 0; dt < 2; ++dt)
#pragma unroll
        for (int e = 0; e < 16; ++e) { const float v = o[0][dt][e] * c0 + o[1][dt][e] * c1; o[0][dt][e] = v; ss += v * v; }
    ss += __shfl_xor(ss, 32);
    const float r = rsqrtf(ss * (1.f / 64.f) + EPS) * (1.f - lambda_init);
    bf16_t* op = p.MIXO + (long)tokq * D + 768 + hh * 64;
    int lw = l * 64; asm volatile("" : "+v"(lw));
#pragma unroll
    for (int dt = 0; dt < 2; ++dt)
#pragma unroll
        for (int g = 0; g < 4; ++g) {
            const int dv = dt * 32 + 8 * g + 4 * h;
            const float4 wv = *(const float4*)(p.c_subln_w + lw + dv);
            uint2 ov; ov.x = pack_bf16(o[0][dt][4 * g + 0] * r * wv.x, o[0][dt][4 * g + 1] * r * wv.y);
            ov.y = pack_bf16(o[0][dt][4 * g + 2] * r * wv.z, o[0][dt][4 * g + 3] * r * wv.w);
            *(uint2*)(op + dv) = ov;
        }
}


__device__ __forceinline__ void b_attnA(const P& p, int l, int unit, bf16_t* smem) {
    const int tid = otid(), lane = tid & 63, w = tid >> 6, c = lane & 31, h = lane >> 5;
    const bool ctxq = unit >= NB * 4 * (L / 128);
    int b, hd, qb;
    if (!ctxq) { qb = unit & 31; hd = (unit >> 5) & 3; b = unit >> 7; }
    else { const int u = unit - NB * 4 * (L / 128); qb = u & 1; hd = (u >> 1) & 3; b = u >> 3; }
    const int kvh = hd >> 1;
    const int q0 = qb * 128 + w * 32, iq = q0 + c;
    const int tokq = (ctxq ? NLAT + b * LC : b * L) + iq;
    const int tl0 = ctxq ? 0 : max(0, 2 * qb - 2), tl1 = ctxq ? -1 : min(63, 2 * qb + 3), nloc = tl1 - tl0 + 1, nt = nloc + 4;
    bf16x8 qf[4];
    {
        const float qs = 0.125f * 1.4426950408889634f;
        const bf16_t* qp = p.PROJ + (long)tokq * PC + P_AQ + hd * 64;
#pragma unroll
        for (int s2 = 0; s2 < 4; ++s2) {
            const u32x4 raw = *(const u32x4*)(qp + s2 * 16 + h * 8);
            u32x4 sc;
#pragma unroll
            for (int e = 0; e < 4; ++e) sc[e] = pack_bf16(bf2f((bf16_t)(raw[e] & 0xffff)) * qs, bf2f((bf16_t)(raw[e] >> 16)) * qs);
            qf[s2] = __builtin_bit_cast(bf16x8, sc);
        }
    }
    const bf16_t* vtb = p.VTA + (long)(b * 2 + kvh) * 64 * NKEY;
    const int srow0 = tid >> 3, sch = (tid & 7) * 8;
    u32x4 rk[2], rv[2];
    auto tile_of = [&](int it) { return it < nloc ? tl0 + it : 64 + (it - nloc); };
    auto gload = [&](int t) {
        const int tok0 = t < 64 ? b * L + t * 64 : NLAT + b * LC + (t - 64) * 64;
#pragma unroll
        for (int i = 0; i < 2; ++i) {
            rk[i] = *(const u32x4*)(p.PROJ + (long)(tok0 + srow0 + i * 32) * PC + P_AK + kvh * 64 + sch);
            rv[i] = *(const u32x4*)(vtb + (long)(srow0 + i * 32) * NKEY + t * 64 + sch);
        }
    };
    auto lstore = [&](int buf) {
        bf16_t* Ks = smem + buf * (2 * 64 * 72); bf16_t* Vs = Ks + 64 * 72;
#pragma unroll
        for (int i = 0; i < 2; ++i) { *(u32x4*)(Ks + (srow0 + i * 32) * 72 + sch) = rk[i]; *(u32x4*)(Vs + (srow0 + i * 32) * 72 + sch) = rv[i]; }
    };
    f32x16 o[2];
#pragma unroll
    for (int dt = 0; dt < 2; ++dt)
#pragma unroll
        for (int e = 0; e < 16; ++e) o[dt][e] = 0.f;
    f32x16 negm; float lsum;
    {
        float qn = 0.f;
#pragma unroll
        for (int s2 = 0; s2 < 4; ++s2) { const u32x4 qq = __builtin_bit_cast(u32x4, qf[s2]);
#pragma unroll
            for (int e = 0; e < 4; ++e) { const float a = bf2f((bf16_t)(qq[e] & 0xffff)), bq = bf2f((bf16_t)(qq[e] >> 16)); qn += a * a + bq * bq; } }
        qn += __shfl_xor(qn, 32);
        const float km = __uint_as_float(p.KMAX[(l * NB + b) * 10 + 8 + kvh]);
        const float sk = p.a_sink[l * 4 + hd] * 1.4426950408889634f;
        const float mb = fmaxf(sqrtf(qn * km), sk);
#pragma unroll
        for (int e = 0; e < 16; ++e) negm[e] = -mb;
        lsum = h == 0 ? __builtin_amdgcn_exp2f(sk - mb) : 0.f;
    }
    __syncthreads();
    gload(tile_of(0)); lstore(0);
    __syncthreads();
    for (int it = 0; it < nt; ++it) {
        if (it + 1 < nt) gload(tile_of(it + 1));
        const int t = tile_of(it);
        const bool local = t < 64;
        const bf16_t* Ks = smem + (it & 1) * (2 * 64 * 72); const bf16_t* Vs = Ks + 64 * 72;
#pragma unroll
        for (int sub = 0; sub < 2; ++sub) {
            const int j0 = t * 64 + sub * 32;
            if (local && (j0 + 31 < q0 - 128 || j0 > q0 + 31 + 128)) continue;
            f32x16 sa = negm;
#pragma unroll
            for (int s2 = 0; s2 < 4; ++s2) {
                const bf16x8 kf = *(const bf16x8*)(Ks + (sub * 32 + c) * 72 + s2 * 16 + h * 8);
                sa = __builtin_amdgcn_mfma_f32_32x32x16_bf16(kf, qf[s2], sa, 0, 0, 0);
            }
            if (local) {
#pragma unroll
                for (int e = 0; e < 16; ++e) { const int j = j0 + 8 * (e >> 2) + 4 * h + (e & 3); const int dj = j - iq; if (dj > 128 || dj < -128) sa[e] = -INFINITY; }
            }
            float ps = 0.f;
            u32x4 a0, a1;
#pragma unroll
            for (int e = 0; e < 4; ++e) {
                const float p0 = __builtin_amdgcn_exp2f(sa[2 * e]), p1 = __builtin_amdgcn_exp2f(sa[2 * e + 1]);
                const float p2 = __builtin_amdgcn_exp2f(sa[8 + 2 * e]), p3 = __builtin_amdgcn_exp2f(sa[8 + 2 * e + 1]);
                ps += (p0 + p1) + (p2 + p3);
                a0[e] = pack_bf16(p0, p1); a1[e] = pack_bf16(p2, p3);
            }
            lsum += ps;
            const bf16x8 pk0 = __builtin_bit_cast(bf16x8, a0), pk1 = __builtin_bit_cast(bf16x8, a1);
#pragma unroll
            for (int dt = 0; dt < 2; ++dt) {
                const bf16x8 v0 = *(const bf16x8*)(Vs + (dt * 32 + c) * 72 + sub * 32 + h * 8);
                const bf16x8 v1 = *(const bf16x8*)(Vs + (dt * 32 + c) * 72 + sub * 32 + 16 + h * 8);
                o[dt] = __builtin_amdgcn_mfma_f32_32x32x16_bf16(v0, pk0, o[dt], 0, 0, 0);
                o[dt] = __builtin_amdgcn_mfma_f32_32x32x16_bf16(v1, pk1, o[dt], 0, 0, 0);
            }
        }
        if (it + 1 < nt) lstore((it + 1) & 1);
        __syncthreads();
    }
    const float inv = 1.f / (lsum + __shfl_xor(lsum, 32));
    bf16_t* op = p.MIXO + (long)tokq * D + hd * 64;
#pragma unroll
    for (int dt = 0; dt < 2; ++dt)
#pragma unroll
        for (int g = 0; g < 4; ++g) {
            uint2 ov; ov.x = pack_bf16(o[dt][4 * g + 0] * inv, o[dt][4 * g + 1] * inv); ov.y = pack_bf16(o[dt][4 * g + 2] * inv, o[dt][4 * g + 3] * inv);
            *(uint2*)(op + dt * 32 + 8 * g + 4 * h) = ov;
        }
}

constexpr int NCH = 34;
constexpr int XT_STRIDE = 136;
__device__ __forceinline__ int chunk_tok0(int b, int cc) { return cc < 2 ? NLAT + b * LC + cc * 128 : b * L + (cc - 2) * 128; }
__device__ __forceinline__ float softplusf(float v) { return fmaxf(v, 0.f) + log1pf(expf(-fabsf(v))); }

__device__ __forceinline__ void ssd_dt_cum(const P& p, int l, int tok0, int head, float* cumv, float* dtv) {
    const int lane = otid() & 63, w = otid() >> 6;
    if (w < 2) {
        const int dir = w;
        const float a = -expf(p.a_log[(l * 2 + dir) * 8 + head]), dtb = p.dt_bias[(l * 2 + dir) * 8 + head];
        const int k0 = 2 * lane, k1 = 2 * lane + 1, i0 = dir ? 127 - k0 : k0, i1 = dir ? 127 - k1 : k1;
        const float dt0 = softplusf(p.DT[(long)(tok0 + i0) * 16 + dir * 8 + head] + dtb), dt1 = softplusf(p.DT[(long)(tok0 + i1) * 16 + dir * 8 + head] + dtb);
        const float la0 = dt0 * a, la1 = dt1 * a;
        float sc = la0 + la1;
#pragma unroll
        for (int off = 1; off < 64; off <<= 1) { const float t = __shfl_up(sc, off); if (lane >= off) sc += t; }
        const float excl = sc - (la0 + la1);
        cumv[dir * 128 + i0] = excl + la0; cumv[dir * 128 + i1] = excl + la0 + la1;
        dtv[dir * 128 + i0] = dt0; dtv[dir * 128 + i1] = dt1;
    }
}
__device__ __forceinline__ void ssd_conv_load(const P& p, int tok0, int cpos, int len, int col0, u32x4 (&raw)[8]) {
    const int tid = otid(), ch8 = (tid & 7) * 8, t0 = (tid >> 3) * 4;
#pragma unroll
    for (int r = 0; r < 8; ++r) {
        const int tt = t0 - 2 + r, pos = cpos + tt;
        u32x4 v = (u32x4){0u, 0u, 0u, 0u};
        if (pos >= 0 && pos < len) v = *(const u32x4*)(p.PROJ + (long)(tok0 + tt) * PC + P_BX + col0 + ch8);
        raw[r] = v;
    }
}
template <bool TR>
__device__ __forceinline__ void ssd_conv_apply(const P& p, int l, int col0, const u32x4 (&raw)[8], bf16_t* dst) {
    const int tid = otid(), ch8 = (tid & 7) * 8, t0 = (tid >> 3) * 4;
    float xr[8][8];
#pragma unroll
    for (int r = 0; r < 8; ++r)
#pragma unroll
        for (int e = 0; e < 4; ++e) { xr[r][2 * e] = bf2f((bf16_t)(raw[r][e] & 0xffff)); xr[r][2 * e + 1] = bf2f((bf16_t)(raw[r][e] >> 16)); }
    float acc[4][8];
    { const float4 b0 = *(const float4*)(p.conv_b + l * 768 + col0 + ch8), b1 = *(const float4*)(p.conv_b + l * 768 + col0 + ch8 + 4);
#pragma unroll
      for (int i = 0; i < 4; ++i) { acc[i][0] = b0.x; acc[i][1] = b0.y; acc[i][2] = b0.z; acc[i][3] = b0.w; acc[i][4] = b1.x; acc[i][5] = b1.y; acc[i][6] = b1.z; acc[i][7] = b1.w; } }
#pragma unroll
    for (int tap = 0; tap < 5; ++tap) {
        const float4 w0 = *(const float4*)(p.conv_w + (l * 5 + tap) * 768 + col0 + ch8), w1 = *(const float4*)(p.conv_w + (l * 5 + tap) * 768 + col0 + ch8 + 4);
        const float wv[8] = {w0.x, w0.y, w0.z, w0.w, w1.x, w1.y, w1.z, w1.w};
#pragma unroll
        for (int i = 0; i < 4; ++i)
#pragma unroll
            for (int e = 0; e < 8; ++e) acc[i][e] += wv[e] * xr[i + tap][e];
    }
#pragma unroll
    for (int i = 0; i < 4; ++i) {
        if (TR) {
#pragma unroll
            for (int e = 0; e < 8; ++e) dst[(ch8 + e) * XT_STRIDE + t0 + i] = f2bf(siluf(acc[i][e]));
        } else {
            u32x4 o;
#pragma unroll
            for (int e = 0; e < 4; ++e) o[e] = pack_bf16(siluf(acc[i][2 * e]), siluf(acc[i][2 * e + 1]));
            *(u32x4*)(dst + (t0 + i) * 72 + ch8) = o;
        }
    }
}

__device__ __forceinline__ void b_ssd_states(const P& p, int l, int unit, bf16_t* smem) {
    const int head = unit & 7, cc = (unit >> 3) % NCH, b = unit / (8 * NCH), g = head >> 2;
    const int tok0 = chunk_tok0(b, cc);
    const int tid = otid(), lane = tid & 63, w = tid >> 6, c = lane & 31, h = lane >> 5;
    bf16_t* xT = smem; bf16_t* BT = smem + 64 * XT_STRIDE;
    float* cumv = (float*)(smem + 2 * 64 * XT_STRIDE); float* dtv = cumv + 256; float* wdt = dtv + 256;
    __syncthreads();
    const int cpos = cc < 2 ? cc * 128 : (cc - 2) * 128, slen = cc < 2 ? LC : L;
    {
        u32x4 rx[8], rb[8];
        ssd_conv_load(p, tok0, cpos, slen, head * 64, rx);
        ssd_conv_load(p, tok0, cpos, slen, 512 + g * 64, rb);
        ssd_dt_cum(p, l, tok0, head, cumv, dtv);
        ssd_conv_apply<true>(p, l, head * 64, rx, xT);
        ssd_conv_apply<true>(p, l, 512 + g * 64, rb, BT);
    }
    __syncthreads();
    { const int dir = tid >> 7, t = tid & 127; const float ce = cumv[dir * 128 + (dir ? 0 : 127)];
      wdt[tid] = __expf(ce - cumv[tid]) * dtv[tid];
      if (t == 0) wt_store(&p.DEC[((long)(b * NCH + cc) * 8 + head) * 2 + dir], __expf(ce)); }
    __syncthreads();
    const int dir = w >> 1, pt = w & 1;
    f32x16 acc[2];
#pragma unroll
    for (int nt = 0; nt < 2; ++nt)
#pragma unroll
        for (int e = 0; e < 16; ++e) acc[nt][e] = 0.f;
#pragma unroll
    for (int ks = 0; ks < 8; ++ks) {
        const u32x4 xr = *(const u32x4*)(xT + (pt * 32 + c) * XT_STRIDE + ks * 16 + h * 8);
        const f32x4 w0 = *(const f32x4*)(wdt + dir * 128 + ks * 16 + h * 8), w1 = *(const f32x4*)(wdt + dir * 128 + ks * 16 + h * 8 + 4);
        u32x4 xs;
        xs[0] = pack_bf16(bf2f((bf16_t)(xr[0] & 0xffff)) * w0[0], bf2f((bf16_t)(xr[0] >> 16)) * w0[1]);
        xs[1] = pack_bf16(bf2f((bf16_t)(xr[1] & 0xffff)) * w0[2], bf2f((bf16_t)(xr[1] >> 16)) * w0[3]);
        xs[2] = pack_bf16(bf2f((bf16_t)(xr[2] & 0xffff)) * w1[0], bf2f((bf16_t)(xr[2] >> 16)) * w1[1]);
        xs[3] = pack_bf16(bf2f((bf16_t)(xr[3] & 0xffff)) * w1[2], bf2f((bf16_t)(xr[3] >> 16)) * w1[3]);
        const bf16x8 xa = __builtin_bit_cast(bf16x8, xs);
#pragma unroll
        for (int nt = 0; nt < 2; ++nt) {
            const bf16x8 bb = *(const bf16x8*)(BT + (nt * 32 + c) * XT_STRIDE + ks * 16 + h * 8);
            acc[nt] = __builtin_amdgcn_mfma_f32_32x32x16_bf16(xa, bb, acc[nt], 0, 0, 0);
        }
    }
    float* st = p.ST + (((long)(b * NCH + cc) * 8 + head) * 2 + dir) * 4096;
#pragma unroll
    for (int nt = 0; nt < 2; ++nt)
#pragma unroll
        for (int e = 0; e < 16; ++e) { const int pr = pt * 32 + 8 * (e >> 2) + 4 * h + (e & 3); wt_store(&st[pr * 64 + nt * 32 + c], acc[nt][e]); }
    unit_publish(p.SYNC + l * 2 + 0);
}

__device__ __forceinline__ void b_ssd_scan(const P& p, int l, int vb) {
    unit_wait(p.SYNC + l * 2 + 0, (unsigned)(NB * NCH * 8));
    const int idx = vb * 256 + otid();
    const int e = idx & 4095, dir = (idx >> 12) & 1, head = (idx >> 13) & 7, b = idx >> 16;
    float stv[NCH], dcv[NCH];
#pragma unroll
    for (int k = 0; k < NCH; ++k) {
        const int cc = dir ? (k < 2 ? 1 - k : 35 - k) : k;
        const long base = ((long)(b * NCH + cc) * 8 + head) * 2 + dir;
        stv[k] = p.ST[base * 4096 + e]; dcv[k] = p.DEC[base];
    }
    float hst = 0.f;
#pragma unroll
    for (int k = 0; k < NCH; ++k) {
        const int cc = dir ? (k < 2 ? 1 - k : 35 - k) : k;
        const long base = ((long)(b * NCH + cc) * 8 + head) * 2 + dir;
        { const float oth = __shfl_xor(hst, 1); if ((e & 1) == 0) wt_store((unsigned*)(p.HS + base * 4096 + e), pack_bf16(hst, oth)); }
        hst = dcv[k] * hst + stv[k];
    }
    unit_publish(p.SYNC + l * 2 + 1);
}

__device__ __forceinline__ void b_ssd_out(const P& p, int l, int unit, bf16_t* smem) {
    const int head = unit & 7, cc = (unit >> 3) % NCH, b = unit / (8 * NCH), g = head >> 2;
    const int tok0 = chunk_tok0(b, cc);
    const int tid = otid(), lane = tid & 63, w = tid >> 6, c = lane & 31, h = lane >> 5;
    bf16_t* Cs = smem; bf16_t* Bs = smem + 128 * 72; bf16_t* xT = smem + 2 * 128 * 72;
    float* cumv = (float*)(smem + 2 * 128 * 72 + 64 * XT_STRIDE); float* dtv = cumv + 256;
    __syncthreads();
    const int cpos = cc < 2 ? cc * 128 : (cc - 2) * 128, slen = cc < 2 ? LC : L;
    const int t = 32 * w + c;
    const bf16_t* zp = p.PROJ + (long)(tok0 + t) * PC + P_BZ + head * 64;
    {
        u32x4 rc[8], rb[8], rx[8];
        ssd_conv_load(p, tok0, cpos, slen, 640 + g * 64, rc);
        ssd_conv_load(p, tok0, cpos, slen, 512 + g * 64, rb);
        ssd_dt_cum(p, l, tok0, head, cumv, dtv);
        ssd_conv_apply<false>(p, l, 640 + g * 64, rc, Cs);
        ssd_conv_load(p, tok0, cpos, slen, head * 64, rx);
        ssd_conv_apply<false>(p, l, 512 + g * 64, rb, Bs);
        ssd_conv_apply<true>(p, l, head * 64, rx, xT);
    }
    unit_wait(p.SYNC + l * 2 + 1, (unsigned)(NB * 8 * 2 * 4096 / 256));
    bf16x8 cf[4];
#pragma unroll
    for (int ks = 0; ks < 4; ++ks) cf[ks] = *(const bf16x8*)(Cs + t * 72 + ks * 16 + h * 8);
    f32x16 gT[4];
#pragma unroll
    for (int st = 0; st < 4; ++st) {
#pragma unroll
        for (int e = 0; e < 16; ++e) gT[st][e] = 0.f;
#pragma unroll
        for (int ks = 0; ks < 4; ++ks) {
            const bf16x8 bfr = *(const bf16x8*)(Bs + (st * 32 + c) * 72 + ks * 16 + h * 8);
            gT[st] = __builtin_amdgcn_mfma_f32_32x32x16_bf16(bfr, cf[ks], gT[st], 0, 0, 0);
        }
    }
    f32x16 tot[2];
#pragma unroll
    for (int pt = 0; pt < 2; ++pt)
#pragma unroll
        for (int e = 0; e < 16; ++e) tot[pt][e] = 0.f;
#pragma unroll
    for (int dir = 0; dir < 2; ++dir) {
        const float ct = cumv[dir * 128 + t];
        bf16x8 hsf[4][2];
        {
            const bf16_t* hs = p.HS + (((long)(b * NCH + cc) * 8 + head) * 2 + dir) * 4096;
#pragma unroll
            for (int ks = 0; ks < 4; ++ks)
#pragma unroll
                for (int pt = 0; pt < 2; ++pt) hsf[ks][pt] = *(const bf16x8*)(hs + (pt * 32 + c) * 64 + ks * 16 + h * 8);
        }
#pragma unroll
        for (int st = 0; st < 4; ++st) {
            const bool need = dir ? (st >= w) : (st <= w);
            if (need) {
#pragma unroll
                for (int k2 = 0; k2 < 2; ++k2) {
                    float mv[8];
#pragma unroll
                    for (int j = 0; j < 8; ++j) {
                        const int sidx = st * 32 + 16 * k2 + 8 * (j >> 2) + 4 * h + (j & 3);
                        const float cs = cumv[dir * 128 + sidx], ds = dtv[dir * 128 + sidx];
                        const bool ok = (st != w) || (dir ? (sidx >= t) : (sidx <= t));
                        const float arg = ok ? ct - cs : -__builtin_inff();
                        mv[j] = gT[st][8 * k2 + j] * __expf(arg) * ds;
                    }
                    u32x4 pm; pm[0] = pack_bf16(mv[0], mv[1]); pm[1] = pack_bf16(mv[2], mv[3]); pm[2] = pack_bf16(mv[4], mv[5]); pm[3] = pack_bf16(mv[6], mv[7]);
                    const bf16x8 pmb = __builtin_bit_cast(bf16x8, pm);
#pragma unroll
                    for (int pt = 0; pt < 2; ++pt) {
                        const bf16_t* xr = xT + (pt * 32 + c) * XT_STRIDE + st * 32 + 16 * k2 + 4 * h;
                        const uint2 lo = *(const uint2*)xr, hi = *(const uint2*)(xr + 8);
                        const u32x4 xa = (u32x4){lo.x, lo.y, hi.x, hi.y};
                        tot[pt] = __builtin_amdgcn_mfma_f32_32x32x16_bf16(__builtin_bit_cast(bf16x8, xa), pmb, tot[pt], 0, 0, 0);
                    }
                }
            }
        }
        const float et = __expf(ct);
#pragma unroll
        for (int ks = 0; ks < 4; ++ks) {
            const u32x4 cr = __builtin_bit_cast(u32x4, cf[ks]);
            u32x4 cs4;
#pragma unroll
            for (int e = 0; e < 4; ++e) cs4[e] = pack_bf16(bf2f((bf16_t)(cr[e] & 0xffff)) * et, bf2f((bf16_t)(cr[e] >> 16)) * et);
            const bf16x8 cfs = __builtin_bit_cast(bf16x8, cs4);
#pragma unroll
            for (int pt = 0; pt < 2; ++pt) {
                tot[pt] = __builtin_amdgcn_mfma_f32_32x32x16_bf16(hsf[ks][pt], cfs, tot[pt], 0, 0, 0);
            }
        }
    }
    const float dsk = p.d_skip[(l * 2 + 0) * 8 + head] + p.d_skip[(l * 2 + 1) * 8 + head];
    bf16_t* gp = p.MIXO + (long)(tok0 + t) * D + 256 + head * 64;
    uint2 zr[2][4];
#pragma unroll
    for (int pt = 0; pt < 2; ++pt)
#pragma unroll
        for (int gq = 0; gq < 4; ++gq) zr[pt][gq] = *(const uint2*)(zp + pt * 32 + 8 * gq + 4 * h);
    float ss = 0.f;
#pragma unroll
    for (int pt = 0; pt < 2; ++pt)
#pragma unroll
        for (int gq = 0; gq < 4; ++gq) {
            const int p0 = pt * 32 + 8 * gq + 4 * h;
            const uint2 zq = zr[pt][gq];
            const float zv[4] = {bf2f((bf16_t)(zq.x & 0xffff)), bf2f((bf16_t)(zq.x >> 16)), bf2f((bf16_t)(zq.y & 0xffff)), bf2f((bf16_t)(zq.y >> 16))};
            float gv[4];
#pragma unroll
            for (int e = 0; e < 4; ++e) { const float y = tot[pt][4 * gq + e] + bf2f(xT[(p0 + e) * XT_STRIDE + t]) * dsk; gv[e] = y * siluf(zv[e]); ss += gv[e] * gv[e]; }
            uint2 ov; ov.x = pack_bf16(gv[0], gv[1]); ov.y = pack_bf16(gv[2], gv[3]);
            *(uint2*)(gp + p0) = ov;
        }
    ss += __shfl_xor(ss, 32);
    if (h == 0) p.SSQ[(long)(tok0 + t) * 8 + head] = ss;
}

__device__ __forceinline__ void b_norm2r(const P& p, int l, int vb, bf16_t* smem) {
    const int tid = otid(), wave = tid >> 6, lane = tid & 63;
    constexpr int HST = D + 16;
    bf16_t* Hs = smem;
    float* red = (float*)(smem + 16 * HST);
    float* lgs = red + 4 * 16 * 48;
    __syncthreads();
#pragma unroll 1
    for (int i4 = 0; i4 < 4; ++i4) {
        const int tl = wave * 4 + i4, tok = vb * 16 + tl;
        float v[16];
        const float* src = p.X + (long)tok * D;
#pragma unroll
        for (int i = 0; i < 4; ++i) { const float4 t = *(const float4*)(src + i * 256 + lane * 4); v[i * 4 + 0] = t.x; v[i * 4 + 1] = t.y; v[i * 4 + 2] = t.z; v[i * 4 + 3] = t.w; }
        float ss = 0.f;
#pragma unroll
        for (int i = 0; i < 16; ++i) ss += v[i] * v[i];
        ss = wave_sum(ss);
        const float r = rsqrtf(ss * (1.f / D) + EPS);
        const float* m = p.MOD + ((long)l * 5 + tok_modrow(tok)) * 6 * D;
        const float* nw = p.norm2_w + l * D;
        bf16_t* ho = p.H + (long)tok * D;
#pragma unroll
        for (int i = 0; i < 4; ++i) {
            const int k = i * 256 + lane * 4;
            const float4 w4 = *(const float4*)(nw + k), sc = *(const float4*)(m + 4 * D + k), sh = *(const float4*)(m + 3 * D + k);
            uint2 o;
            o.x = pack_bf16(v[i * 4 + 0] * r * w4.x * (1.f + sc.x) + sh.x, v[i * 4 + 1] * r * w4.y * (1.f + sc.y) + sh.y);
            o.y = pack_bf16(v[i * 4 + 2] * r * w4.z * (1.f + sc.z) + sh.z, v[i * 4 + 3] * r * w4.w * (1.f + sc.w) + sh.w);
            *(uint2*)(ho + k) = o;
            *(uint2*)(Hs + tl * HST + k) = o;
        }
    }
    __syncthreads();
    {
        const int lr = lane & 15, lq = lane >> 4;
        const bf16_t* wr = p.WT_R + ((long)l * 128 + lr) * D + wave * 256 + lq * 8;
        const bf16_t* hr = Hs + lr * HST + wave * 256 + lq * 8;
        f32x4 acc[3];
#pragma unroll
        for (int ni = 0; ni < 3; ++ni) acc[ni] = (f32x4){0.f, 0.f, 0.f, 0.f};
#pragma unroll
        for (int half = 0; half < 2; ++half) {
            bf16x8 wb[4][3];
#pragma unroll
            for (int ks = 0; ks < 4; ++ks)
#pragma unroll
                for (int ni = 0; ni < 3; ++ni) wb[ks][ni] = *(const bf16x8*)(wr + (long)ni * 16 * D + (half * 4 + ks) * 32);
#pragma unroll
            for (int ks = 0; ks < 4; ++ks) {
                const bf16x8 xa = *(const bf16x8*)(hr + (half * 4 + ks) * 32);
#pragma unroll
                for (int ni = 0; ni < 3; ++ni) acc[ni] = __builtin_amdgcn_mfma_f32_16x16x32_bf16(wb[ks][ni], xa, acc[ni], 0, 0, 0);
            }
        }
#pragma unroll
        for (int ni = 0; ni < 3; ++ni) *(f32x4*)(red + (wave * 16 + lr) * 48 + ni * 16 + lq * 4) = acc[ni];
    }
    __syncthreads();
#pragma unroll
    for (int i = 0; i < 3; ++i) {
        const int idx = tid + i * 256, t = idx / 48, j = idx % 48;
        lgs[t * 49 + j] = (red[(0 * 16 + t) * 48 + j] + red[(1 * 16 + t) * 48 + j]) + (red[(2 * 16 + t) * 48 + j] + red[(3 * 16 + t) * 48 + j]);
    }
    __syncthreads();
    if (tid < 16) {
        const int tok = vb * 16 + tid;
        const float* lg = lgs + tid * 49;
        int gs = 0; float gm = lg[0];
#pragma unroll
        for (int j = 1; j < 4; ++j) { const float v = lg[j]; if (v > gm) { gm = v; gs = j; } }
        float den = 0.f;
#pragma unroll
        for (int j = 0; j < 4; ++j) den += expf(lg[j] - gm);
        const float gp = 1.f / den;
        float e0 = -3.4e38f, e1 = -3.4e38f; int i0 = 0, i1 = 0;
#pragma unroll
        for (int j = 0; j < 8; ++j) {
            const float val = lg[4 + gs * 8 + j];
            if (val > e0) { e1 = e0; i1 = i0; e0 = val; i0 = j; }
            else if (val > e1) { e1 = val; i1 = j; }
        }
        const float x1 = expf(e1 - e0), w0 = gp / (1.f + x1), w1 = gp * x1 / (1.f + x1);
        const int ex0 = gs * 8 + i0, ex1 = gs * 8 + i1;
        int* cnt = p.cnt + l * NEXP;
        const int rk0 = atomicAdd(&cnt[ex0], 1); p.list[(long)ex0 * NTOK + rk0] = tok * 2 + 0; p.gatew[tok * 2 + 0] = w0;
        const int rk1 = atomicAdd(&cnt[ex1], 1); p.list[(long)ex1 * NTOK + rk1] = tok * 2 + 1; p.gatew[tok * 2 + 1] = w1;
    }
}

struct MoeTile { int e, mt, cnt, off; };
__device__ __forceinline__ int moe_row_tiles(const int* cnt) { int t = 0; for (int e = 0; e < NEXP; ++e) t += (cnt[e] + 127) >> 7; return t; }
__device__ __forceinline__ MoeTile moe_find_tile(const int* cnt, int tile) {
    MoeTile t; t.e = -1; t.mt = 0; t.cnt = 0; t.off = 0;
    int acc_t = 0, off = 0;
    for (int e = 0; e < NEXP; ++e) {
        const int c = cnt[e], nt = (c + 127) >> 7;
        if (t.e < 0 && tile < acc_t + nt) { t.e = e; t.mt = tile - acc_t; t.cnt = c; t.off = off; }
        acc_t += nt; off += c;
    }
    return t;
}
struct RowGather { const bf16_t* base; const int* lst; int n; __device__ __forceinline__ const bf16_t* operator()(int r) const { return base + (long)(lst[r < n ? r : n - 1] >> 1) * D; } };
struct RowLimit { const bf16_t* base; long ld; int n; __device__ __forceinline__ const bf16_t* operator()(int r) const { return base + (long)(r < n ? r : n - 1) * ld; } };
template <int NI> struct RowGateUp { const bf16_t* wg; const bf16_t* wu; __device__ __forceinline__ const bf16_t* operator()(int n) const {
    const int wn = n / (NI * 16), f = (n >> 4) % NI, j = n & 15, col = wn * (NI * 8) + (f % (NI / 2)) * 16 + j; return wg + (long)(f / (NI / 2)) * (wu - wg) + (long)col * D; } };

template <int NI>
__device__ __forceinline__ void b_moe_up(const P& p, int l, int rt, int h0, bf16_t* smem) {
    const MoeTile t = moe_find_tile(p.cnt + l * NEXP, rt);
    if (t.e < 0) return;
    const int nrow = min(128, t.cnt - t.mt * 128);
    RowGather ra{p.H, p.list + (long)t.e * NTOK + t.mt * 128, nrow};
    const long wofs = (((long)l * NEXP + t.e) * DEXP + h0) * D;
    RowGateUp<NI> rb{p.WT_G + wofs, p.WT_U + wofs};
    bf16_t* out = p.HID + (long)(t.off + t.mt * 128) * DEXP + h0;
    auto epi = [&](const f32x4 (&acc)[4][NI], int wm, int wn, int lr, int lq) {
#pragma unroll
        for (int mi = 0; mi < 4; ++mi) {
            const int r = wm * 64 + mi * 16 + lr;
            if (r < nrow) {
#pragma unroll
                for (int f = 0; f < NI / 2; ++f) {
                    const f32x4 gt = acc[mi][f], up = acc[mi][NI / 2 + f];
                    float hv[4];
#pragma unroll
                    for (int e = 0; e < 4; ++e) hv[e] = siluf(gt[e]) * up[e];
                    uint2 o; o.x = pack_bf16(hv[0], hv[1]); o.y = pack_bf16(hv[2], hv[3]);
                    *(uint2*)(out + (long)r * DEXP + wn * (NI * 8) + f * 16 + lq * 4) = o;
                }
            }
        }
    };
    if constexpr (NI == 8) gemm_tile32<4, 8>(ra, rb, D, smem, epi); else gemm_tile<4, NI>(ra, rb, D, smem, epi);
}

template <int NI>
__device__ __forceinline__ void b_moe_down(const P& p, int l, int rt, int n0, bf16_t* smem) {
    const MoeTile t = moe_find_tile(p.cnt + l * NEXP, rt);
    if (t.e < 0) return;
    const int nrow = min(128, t.cnt - t.mt * 128);
    const int slot0 = t.off + t.mt * 128;
    RowLimit ra{p.HID + (long)slot0 * DEXP, DEXP, nrow};
    RowLin rb{p.WT_D + (((long)l * NEXP + t.e) * D + n0) * DEXP, DEXP};
    const int* lst = p.list + (long)t.e * NTOK + t.mt * 128;
    int asg[4]; float gwv[4];
    {
        const int lane = otid() & 63, w = otid() >> 6;
#pragma unroll
        for (int mi = 0; mi < 4; ++mi) { const int r = (w >> 1) * 64 + mi * 16 + (lane & 15); asg[mi] = lst[r < nrow ? r : nrow - 1]; gwv[mi] = p.gatew[asg[mi]]; }
    }
    auto epi = [&](const f32x4 (&acc)[4][NI], int wm, int wn, int lr, int lq) {
#pragma unroll
        for (int mi = 0; mi < 4; ++mi) {
            const int r = wm * 64 + mi * 16 + lr;
            if (r < nrow) {
                const float gw = gwv[mi];
                if (n0 == 0 && wn == 0 && lq == 0) p.pos[asg[mi]] = slot0 + r;
#pragma unroll
                for (int ni = 0; ni < NI; ++ni) {
                    const int n = n0 + wn * (NI * 16) + ni * 16 + lq * 4;
                    const f32x4 a = acc[mi][ni];
                    uint2 o; o.x = pack_bf16(a[0] * gw, a[1] * gw); o.y = pack_bf16(a[2] * gw, a[3] * gw);
                    *(uint2*)(p.YS + (long)(slot0 + r) * D + n) = o;
                }
            }
        }
    };
    if constexpr (NI == 8) gemm_tile32<4, 8>(ra, rb, DEXP, smem, epi); else gemm_tile<4, NI>(ra, rb, DEXP, smem, epi);
}

__device__ __forceinline__ void b_final(const P& p, int vb) {
    const int wave = otid() >> 6, lane = otid() & 63;
    const int tok = vb * 4 + wave;
    if (tok >= NLAT) return;
    float v[16];
    const float* src = p.X + (long)tok * D;
#pragma unroll
    for (int i = 0; i < 4; ++i) { const float4 t = *(const float4*)(src + i * 256 + lane * 4); v[i * 4 + 0] = t.x; v[i * 4 + 1] = t.y; v[i * 4 + 2] = t.z; v[i * 4 + 3] = t.w; }
    {
        const bf16_t* ys0 = p.YS + (long)p.pos[tok * 2 + 0] * D; const bf16_t* ys1 = p.YS + (long)p.pos[tok * 2 + 1] * D;
        const float* g2 = p.MOD + ((long)(DEPTH - 1) * 5 + tok_modrow(tok)) * 6 * D + 5 * D;
#pragma unroll
        for (int i = 0; i < 4; ++i) {
            const uint2 t = *(const uint2*)(ys0 + i * 256 + lane * 4), u = *(const uint2*)(ys1 + i * 256 + lane * 4);
            const float4 g = *(const float4*)(g2 + i * 256 + lane * 4);
            v[i * 4 + 0] += (bf2f((bf16_t)(t.x & 0xffff)) + bf2f((bf16_t)(u.x & 0xffff))) * g.x; v[i * 4 + 1] += (bf2f((bf16_t)(t.x >> 16)) + bf2f((bf16_t)(u.x >> 16))) * g.y;
            v[i * 4 + 2] += (bf2f((bf16_t)(t.y & 0xffff)) + bf2f((bf16_t)(u.y & 0xffff))) * g.z; v[i * 4 + 3] += (bf2f((bf16_t)(t.y >> 16)) + bf2f((bf16_t)(u.y >> 16))) * g.w;
        }
    }
    float ss = 0.f;
#pragma unroll
    for (int i = 0; i < 16; ++i) ss += v[i] * v[i];
    ss = wave_sum(ss);
    const float r = rsqrtf(ss * (1.f / D) + EPS);
    float* o = p.out + (long)tok * D;
#pragma unroll
    for (int i = 0; i < 4; ++i) { const float4 w = *(const float4*)(p.final_w + i * 256 + lane * 4);
        *(float4*)(o + i * 256 + lane * 4) = make_float4(v[i * 4 + 0] * r * w.x, v[i * 4 + 1] * r * w.y, v[i * 4 + 2] * r * w.z, v[i * 4 + 3] * r * w.w); }
}


#define XB_TMO      128
#define XB_XCNT(j)  (256  + 64 * (j))
#define XB_XSUB(j)  (1280 + 64 * (j))
#define XB_XGEN(j)  (2304 + 64 * (j))
#define XB_TOP      3328
#define XB_TOPGEN   3392
#define XCD_BAR_WORDS 3456
#define XB_SPIN_CAP (1u << 22)
__device__ __forceinline__ unsigned xb_ld(unsigned* p)              { return __hip_atomic_load(p, __ATOMIC_RELAXED, __HIP_MEMORY_SCOPE_AGENT); }
__device__ __forceinline__ unsigned xb_add(unsigned* p, unsigned v) { return __hip_atomic_fetch_add(p, v, __ATOMIC_RELAXED, __HIP_MEMORY_SCOPE_AGENT); }
__device__ __forceinline__ unsigned xb_xcc_id() { return (unsigned)__builtin_amdgcn_s_getreg((3 << 11) | 20) & 0xFu; }
#define XB_SPIN(cond, bar) do { unsigned _sp = 0; while (cond) { __builtin_amdgcn_s_sleep(1); \
    if ((++_sp & 255u) == 0u) { if (xb_ld(&(bar)[XB_TMO])) break; if (_sp > XB_SPIN_CAP) { atomicAdd(&(bar)[XB_TMO], 1u); break; } } } } while (0)
struct XcdBarrier { unsigned* bar; unsigned x; volatile LAS unsigned* st; };
__device__ __forceinline__ XcdBarrier xcd_barrier_post(unsigned* bar, volatile LAS unsigned* st) {
    XcdBarrier b; b.bar = bar; b.x = xb_xcc_id(); b.st = st;
    if (threadIdx.x == 0) (void)xb_add(&bar[XB_XCNT(b.x)], 1u);
    return b;
}
__device__ __forceinline__ void xcd_barrier_complete(unsigned* bar, unsigned x, unsigned& nloc, unsigned& nx) {
    const unsigned G = gridDim.x * gridDim.y * gridDim.z;
    unsigned sum, cnt, mine, sp = 0u;
    for (;;) {
        sum = 0u; cnt = 0u; mine = 0u;
#pragma unroll
        for (unsigned j = 0; j < 16; ++j) { const unsigned c = xb_ld(&bar[XB_XCNT(j)]); sum += c; cnt += (c > 0u) ? 1u : 0u; mine = (j == x) ? c : mine; }
        if (sum == G) break;
        __builtin_amdgcn_s_sleep(1);
        if ((++sp & 255u) == 0u) { if (xb_ld(&bar[XB_TMO])) break; if (sp > XB_SPIN_CAP) { atomicAdd(&bar[XB_TMO], 1u); break; } }
    }
    nloc = mine > 0u ? mine : 1u; nx = cnt > 0u ? cnt : 1u;
}
__device__ __forceinline__ void xcd_barrier(const XcdBarrier& b) {
    asm volatile("s_waitcnt vmcnt(0)" ::: "memory");
    __syncthreads();
    if (threadIdx.x == 0) {
        unsigned* bar = b.bar;
        __builtin_amdgcn_s_waitcnt(0);
        unsigned bx = __builtin_amdgcn_readfirstlane(b.x); asm volatile("" : "+s"(bx));
        unsigned nloc = b.st[0], nx = b.st[1];
        if (nloc == 0u) { xcd_barrier_complete(bar, bx, nloc, nx); b.st[0] = nloc; b.st[1] = nx; }
        const unsigned old = xb_add(&bar[XB_XSUB(bx)], 1u);
        const unsigned gen = old / nloc;
        if (old + 1u == (gen + 1u) * nloc) {
            __builtin_amdgcn_fence(__ATOMIC_RELEASE, "agent");
            asm volatile("s_waitcnt vmcnt(0)" ::: "memory");
            const unsigned og = xb_add(&bar[XB_TOP], 1u);
            const unsigned tg = og / nx;
            if (og + 1u == (tg + 1u) * nx) xb_add(&bar[XB_TOPGEN], 1u);
            else XB_SPIN(xb_ld(&bar[XB_TOPGEN]) == tg, bar);
            __builtin_amdgcn_fence(__ATOMIC_ACQUIRE, "agent");
            xb_add(&bar[XB_XGEN(bx)], 1u);
            asm volatile("s_waitcnt vmcnt(0)" ::: "memory");
        } else {
            XB_SPIN(xb_ld(&bar[XB_XGEN(bx)]) == gen, bar);
            __builtin_amdgcn_fence(__ATOMIC_ACQUIRE, "agent");
            asm volatile("s_waitcnt vmcnt(0)" ::: "memory");
        }
    }
    __syncthreads();
}

#define FOR_VB(n) for (int vb = blockIdx.x; vb < (n); vb += gridDim.x)
#define FOR_VB_XCD(n) for (int _ch = ((n) + 7) >> 3, _j = (int)blockIdx.x >> 3, vb = ((int)blockIdx.x & 7) * _ch + _j; _j < _ch; _j += (int)gridDim.x >> 3, vb += (int)gridDim.x >> 3) if (vb < (n))
#define FOR_VB_OFF(n, off) for (int vb = (int)((blockIdx.x + gridDim.x - ((off) % gridDim.x)) % gridDim.x); vb < (n); vb += gridDim.x)
__global__ void __launch_bounds__(256, 2) k_mega(P p) {
    extern __shared__ __attribute__((aligned(16))) unsigned char dynlds[];
    bf16_t* smem = (bf16_t*)dynlds;
    uint4* xbw = (uint4*)(dynlds + SMEM_BYTES);
    float (*tt)[65] = (float (*)[65])smem;
    if (threadIdx.x == 0) *xbw = make_uint4(0u, 0u, 0u, 0u);
    __syncthreads();
    const XcdBarrier xb = xcd_barrier_post(p.bar, (volatile LAS unsigned*)xbw);
    if (threadIdx.x == 0) {
        const unsigned key = (xb.x << 8) | ((unsigned)__builtin_amdgcn_s_getreg((7 << 11) | (8 << 6) | 4) & 0xFFu);
        ((volatile LAS unsigned*)xbw)[4] = xb_add(&p.cuslot[key], 1u) & 1u;
    }
    __syncthreads();
    const int slot = __builtin_amdgcn_readfirstlane((int)((volatile LAS unsigned*)xbw)[4]);
    if (blockIdx.x == 0 && otid() < DEPTH * NEXP) p.cnt[otid()] = 0;
    if (blockIdx.x == 1 && otid() < DEPTH * NB * 10) p.KMAX[otid()] = 0u;
    if (blockIdx.x == 2) for (int i = otid(); i < SY_LAYER + DEPTH * SY_STRIDE; i += 256) p.SYNC[i] = 0u;
    FOR_VB(6) b_rope_table(p, vb);
    FOR_VB(DEPTH * 6 * D / 64) b_mod(p, vb, (float*)smem);
    __syncthreads();
    constexpr int CI1 = 28 * 16 / 4, CI2 = 12 * 16 / 4, CVO = (D / 64) * (D / 64) / 4;
    auto prep_in = [&](int bz, int off) {
        FOR_VB_OFF(CI1, off) b_convT_stream(bz * CI1 + vb, p.w_in, p.WT_IN, D, 1792, nullptr, IN_COLS, 0, 0, (long)D * IN_COLS, (long)PCW * D);
        FOR_VB_OFF(CI2, off + CI1) b_convT_stream(bz * CI2 + vb, p.w_in, p.WT_IN, D, 768, nullptr, IN_COLS, 1808, 1792, (long)D * IN_COLS, (long)PCW * D);
        FOR_VB_OFF(16, off + CI1 + CI2) b_convT(tt, 0, vb, bz, p.w_in, p.WT_IN, D, IN_COLS, OLD_BDT, 16, PC, (long)D * IN_COLS, (long)PCW * D);
    };
    prep_in(0, 384);
    FOR_VB_OFF(1 * 16 * DEPTH, 48) b_convT(tt, 0, vb % 16, vb / 16, p.w_grouter, p.WT_R, D, 4, 0, 4, 0, (long)D * 4, (long)128 * D);
    FOR_VB_OFF(1 * 16 * DEPTH, 112) b_convT(tt, 0, vb % 16, vb / 16, p.w_router, p.WT_R, D, 32, 0, 32, 4, (long)D * 32, (long)128 * D);
    xcd_barrier(xb);
    for (int l = 0; l < DEPTH; ++l) {
        const bool last = (l == DEPTH - 1);
        const int ntok = last ? NLAT : NTOK;
        FOR_VB(NTOK / 16) b_norm1(p, l, vb);
        {
            constexpr int NT = PCW / 128, MPX = (NTOK / 128) / 8, CH = MPX * NT, M0 = (MPX + 1) / 2, M1 = MPX - M0;
            for (int j = (int)blockIdx.x >> 3; j < CH; j += (int)gridDim.x >> 3) {
                const int jj = j < M0 * NT ? j : j - M0 * NT, mh = j < M0 * NT ? M0 : M1, m = (j < M0 * NT ? 0 : M0) + jj % mh, n = jj / mh;
                b_inproj(p, l, (((int)blockIdx.x & 7) * MPX + m) * NT + n, smem);
            }
        }
        xcd_barrier(xb);
        {
            const int nst = NB * NCH * 8, nsc = NB * 8 * 2 * 4096 / 256;
            const int ncu = NB * 4 * (L / 128) + (last ? 0 : NB * 4 * 2);
            FOR_VB_OFF(nst, 0) b_ssd_states(p, l, vb, smem);
            constexpr int CVL = NEXP * (D / 64) * (DEXP / 64) / 4;
#pragma unroll 1
            for (int step = 0; step < 2; ++step) {
                if ((step ^ slot) == 0) {
                    FOR_VB_OFF(ncu, nst) b_attnC(p, l, vb, smem);
                } else {
                    for (int vb = l * CVL + (int)blockIdx.x; vb < (l + 1) * CVL; vb += (int)gridDim.x) b_convT_stream(vb, p.w_gate, p.WT_G, D, DEXP);
                    for (int vb = l * CVL + (int)blockIdx.x; vb < (l + 1) * CVL; vb += (int)gridDim.x) b_convT_stream(vb, p.w_up, p.WT_U, D, DEXP);
                    for (int vb = l * CVL + (int)blockIdx.x; vb < (l + 1) * CVL; vb += (int)gridDim.x) b_convT_stream(vb, p.w_down, p.WT_D, DEXP, D);
                    FOR_VB_OFF(CVO, 192) b_convT_stream(l * CVO + vb, p.w_out, p.WT_OUT, D, D, p.b_norm_w);
                    if (l + 1 < DEPTH) prep_in(l + 1, 192 + CVO);
                }
                if (step == 0) { FOR_VB_OFF(nsc, nst + ncu) b_ssd_scan(p, l, vb); }
            }
            FOR_VB_OFF(ncu, nst + nsc + ncu) b_attnA(p, l, vb, smem);
            FOR_VB_OFF(nst, nst + nsc + 2 * ncu) { if (last && ((vb >> 3) % NCH) < 2) continue; b_ssd_out(p, l, vb, smem); }
        }
        xcd_barrier(xb);
        {
            const int ch = (ntok / 128) * (D / 128) / 8, bpx = (int)gridDim.x >> 3, j = (int)blockIdx.x >> 3, xc = (int)blockIdx.x & 7;
            const int rem = ch % bpx, nfull = (rem * 8 <= bpx) ? ch - rem : ch;
            for (int t = j; t < nfull; t += bpx) { const int vb = xc * ch + t; b_outproj<4, 4>(p, l, (vb >> 3) * 128, (vb & 7) * 128, smem); }
            for (int q = j; q < (ch - nfull) * 8; q += bpx) { const int vb = xc * ch + nfull + (q >> 3), sub = q & 7; b_outproj<2, 1>(p, l, (vb >> 3) * 128 + (sub >> 2) * 64, (vb & 7) * 128 + (sub & 3) * 32, smem); }
        }
        xcd_barrier(xb);
        FOR_VB(ntok / 16) b_norm2r(p, l, vb, smem);
        xcd_barrier(xb);
        const int nbig = moe_row_tiles(p.cnt + l * NEXP) * 4, mch = (nbig + 7) >> 3, bpx = (int)gridDim.x >> 3, mj = (int)blockIdx.x >> 3;
        const int mlo = ((int)blockIdx.x & 7) * mch, mcnt = max(min(mlo + mch, nbig) - mlo, 0), mrem = mcnt % bpx;
        const int msplit = (mrem == 0) ? 1 : (mrem * 4 <= bpx) ? 4 : (mrem * 2 <= bpx) ? 2 : 1, mfull = msplit > 1 ? mcnt - mrem : mcnt;
        for (int t = mj; t < mfull; t += bpx) { const int bt = mlo + t; b_moe_up<8>(p, l, bt >> 2, (bt & 3) * 128, smem); }
        if (msplit == 4) { for (int q = mj; q < mrem * 4; q += bpx) { const int bt = mlo + mfull + (q >> 2); b_moe_up<2>(p, l, bt >> 2, (bt & 3) * 128 + (q & 3) * 32, smem); } }
        else if (msplit == 2) { for (int q = mj; q < mrem * 2; q += bpx) { const int bt = mlo + mfull + (q >> 1); b_moe_up<4>(p, l, bt >> 2, (bt & 3) * 128 + (q & 1) * 64, smem); } }
        xcd_barrier(xb);
        for (int t = mj; t < mfull; t += bpx) { const int bt = mlo + t; b_moe_down<8>(p, l, bt >> 2, (bt & 3) * 256, smem); }
        if (msplit == 4) { for (int q = mj; q < mrem * 4; q += bpx) { const int bt = mlo + mfull + (q >> 2); b_moe_down<2>(p, l, bt >> 2, (bt & 3) * 256 + (q & 3) * 64, smem); } }
        else if (msplit == 2) { for (int q = mj; q < mrem * 2; q += bpx) { const int bt = mlo + mfull + (q >> 1); b_moe_down<4>(p, l, bt >> 2, (bt & 3) * 256 + (q & 1) * 128, smem); } }
        xcd_barrier(xb);
    }
    FOR_VB(NLAT / 4) b_final(p, vb);
}

extern "C" void kernel_launch(void* const* d_in, const int* in_sizes, int n_in, void* d_out, int out_size, void* d_ws, size_t ws_size, hipStream_t stream) {
    P p{};
    const float** f = (const float**)&p;
    for (int i = 0; i < 25; ++i) f[i] = (const float*)d_in[i];
    p.out = (float*)d_out;
    char* w = (char*)d_ws; size_t off = 0;
    auto take = [&](size_t bytes) { char* r = w + off; off += (bytes + 255) & ~(size_t)255; return r; };
    p.X = (float*)take((size_t)NTOK * D * 4);
    p.MOD = (float*)take((size_t)DEPTH * 5 * 6 * D * 4);
    p.DT = (float*)take((size_t)NTOK * 16 * 4);
    p.SSQ = (float*)take((size_t)NTOK * 8 * 4);
    p.SYNC = (unsigned*)take((size_t)(SY_LAYER + DEPTH * SY_STRIDE) * 4);
    p.ST = (float*)take((size_t)NB * NCH * 16 * 4096 * 4);
    p.DEC = (float*)take((size_t)NB * NCH * 16 * 4);
    p.HS = (bf16_t*)take((size_t)NB * NCH * 16 * 4096 * 2);
    p.gatew = (float*)take((size_t)NTOK * 2 * 4);
    p.H = (bf16_t*)take((size_t)NTOK * D * 2);
    p.PROJ = (bf16_t*)take((size_t)NTOK * PC * 2);
    p.WT_IN = (bf16_t*)take((size_t)DEPTH * PCW * D * 2);
    p.WT_R = (bf16_t*)take((size_t)DEPTH * 128 * D * 2);
    p.WT_OUT = (bf16_t*)take((size_t)DEPTH * D * D * 2);
    p.WT_G = (bf16_t*)take((size_t)DEPTH * NEXP * DEXP * D * 2);
    p.WT_U = (bf16_t*)take((size_t)DEPTH * NEXP * DEXP * D * 2);
    p.WT_D = (bf16_t*)take((size_t)DEPTH * NEXP * DEXP * D * 2);
    p.MIXO = (bf16_t*)take((size_t)NTOK * D * 2);
    p.HID = (bf16_t*)take((size_t)(NTOK * 2 + 128) * DEXP * 2);
    p.YS = (bf16_t*)take((size_t)(NTOK * 2 + 128) * D * 2);
    p.cnt = (int*)take((size_t)DEPTH * NEXP * 4);
    p.list = (int*)take((size_t)NEXP * NTOK * 4);
    p.pos = (int*)take((size_t)NTOK * 2 * 4);
    p.VT = (bf16_t*)take((size_t)NB * 4 * 64 * NKEY * 2);
    p.VTA = (bf16_t*)take((size_t)NB * 2 * 64 * NKEY * 2);
    p.bar = (unsigned*)take((size_t)(XCD_BAR_WORDS + 4096) * 4); p.cuslot = p.bar + XCD_BAR_WORDS;
    p.ROPE = (float*)take((size_t)64 * 24 * 2 * 4);
    p.KMAX = (unsigned*)take((size_t)DEPTH * NB * 10 * 4);
    if (off > ws_size) { fprintf(stderr, "workspace too small: need %zu have %zu\n", off, ws_size); return; }

    (void)hipMemsetAsync(p.bar, 0, (XCD_BAR_WORDS + 4096) * 4, stream);
    static int grid_blocks = 0;
    if (!grid_blocks) {
        int dev = 0, cus = 0, per_cu = 0;
        (void)hipGetDevice(&dev);
        (void)hipDeviceGetAttribute(&cus, hipDeviceAttributeMultiprocessorCount, dev);
        if (hipFuncSetAttribute((const void*)k_mega, hipFuncAttributeMaxDynamicSharedMemorySize, LDS_BYTES) != hipSuccess) fprintf(stderr, "hipFuncSetAttribute(LDS %d) failed\n", LDS_BYTES);
        (void)hipOccupancyMaxActiveBlocksPerMultiprocessor(&per_cu, k_mega, 256, LDS_BYTES);
        if (per_cu > 2) per_cu = 2;
        grid_blocks = cus * per_cu;
    }
    void* args[] = {&p};
    hipError_t e = hipLaunchCooperativeKernel((void*)k_mega, dim3(grid_blocks), dim3(256), args, LDS_BYTES, stream);
    if (e != hipSuccess) fprintf(stderr, "cooperative launch failed: %s (grid %d)\n", hipGetErrorString(e), grid_blocks);
}
```

```cpp
#include <hip/hip_runtime.h>
#include <cstdio>
#include <cstdint>

typedef unsigned short bf16_t;
typedef short bf16x8 __attribute__((ext_vector_type(8)));
typedef float f32x4 __attribute__((ext_vector_type(4)));
typedef unsigned u32x4 __attribute__((ext_vector_type(4)));
typedef float f32x16 __attribute__((ext_vector_type(16)));

constexpr int D = 1024, NB = 4, L = 4096, LC = 256, NLAT = NB * L, NCTX = NB * LC, NTOK = NLAT + NCTX, DEPTH = 4;
constexpr int IN_COLS = 2576, OLD_BDT = 1792;
constexpr int PC = 2560;
constexpr int PCW = 2688;
constexpr int P_AQ = 0, P_AK = 256, P_AV = 384, P_BZ = 512, P_BX = 1024, P_CQ = 1792, P_CK = 2048, P_CV = 2304;
constexpr int NEXP = 32, DEXP = 512;
constexpr int NKEY = L + LC;
constexpr int NKT = NKEY / 64;
constexpr float EPS = 1e-6f;

__device__ __forceinline__ int otid() { int t = threadIdx.x; asm volatile("" : "+v"(t)); return t; }
typedef __bf16 bf16n2 __attribute__((ext_vector_type(2)));
__device__ __forceinline__ bf16_t f2bf(float f) { return __builtin_bit_cast(bf16_t, (__bf16)f); }
__device__ __forceinline__ unsigned pack_bf16(float a, float b) { const bf16n2 v = {(__bf16)a, (__bf16)b}; return __builtin_bit_cast(unsigned, v); }
__device__ __forceinline__ float bf2f(bf16_t h) { return __uint_as_float(((unsigned)h) << 16); }
__device__ __forceinline__ float wave_sum(float v) {
#pragma unroll
    for (int o = 32; o > 0; o >>= 1) v += __shfl_xor(v, o);
    return v;
}
__device__ __forceinline__ float siluf(float v) { return v * __builtin_amdgcn_rcpf(1.f + __expf(-v)); }
__device__ __forceinline__ int tok_modrow(int tok) { return tok < NLAT ? tok / L : NB; }

struct P {
    const float *x, *c, *ctx, *c_ctx, *w_mod, *b_mod, *norm1_w, *norm2_w, *w_in, *w_out, *a_sink, *conv_w, *conv_b, *dt_bias, *a_log, *d_skip,
        *b_norm_w, *c_lambda, *c_subln_w, *w_grouter, *w_router, *w_gate, *w_up, *w_down, *final_w;
    float* out;
    float* X; float* MOD; float* DT; float* SSQ; float* gatew; float* ST; float* DEC; float* ROPE;
    bf16_t *H, *PROJ, *WT_IN, *WT_OUT, *WT_G, *WT_U, *WT_D, *MIXO, *HID, *YS, *VT, *VTA, *HS, *WT_R;
    int *cnt, *list, *pos;
    unsigned* bar; unsigned* cuslot;
    unsigned* SYNC;
    unsigned* KMAX;
};

__device__ __forceinline__ void b_convT(float (*t)[65], int bx, int by, int bz, const float* __restrict__ src, bf16_t* __restrict__ dst, int K, int ld_src, int c0, int ncols, int n_dst0,
                                        long src_bstride, long dst_bstride) {
    src += (long)bz * src_bstride; dst += (long)bz * dst_bstride;
    const int kb = by * 64, nb = bx * 64, tid = otid();
    const int c4 = (tid & 15) * 4, kr0 = tid >> 4;
#pragma unroll
    for (int i = 0; i < 4; ++i) {
        const int kr = kr0 + i * 16;
        float4 v = make_float4(0.f, 0.f, 0.f, 0.f);
        if (nb + c4 < ncols) v = *(const float4*)(src + (long)(kb + kr) * ld_src + c0 + nb + c4);
        t[kr][c4] = v.x; t[kr][c4 + 1] = v.y; t[kr][c4 + 2] = v.z; t[kr][c4 + 3] = v.w;
    }
    __syncthreads();
    const int n = tid >> 2, kq = (tid & 3) * 16;
    if (nb + n < ncols) {
        unsigned o[8];
#pragma unroll
        for (int j = 0; j < 8; ++j) o[j] = (unsigned)f2bf(t[kq + 2 * j][n]) | ((unsigned)f2bf(t[kq + 2 * j + 1][n]) << 16);
        bf16_t* d = dst + (long)(n_dst0 + nb + n) * K + kb + kq;
        *(u32x4*)d = (u32x4){o[0], o[1], o[2], o[3]};
        *(u32x4*)(d + 8) = (u32x4){o[4], o[5], o[6], o[7]};
    }
    __syncthreads();
}

__device__ __forceinline__ void b_convT_stream(int vb, const float* __restrict__ src, bf16_t* __restrict__ dst, int K, int N, const float* rowscale = nullptr,
                                               int ld_src = 0, int c0 = 0, int n_dst0 = 0, long src_ms = 0, long dst_ms = 0) {
    const int tid = otid(), lane = tid & 63;
    const int gw = vb * 4 + (tid >> 6);
    const int nbs = N >> 6, kbs = K >> 6;
    const int mat = gw / (nbs * kbs), r = gw % (nbs * kbs), kb = r / nbs, nb = r % nbs;
    const int kq = lane & 3, n4l = lane >> 2;
    if (ld_src == 0) { ld_src = N; src_ms = (long)K * N; dst_ms = (long)K * N; }
    const float* sp = src + mat * src_ms + (long)(kb * 64 + kq * 8) * ld_src + c0 + nb * 64 + n4l * 4;
    float4 v[16];
#pragma unroll
    for (int j = 0; j < 16; ++j) v[j] = *(const float4*)(sp + (long)((j & 7) + (j >> 3) * 32) * ld_src);
    if (rowscale) {
        const int k0 = kb * 64 + kq * 8;
        if (k0 >= 256 && k0 < 768) {
#pragma unroll
            for (int j = 0; j < 16; ++j) { const float sc = rowscale[mat * 512 + k0 - 256 + (j & 7) + (j >> 3) * 32]; v[j].x *= sc; v[j].y *= sc; v[j].z *= sc; v[j].w *= sc; }
        }
    }
    bf16_t* dp = dst + mat * dst_ms + (long)(n_dst0 + nb * 64 + n4l * 4) * K + kb * 64 + kq * 8;
    u32x4 o0, o1;
#pragma unroll
    for (int j = 0; j < 4; ++j) { o0[j] = pack_bf16(v[2 * j].x, v[2 * j + 1].x); o1[j] = pack_bf16(v[8 + 2 * j].x, v[8 + 2 * j + 1].x); }
    *(u32x4*)dp = o0; *(u32x4*)(dp + 32) = o1;
#pragma unroll
    for (int j = 0; j < 4; ++j) { o0[j] = pack_bf16(v[2 * j].y, v[2 * j + 1].y); o1[j] = pack_bf16(v[8 + 2 * j].y, v[8 + 2 * j + 1].y); }
    *(u32x4*)(dp + K) = o0; *(u32x4*)(dp + K + 32) = o1;
#pragma unroll
    for (int j = 0; j < 4; ++j) { o0[j] = pack_bf16(v[2 * j].z, v[2 * j + 1].z); o1[j] = pack_bf16(v[8 + 2 * j].z, v[8 + 2 * j + 1].z); }
    *(u32x4*)(dp + 2 * K) = o0; *(u32x4*)(dp + 2 * K + 32) = o1;
#pragma unroll
    for (int j = 0; j < 4; ++j) { o0[j] = pack_bf16(v[2 * j].w, v[2 * j + 1].w); o1[j] = pack_bf16(v[8 + 2 * j].w, v[8 + 2 * j + 1].w); }
    *(u32x4*)(dp + 3 * K) = o0; *(u32x4*)(dp + 3 * K + 32) = o1;
}

__device__ __forceinline__ void b_rope_table(const P& p, int vb) {
    const int idx = vb * 256 + otid();
    if (idx >= 64 * 24) return;
    const int pos = idx / 24, f = idx % 24;
    const float fr = f < 16 ? __expf(-(float)f * (1.f / 16.f) * 9.210340371976184f) : __expf(-(float)(f - 16) * (1.f / 8.f) * 9.210340371976184f);
    float sn, cs; sincosf((float)pos * fr, &sn, &cs);
    p.ROPE[idx * 2] = cs; p.ROPE[idx * 2 + 1] = sn;
}

__device__ __forceinline__ void b_mod(const P& p, int vb, float* red) {
    const int tid = otid(), lane = tid & 63, kq = tid >> 6, ks = lane >> 4, c4 = (lane & 15) * 4;
    const int idx = vb * 64 + c4;
    const int l = idx / (6 * D), n = idx % (6 * D);
    float acc[5][4];
#pragma unroll
    for (int r = 0; r < 5; ++r)
#pragma unroll
        for (int e = 0; e < 4; ++e) acc[r][e] = 0.f;
    const float* w = p.w_mod + (long)l * D * 6 * D + n;
#pragma unroll 8
    for (int k = kq * 256 + ks; k < kq * 256 + 256; k += 4) {
        const float4 wv = *(const float4*)(w + (long)k * 6 * D);
#pragma unroll
        for (int r = 0; r < 5; ++r) {
            const float cv = siluf((r < 4) ? p.c[r * D + k] : p.c_ctx[k]);
            acc[r][0] += cv * wv.x; acc[r][1] += cv * wv.y; acc[r][2] += cv * wv.z; acc[r][3] += cv * wv.w;
        }
    }
#pragma unroll
    for (int r = 0; r < 5; ++r)
#pragma unroll
        for (int e = 0; e < 4; ++e) { float v = acc[r][e]; v += __shfl_xor(v, 16); v += __shfl_xor(v, 32); acc[r][e] = v; }
    __syncthreads();
    if (ks == 0) {
#pragma unroll
        for (int r = 0; r < 5; ++r) *(float4*)(red + (kq * 5 + r) * 64 + c4) = make_float4(acc[r][0], acc[r][1], acc[r][2], acc[r][3]);
    }
    __syncthreads();
    if (tid < 64) {
        const int col = tid, i2 = vb * 64 + col, n2 = i2 % (6 * D);
        const float bv = p.b_mod[l * 6 * D + n2];
#pragma unroll
        for (int r = 0; r < 5; ++r) p.MOD[((long)l * 5 + r) * 6 * D + n2] = ((red[(0 * 5 + r) * 64 + col] + red[(1 * 5 + r) * 64 + col]) + (red[(2 * 5 + r) * 64 + col] + red[(3 * 5 + r) * 64 + col])) + bv;
    }
}

__device__ __forceinline__ void wt_store(float* ptr, float v) { __hip_atomic_store(ptr, v, __ATOMIC_RELAXED, __HIP_MEMORY_SCOPE_AGENT); }
__device__ __forceinline__ void wt_store(unsigned* ptr, unsigned v) { __hip_atomic_store(ptr, v, __ATOMIC_RELAXED, __HIP_MEMORY_SCOPE_AGENT); }
__device__ __forceinline__ void wt_store8(void* ptr, unsigned lo, unsigned hi) { __hip_atomic_store((unsigned long long*)ptr, ((unsigned long long)hi << 32) | lo, __ATOMIC_RELAXED, __HIP_MEMORY_SCOPE_AGENT); }
__device__ __forceinline__ void unit_publish(unsigned* cnt) {
    asm volatile("s_waitcnt vmcnt(0)" ::: "memory");
    __syncthreads();
    if (threadIdx.x == 0) (void)__hip_atomic_fetch_add(cnt, 1u, __ATOMIC_RELAXED, __HIP_MEMORY_SCOPE_AGENT);
}
__device__ __forceinline__ void unit_wait(unsigned* cnt, unsigned target) {
    if (threadIdx.x == 0) {
        unsigned sp = 0;
        while (__hip_atomic_load(cnt, __ATOMIC_RELAXED, __HIP_MEMORY_SCOPE_AGENT) < target) { __builtin_amdgcn_s_sleep(2); if (++sp > (1u << 24)) break; }
        __builtin_amdgcn_fence(__ATOMIC_ACQUIRE, "agent");
        asm volatile("s_waitcnt vmcnt(0)" ::: "memory");
    }
    __syncthreads();
}

__device__ __forceinline__ void unit_wait_nf(unsigned* cnt, unsigned target) {
    if (threadIdx.x == 0) {
        unsigned sp = 0;
        while (__hip_atomic_load(cnt, __ATOMIC_RELAXED, __HIP_MEMORY_SCOPE_AGENT) < target) { __builtin_amdgcn_s_sleep(2); if (++sp > (1u << 24)) break; }
    }
    __syncthreads();
    asm volatile("" ::: "memory");
}
constexpr int SY_LAYER = 64, SY_STRIDE = 1024, SY_N1 = 0, SY_OP = 136, SY_N2 = 272, SY_UP = 408;
__device__ __forceinline__ unsigned* sync_ctr(const P& p, int l, int which, int idx) { return p.SYNC + SY_LAYER + l * SY_STRIDE + which + idx; }

__device__ __forceinline__ void b_norm1(const P& p, int l, int vb) {
    const int wave = otid() >> 6, lane = otid() & 63;
#pragma unroll 1
    for (int i4 = 0; i4 < 4; ++i4) {
        const int tok = vb * 16 + wave * 4 + i4;
        float v[16];
        const float* src = (l == 0) ? (tok < NLAT ? p.x + (long)tok * D : p.ctx + (long)(tok - NLAT) * D) : p.X + (long)tok * D;
#pragma unroll
        for (int i = 0; i < 4; ++i) { const float4 t = *(const float4*)(src + i * 256 + lane * 4); v[i * 4 + 0] = t.x; v[i * 4 + 1] = t.y; v[i * 4 + 2] = t.z; v[i * 4 + 3] = t.w; }
        if (l > 0) {
            const bf16_t* ys0 = p.YS + (long)p.pos[tok * 2 + 0] * D; const bf16_t* ys1 = p.YS + (long)p.pos[tok * 2 + 1] * D;
            const float* g2 = p.MOD + ((long)(l - 1) * 5 + tok_modrow(tok)) * 6 * D + 5 * D;
#pragma unroll
            for (int i = 0; i < 4; ++i) {
                const uint2 t = *(const uint2*)(ys0 + i * 256 + lane * 4), u = *(const uint2*)(ys1 + i * 256 + lane * 4);
                const float4 g = *(const float4*)(g2 + i * 256 + lane * 4);
                v[i * 4 + 0] += (bf2f((bf16_t)(t.x & 0xffff)) + bf2f((bf16_t)(u.x & 0xffff))) * g.x; v[i * 4 + 1] += (bf2f((bf16_t)(t.x >> 16)) + bf2f((bf16_t)(u.x >> 16))) * g.y;
                v[i * 4 + 2] += (bf2f((bf16_t)(t.y & 0xffff)) + bf2f((bf16_t)(u.y & 0xffff))) * g.z; v[i * 4 + 3] += (bf2f((bf16_t)(t.y >> 16)) + bf2f((bf16_t)(u.y >> 16))) * g.w;
            }
        }
        float* xo = p.X + (long)tok * D;
#pragma unroll
        for (int i = 0; i < 4; ++i) *(float4*)(xo + i * 256 + lane * 4) = make_float4(v[i * 4 + 0], v[i * 4 + 1], v[i * 4 + 2], v[i * 4 + 3]);
        float ss = 0.f;
#pragma unroll
        for (int i = 0; i < 16; ++i) ss += v[i] * v[i];
        ss = wave_sum(ss);
        const float r = rsqrtf(ss * (1.f / D) + EPS);
        const float* m = p.MOD + ((long)l * 5 + tok_modrow(tok)) * 6 * D;
        const float* nw = p.norm1_w + l * D;
        bf16_t* ho = p.H + (long)tok * D;
#pragma unroll
        for (int i = 0; i < 4; ++i) {
            const int k = i * 256 + lane * 4;
            const float4 w4 = *(const float4*)(nw + k), sc = *(const float4*)(m + D + k), sh = *(const float4*)(m + k);
            wt_store8(ho + k, pack_bf16(v[i * 4 + 0] * r * w4.x * (1.f + sc.x) + sh.x, v[i * 4 + 1] * r * w4.y * (1.f + sc.y) + sh.y),
                              pack_bf16(v[i * 4 + 2] * r * w4.z * (1.f + sc.z) + sh.z, v[i * 4 + 3] * r * w4.w * (1.f + sc.w) + sh.w));
        }
    }
    unit_publish(sync_ctr(p, l, SY_N1, vb >> 3));
}

#define LAS __attribute__((address_space(3)))
constexpr int LDS_STRIDE = 72;
constexpr int SMEM_BYTES = 65536;
constexpr int LDS_BYTES = SMEM_BYTES + 256;
struct NoHook { template <class A> __device__ __forceinline__ void operator()(int, A&) const {} };
template <int MI = 4, int NI = 4, class RowA, class RowB, class Epi, class Hook = NoHook>
__device__ __forceinline__ void gemm_tile(const RowA& ra, const RowB& rb, int K, bf16_t* smem, const Epi& epi, const Hook& hook = Hook()) {
    LAS unsigned char* lds = (LAS unsigned char*)smem;
    const int tid = otid(), lane = tid & 63, w = __builtin_amdgcn_readfirstlane(tid >> 6), wm = w >> 1, wn = w & 1, lr = lane & 15, lq = lane >> 4;
    f32x4 acc[MI][NI];
#pragma unroll
    for (int i = 0; i < MI; ++i)
#pragma unroll
        for (int j = 0; j < NI; ++j) acc[i][j] = (f32x4){0.f, 0.f, 0.f, 0.f};
    const bf16_t* pa[MI]; const bf16_t* pb[NI];
    const int kcs = ((lane & 7) ^ ((lane >> 3) & 7)) * 8;
#pragma unroll
    for (int i = 0; i < MI; ++i) pa[i] = ra((i * 4 + w) * 8 + (lane >> 3)) + kcs;
#pragma unroll
    for (int i = 0; i < NI; ++i) pb[i] = rb((i * 4 + w) * 8 + (lane >> 3)) + kcs;
    auto stage = [&](int buf, int k0) {
#pragma unroll
        for (int i = 0; i < MI; ++i) __builtin_amdgcn_global_load_lds((const unsigned*)(pa[i] + k0), (LAS unsigned*)(lds + buf * 32768 + (i * 4 + w) * 1024), 16, 0, 0);
#pragma unroll
        for (int i = 0; i < NI; ++i) __builtin_amdgcn_global_load_lds((const unsigned*)(pb[i] + k0), (LAS unsigned*)(lds + buf * 32768 + 16384 + (i * 4 + w) * 1024), 16, 0, 0);
    };
    const int aoff = (wm * MI * 16 + lr) * 128 + ((lq ^ (lr & 7)) << 4), boff = 16384 + (wn * NI * 16 + lr) * 128 + ((lq ^ (lr & 7)) << 4);
    const int nk = K >> 6;
    __syncthreads();
    stage(0, 0);
    for (int kt = 0; kt < nk; ++kt) {
        asm volatile("s_waitcnt vmcnt(0)" ::: "memory");
        __syncthreads();
        if (kt + 1 < nk) stage((kt + 1) & 1, (kt + 1) * 64);
        hook(kt, acc);
        const LAS unsigned char* bs = lds + (kt & 1) * 32768;
#pragma unroll
        for (int ks = 0; ks < 2; ++ks) {
            bf16x8 xa[MI], wb[NI];
#pragma unroll
            for (int i = 0; i < MI; ++i) xa[i] = *(const LAS bf16x8*)(bs + (aoff ^ (ks << 6)) + i * 2048);
#pragma unroll
            for (int i = 0; i < NI; ++i) wb[i] = *(const LAS bf16x8*)(bs + (boff ^ (ks << 6)) + i * 2048);
#pragma unroll
            for (int mi = 0; mi < MI; ++mi)
#pragma unroll
                for (int ni = 0; ni < NI; ++ni) acc[mi][ni] = __builtin_amdgcn_mfma_f32_16x16x32_bf16(wb[ni], xa[mi], acc[mi][ni], 0, 0, 0);
        }
    }
    epi(acc, wm, wn, lr, lq);
}

template <int MI, int NI, class RowA, class RowB, class Epi>
__device__ __forceinline__ void gemm_tile32(const RowA& ra, const RowB& rb, int K, bf16_t* smem, const Epi& epi) {
    LAS unsigned char* lds = (LAS unsigned char*)smem;
    const int tid = otid(), lane = tid & 63, w = __builtin_amdgcn_readfirstlane(tid >> 6), wm = w >> 1, wn = w & 1, lr = lane & 15, lq = lane >> 4;
    constexpr int ABYTES = MI * 32 * 64, STG = (MI + NI) * 32 * 64, PA = MI / 2, PB = NI / 2;
    f32x4 acc[MI][NI];
#pragma unroll
    for (int i = 0; i < MI; ++i)
#pragma unroll
        for (int j = 0; j < NI; ++j) acc[i][j] = (f32x4){0.f, 0.f, 0.f, 0.f};
    const bf16_t* pa[PA]; const bf16_t* pb[PB];
    const int kcs = ((lane & 3) ^ ((4 - ((lane >> 4) & 3)) & 3)) * 8;
#pragma unroll
    for (int i = 0; i < PA; ++i) pa[i] = ra((i * 4 + w) * 16 + (lane >> 2)) + kcs;
#pragma unroll
    for (int i = 0; i < PB; ++i) pb[i] = rb((i * 4 + w) * 16 + (lane >> 2)) + kcs;
    auto stage = [&](int buf, int k0) {
#pragma unroll
        for (int i = 0; i < PA; ++i) __builtin_amdgcn_global_load_lds((const unsigned*)(pa[i] + k0), (LAS unsigned*)(lds + buf * STG + (i * 4 + w) * 1024), 16, 0, 0);
#pragma unroll
        for (int i = 0; i < PB; ++i) __builtin_amdgcn_global_load_lds((const unsigned*)(pb[i] + k0), (LAS unsigned*)(lds + buf * STG + ABYTES + (i * 4 + w) * 1024), 16, 0, 0);
    };
    const int fsw = (lq ^ ((4 - ((lr >> 2) & 3)) & 3)) << 4;
    const int aoff = (wm * MI * 16 + lr) * 64 + fsw, boff = ABYTES + (wn * NI * 16 + lr) * 64 + fsw;
    const int nk = K >> 5;
    __syncthreads();
    stage(0, 0);
    for (int kt = 0; kt < nk; ++kt) {
        asm volatile("s_waitcnt vmcnt(0)" ::: "memory");
        __syncthreads();
        if (kt + 1 < nk) stage((kt + 1) & 1, (kt + 1) * 32);
        const LAS unsigned char* bs = lds + (kt & 1) * STG;
        bf16x8 xa[MI], wb[NI];
#pragma unroll
        for (int i = 0; i < MI; ++i) xa[i] = *(const LAS bf16x8*)(bs + aoff + i * 1024);
#pragma unroll
        for (int i = 0; i < NI; ++i) wb[i] = *(const LAS bf16x8*)(bs + boff + i * 1024);
#pragma unroll
        for (int mi = 0; mi < MI; ++mi)
#pragma unroll
            for (int ni = 0; ni < NI; ++ni) acc[mi][ni] = __builtin_amdgcn_mfma_f32_16x16x32_bf16(wb[ni], xa[mi], acc[mi][ni], 0, 0, 0);
    }
    epi(acc, wm, wn, lr, lq);
}

struct RowLin { const bf16_t* base; long ld; __device__ __forceinline__ const bf16_t* operator()(int r) const { return base + (long)r * ld; } };

__device__ __forceinline__ void b_inproj(const P& p, int l, int vb, bf16_t* smem) {
    const int mt = vb / (PCW / 128), nt = vb % (PCW / 128);
    RowLin ra{p.H + (long)mt * 128 * D, D}, rb{p.WT_IN + ((long)l * PCW + nt * 128) * D, D};
    unit_wait_nf(sync_ctr(p, l, SY_N1, mt), 8u);
    const bool latent = mt < NLAT / 128;
    const int kind = (nt == 20) ? 3 : (nt == 3 || nt == 18 || nt == 19) ? 2 : (latent && nt <= 2) ? 0 : (latent && nt >= 14 && nt <= 17) ? 1 : 4;
    constexpr int OS = 136;
    auto epi = [&](f32x4 (&acc)[4][4], int wm, int wn, int lr, int lq) {
        if (kind == 3) {
            if (wn == 0) {
#pragma unroll
                for (int mi = 0; mi < 4; ++mi) *(f32x4*)(p.DT + (long)(mt * 128 + wm * 64 + mi * 16 + lr) * 16 + lq * 4) = acc[mi][0];
            }
            return;
        }
        if (nt == 2 || nt == 16 || nt == 17) {
            const int b = latent ? mt / (L / 128) : (mt - NLAT / 128) / (LC / 128);
#pragma unroll
            for (int half = 0; half < 2; ++half) {
                float mxv = 0.f;
#pragma unroll
                for (int mi = 0; mi < 4; ++mi) {
                    float ssq = 0.f;
#pragma unroll
                    for (int n2 = 0; n2 < 2; ++n2)
#pragma unroll
                        for (int e = 0; e < 4; ++e) { const float v = acc[mi][2 * half + n2][e]; ssq += v * v; }
                    ssq += __shfl_xor(ssq, 16); ssq += __shfl_xor(ssq, 32);
                    mxv = fmaxf(mxv, ssq);
                }
                if (nt == 2) {
                    const float other = mxv;
                    (void)other;
                }
                if (nt != 2) {
#pragma unroll
                    for (int o = 1; o < 16; o <<= 1) mxv = fmaxf(mxv, __shfl_xor(mxv, o));
                    if ((otid() & 63) == 0) atomicMax(&p.KMAX[(l * NB + b) * 10 + (nt - 16) * 4 + wn * 2 + half], __float_as_uint(mxv));
                }
            }
            if (nt == 2) {
                float mxv = 0.f;
#pragma unroll
                for (int mi = 0; mi < 4; ++mi) {
                    float ssq = 0.f;
#pragma unroll
                    for (int ni = 0; ni < 4; ++ni)
#pragma unroll
                        for (int e = 0; e < 4; ++e) { const float v = acc[mi][ni][e]; ssq += v * v; }
                    ssq += __shfl_xor(ssq, 16); ssq += __shfl_xor(ssq, 32);
                    mxv = fmaxf(mxv, ssq);
                }
#pragma unroll
                for (int o = 1; o < 16; o <<= 1) mxv = fmaxf(mxv, __shfl_xor(mxv, o));
                if ((otid() & 63) == 0) atomicMax(&p.KMAX[(l * NB + b) * 10 + 8 + wn], __float_as_uint(mxv));
            }
        }
        if (kind == 0) {
#pragma unroll
            for (int mi = 0; mi < 4; ++mi) {
                const int i = (mt * 128 + wm * 64 + mi * 16 + lr) & (L - 1);
#pragma unroll
                for (int hf = 0; hf < 2; ++hf) {
                    const int pos = hf ? (i & 63) : (i >> 6);
                    const float* tb = p.ROPE + (pos * 24 + lq * 4) * 2;
                    const f32x4 t0 = *(const f32x4*)tb, t1 = *(const f32x4*)(tb + 4);
                    const float cs[4] = {t0[0], t0[2], t1[0], t1[2]}, sn[4] = {t0[1], t0[3], t1[1], t1[3]};
#pragma unroll
                    for (int e = 0; e < 4; ++e) {
                        const float u1 = acc[mi][2 * hf][e], u2 = acc[mi][2 * hf + 1][e];
                        acc[mi][2 * hf][e] = u1 * cs[e] - u2 * sn[e]; acc[mi][2 * hf + 1][e] = u1 * sn[e] + u2 * cs[e];
                    }
                }
            }
        } else if (kind == 1) {
#pragma unroll
            for (int mi = 0; mi < 4; ++mi) {
                const int i = (mt * 128 + wm * 64 + mi * 16 + lr) & (L - 1);
#pragma unroll
                for (int hf = 0; hf < 2; ++hf) {
                    const int pos = hf ? (i & 63) : (i >> 6);
                    const float* tb = p.ROPE + (pos * 24 + 16 + (lq & 1) * 4) * 2;
                    const f32x4 t0 = *(const f32x4*)tb, t1 = *(const f32x4*)(tb + 4);
                    const float cs[4] = {t0[0], t0[2], t1[0], t1[2]}, sn[4] = {t0[1], t0[3], t1[1], t1[3]};
#pragma unroll
                    for (int n2 = 0; n2 < 2; ++n2) {
                        const int ni = 2 * n2 + hf;
#pragma unroll
                        for (int e = 0; e < 4; ++e) {
                            const float v = acc[mi][ni][e], pv = __shfl_xor(v, 32);
                            acc[mi][ni][e] = lq < 2 ? v * cs[e] - pv * sn[e] : pv * sn[e] + v * cs[e];
                        }
                    }
                }
            }
        }
        __syncthreads();
        if (kind == 2) {
#pragma unroll
            for (int mi = 0; mi < 4; ++mi) {
                const int m = wm * 64 + mi * 16 + lr, mp = (m & ~12) | ((m & 4) << 1) | ((m & 8) >> 1);
#pragma unroll
                for (int ni = 0; ni < 4; ++ni)
#pragma unroll
                    for (int e = 0; e < 4; ++e) smem[(wn * 64 + ni * 16 + lq * 4 + e) * OS + mp] = f2bf(acc[mi][ni][e]);
            }
        } else {
#pragma unroll
            for (int mi = 0; mi < 4; ++mi)
#pragma unroll
                for (int ni = 0; ni < 4; ++ni) {
                    const f32x4 a = acc[mi][ni];
                    uint2 o; o.x = pack_bf16(a[0], a[1]); o.y = pack_bf16(a[2], a[3]);
                    *(uint2*)(smem + (wm * 64 + mi * 16 + lr) * OS + wn * 64 + ni * 16 + lq * 4) = o;
                }
        }
        __syncthreads();
        const int tid = otid();
        if (kind == 2) {
            const int nh = nt == 3 ? 2 : 4, hbase = nt == 3 ? 0 : (nt - 18) * 2;
            bf16_t* vtb = nt == 3 ? p.VTA : p.VT;
            const int b = latent ? mt / (L / 128) : (mt - NLAT / 128) / (LC / 128);
            const int key0 = latent ? (mt % (L / 128)) * 128 : L + ((mt - NLAT / 128) % (LC / 128)) * 128;
#pragma unroll
            for (int i2 = 0; i2 < 8; ++i2) {
                const int idx = tid + i2 * 256, n = idx >> 4, mc = (idx & 15) * 8;
                const u32x4 v = *(const u32x4*)(smem + n * OS + mc);
                *(u32x4*)(vtb + ((long)(b * nh + hbase + (n >> 6)) * 64 + (n & 63)) * NKEY + key0 + mc) = v;
            }
        } else {
            bf16_t* out = p.PROJ + (long)mt * 128 * PC + nt * 128;
#pragma unroll
            for (int i2 = 0; i2 < 8; ++i2) {
                const int idx = tid + i2 * 256, m = idx >> 4, nc = (idx & 15) * 8;
                *(u32x4*)(out + (long)m * PC + nc) = *(const u32x4*)(smem + m * OS + nc);
            }
        }
    };
    gemm_tile(ra, rb, D, smem, epi);
}

template <int MI, int NI>
__device__ __forceinline__ void b_outproj(const P& p, int l, int row0, int col0, bf16_t* smem) {
    RowLin ra{p.MIXO + (long)row0 * D, D}, rb{p.WT_OUT + ((long)l * D + col0) * D, D};
    auto epi = [&](const f32x4 (&acc)[MI][NI], int wm, int wn, int lr, int lq) {
#pragma unroll
        for (int mi = 0; mi < MI; ++mi) {
            const int tok = row0 + wm * MI * 16 + mi * 16 + lr;
            const float* g1 = p.MOD + ((long)l * 5 + tok_modrow(tok)) * 6 * D + 2 * D;
#pragma unroll
            for (int ni = 0; ni < NI; ++ni) {
                const int n = col0 + wn * NI * 16 + ni * 16 + lq * 4;
                const float4 g = *(const float4*)(g1 + n);
                float4* xp = (float4*)(p.X + (long)tok * D + n);
                float4 xv = *xp; const f32x4 a = acc[mi][ni];
                xv.x += g.x * a[0]; xv.y += g.y * a[1]; xv.z += g.z * a[2]; xv.w += g.w * a[3];
                *xp = xv;
            }
        }
    };
    float rs0[MI], rs1[MI];
    {
        const int lane = otid() & 63, w = otid() >> 6, wm0 = w >> 1, lr0 = lane & 15;
#pragma unroll
        for (int mi = 0; mi < MI; ++mi) {
            const float* sq = p.SSQ + (long)(row0 + wm0 * MI * 16 + mi * 16 + lr0) * 8;
            const f32x4 s0 = *(const f32x4*)sq, s1 = *(const f32x4*)(sq + 4);
            rs0[mi] = rsqrtf(((s0[0] + s0[1]) + (s0[2] + s0[3])) * (1.f / 256.f) + EPS); rs1[mi] = rsqrtf(((s1[0] + s1[1]) + (s1[2] + s1[3])) * (1.f / 256.f) + EPS);
        }
    }
    auto hook = [&](int kt, f32x4 (&acc)[MI][NI]) {
        if (kt == 4 || kt == 8 || kt == 12) {
#pragma unroll
            for (int mi = 0; mi < MI; ++mi) {
                const float f = kt == 4 ? 1.f / rs0[mi] : kt == 8 ? rs0[mi] / rs1[mi] : rs1[mi];
#pragma unroll
                for (int ni = 0; ni < NI; ++ni) acc[mi][ni] *= f;
            }
        }
    };
    gemm_tile<MI, NI>(ra, rb, D, smem, epi, hook);
}


__device__ __forceinline__ void b_attnC(const P& p, int l, int unit, bf16_t* smem) {
    const int tid = otid(), lane = tid & 63, w = tid >> 6, c = lane & 31, h = lane >> 5;
    const bool ctxq = unit >= NB * 4 * (L / 128);
    int b, hh, qb;
    if (!ctxq) { qb = unit & 31; hh = (unit >> 5) & 3; b = unit >> 7; }
    else { const int u = unit - NB * 4 * (L / 128); qb = u & 1; hh = (u >> 1) & 3; b = u >> 3; }
    const int tokq = (ctxq ? NLAT + b * LC : b * L) + qb * 128 + w * 32 + c;
    const int t0 = ctxq ? 64 : 0, nt = ctxq ? 4 : NKT;
    const float lambda_init = 0.8f - 0.6f * expf(-0.3f * (float)l);
    const float* cl = p.c_lambda + l * 128;
    const float d1 = wave_sum(h == 0 ? cl[c] * cl[32 + c] : 0.f), d2 = wave_sum(h == 0 ? cl[64 + c] * cl[96 + c] : 0.f);
    const float lam = expf(d1) - expf(d2) + lambda_init;
    bf16x8 qf[2][2];
    {
        const float qs = 0.17677669529663687f * 1.4426950408889634f;
        const bf16_t* qp = p.PROJ + (long)tokq * PC + P_CQ + hh * 64;
#pragma unroll
        for (int m = 0; m < 2; ++m)
#pragma unroll
            for (int s2 = 0; s2 < 2; ++s2) {
                const u32x4 raw = *(const u32x4*)(qp + m * 32 + s2 * 16 + h * 8);
                u32x4 sc;
#pragma unroll
                for (int e = 0; e < 4; ++e) sc[e] = pack_bf16(bf2f((bf16_t)(raw[e] & 0xffff)) * qs, bf2f((bf16_t)(raw[e] >> 16)) * qs);
                qf[m][s2] = __builtin_bit_cast(bf16x8, sc);
            }
    }
    LAS unsigned char* lds = (LAS unsigned char*)smem;
    const bf16_t* vtb = p.VT + (long)(b * 4 + hh) * 64 * NKEY;
    const int wu = __builtin_amdgcn_readfirstlane(w);
    int srow[2], schk[2];
#pragma unroll
    for (int i = 0; i < 2; ++i) { srow[i] = (wu * 2 + i) * 8 + (lane >> 3); schk[i] = ((lane & 7) ^ ((srow[i] >> 1) & 7)) * 8; }
    auto dma = [&](int buf, int t) {
        const int tok0 = t < 64 ? b * L + t * 64 : NLAT + b * LC + (t - 64) * 64;
#pragma unroll
        for (int i = 0; i < 2; ++i) {
            __builtin_amdgcn_global_load_lds((const unsigned*)(p.PROJ + (long)(tok0 + srow[i]) * PC + P_CK + hh * 64 + schk[i]), (LAS unsigned*)(lds + buf * 16384 + (wu * 2 + i) * 1024), 16, 0, 0);
            __builtin_amdgcn_global_load_lds((const unsigned*)(vtb + (long)srow[i] * NKEY + t * 64 + schk[i]), (LAS unsigned*)(lds + buf * 16384 + 8192 + (wu * 2 + i) * 1024), 16, 0, 0);
        }
    };
    f32x16 o[2][2];
#pragma unroll
    for (int m = 0; m < 2; ++m)
#pragma unroll
        for (int dt = 0; dt < 2; ++dt)
#pragma unroll
            for (int e = 0; e < 16; ++e) o[m][dt][e] = 0.f;
    float negm[2];
    float lsum[2] = {0.f, 0.f};
#pragma unroll
    for (int m = 0; m < 2; ++m) {
        float qn = 0.f;
#pragma unroll
        for (int s2 = 0; s2 < 2; ++s2) { const u32x4 qq = __builtin_bit_cast(u32x4, qf[m][s2]);
#pragma unroll
            for (int e = 0; e < 4; ++e) { const float a = bf2f((bf16_t)(qq[e] & 0xffff)), bq = bf2f((bf16_t)(qq[e] >> 16)); qn += a * a + bq * bq; } }
        qn += __shfl_xor(qn, 32);
        const float km = __uint_as_float(p.KMAX[(l * NB + b) * 10 + hh * 2 + m]);
        negm[m] = -sqrtf(qn * km);
    }
    f32x16 negv;
    { const float nm = fminf(negm[0], negm[1]);
#pragma unroll
      for (int e = 0; e < 16; ++e) negv[e] = nm; }
    const int swz = (c >> 1) & 7;
    const int krow = c * 128, fo0 = ((0 + h) ^ swz) << 4, fo1 = ((2 + h) ^ swz) << 4, fo2 = ((4 + h) ^ swz) << 4, fo3 = ((6 + h) ^ swz) << 4;
    __syncthreads();
    dma(0, t0);
    for (int it = 0; it < nt; ++it) {
        asm volatile("s_waitcnt vmcnt(0)" ::: "memory");
        __syncthreads();
        if (it + 1 < nt) dma((it + 1) & 1, t0 + it + 1);
        const LAS unsigned char* Ks = lds + (it & 1) * 16384; const LAS unsigned char* Vs = Ks + 8192;
        auto qk = [&](int sub, int m) -> f32x16 {
            const LAS unsigned char* kr = Ks + sub * 4096 + krow;
            const bf16x8 k0 = *(const LAS bf16x8*)(kr + (m ? fo2 : fo0)), k1 = *(const LAS bf16x8*)(kr + (m ? fo3 : fo1));
            const f32x16 sa = __builtin_amdgcn_mfma_f32_32x32x16_bf16(k0, qf[m][0], negv, 0, 0, 0);
            return __builtin_amdgcn_mfma_f32_32x32x16_bf16(k1, qf[m][1], sa, 0, 0, 0);
        };
        f32x16 sa = qk(0, 0);
        bf16x8 vf[2][2];
#pragma unroll
        for (int j = 0; j < 4; ++j) {
            const int sub = j >> 1, m = j & 1;
            if (m == 0) {
#pragma unroll
                for (int dt = 0; dt < 2; ++dt) {
                    const LAS unsigned char* vr = Vs + dt * 4096 + krow;
                    vf[dt][0] = *(const LAS bf16x8*)(vr + (sub ? fo2 : fo0)); vf[dt][1] = *(const LAS bf16x8*)(vr + (sub ? fo3 : fo1));
                }
            }
            f32x16 san;
            if (j < 3) san = qk((j + 1) >> 1, (j + 1) & 1);
            float ps = 0.f;
            u32x4 a0, a1;
#pragma unroll
            for (int e = 0; e < 4; ++e) {
                const float p0 = __builtin_amdgcn_exp2f(sa[2 * e]), p1 = __builtin_amdgcn_exp2f(sa[2 * e + 1]);
                const float p2 = __builtin_amdgcn_exp2f(sa[8 + 2 * e]), p3 = __builtin_amdgcn_exp2f(sa[8 + 2 * e + 1]);
                ps = (((ps + p0) + p1) + p2) + p3;
                a0[e] = pack_bf16(p0, p1); a1[e] = pack_bf16(p2, p3);
            }
            lsum[m] += ps; asm volatile("" : "+v"(lsum[m]));
            const bf16x8 pk0 = __builtin_bit_cast(bf16x8, a0), pk1 = __builtin_bit_cast(bf16x8, a1);
#pragma unroll
            for (int dt = 0; dt < 2; ++dt) {
                o[m][dt] = __builtin_amdgcn_mfma_f32_32x32x16_bf16(vf[dt][0], pk0, o[m][dt], 0, 0, 0);
                o[m][dt] = __builtin_amdgcn_mfma_f32_32x32x16_bf16(vf[dt][1], pk1, o[m][dt], 0, 0, 0);
            }
            if (j < 3) sa = san;
            __builtin_amdgcn_sched_barrier(0);
        }
    }
    __syncthreads();
    const float l0 = lsum[0] + __shfl_xor(lsum[0], 32), l1 = lsum[1] + __shfl_xor(lsum[1], 32);
    const float c0 = 1.f / l0, c1 = -lam / l1;
    float ss = 0.f;
#pragma unroll
    for (int dt = 0; dt < 2; ++dt)
#pragma unroll
        for (int e = 0; e < 16; ++e) { const float v = o[0][dt][e] * c0 + o[1][dt][e] * c1; o[0][dt][e] = v; ss += v * v; }
    ss += __shfl_xor(ss, 32);
    const float r = rsqrtf(ss * (1.f / 64.f) + EPS) * (1.f - lambda_init);
    bf16_t* op = p.MIXO + (long)tokq * D + 768 + hh * 64;
    int lw = l * 64; asm volatile("" : "+v"(lw));
#pragma unroll
    for (int dt = 0; dt < 2; ++dt)
#pragma unroll
        for (int g = 0; g < 4; ++g) {
            const int dv = dt * 32 + 8 * g + 4 * h;
            const float4 wv = *(const float4*)(p.c_subln_w + lw + dv);
            uint2 ov; ov.x = pack_bf16(o[0][dt][4 * g + 0] * r * wv.x, o[0][dt][4 * g + 1] * r * wv.y);
            ov.y = pack_bf16(o[0][dt][4 * g + 2] * r * wv.z, o[0][dt][4 * g + 3] * r * wv.w);
            *(uint2*)(op + dv) = ov;
        }
}


__device__ __forceinline__ void b_attnA(const P& p, int l, int unit, bf16_t* smem) {
    const int tid = otid(), lane = tid & 63, w = tid >> 6, c = lane & 31, h = lane >> 5;
    const bool ctxq = unit >= NB * 4 * (L / 128);
    int b, hd, qb;
    if (!ctxq) { qb = unit & 31; hd = (unit >> 5) & 3; b = unit >> 7; }
    else { const int u = unit - NB * 4 * (L / 128); qb = u & 1; hd = (u >> 1) & 3; b = u >> 3; }
    const int kvh = hd >> 1;
    const int q0 = qb * 128 + w * 32, iq = q0 + c;
    const int tokq = (ctxq ? NLAT + b * LC : b * L) + iq;
    const int tl0 = ctxq ? 0 : max(0, 2 * qb - 2), tl1 = ctxq ? -1 : min(63, 2 * qb + 3), nloc = tl1 - tl0 + 1, nt = nloc + 4;
    bf16x8 qf[4];
    {
        const float qs = 0.125f * 1.4426950408889634f;
        const bf16_t* qp = p.PROJ + (long)tokq * PC + P_AQ + hd * 64;
#pragma unroll
        for (int s2 = 0; s2 < 4; ++s2) {
            const u32x4 raw = *(const u32x4*)(qp + s2 * 16 + h * 8);
            u32x4 sc;
#pragma unroll
            for (int e = 0; e < 4; ++e) sc[e] = pack_bf16(bf2f((bf16_t)(raw[e] & 0xffff)) * qs, bf2f((bf16_t)(raw[e] >> 16)) * qs);
            qf[s2] = __builtin_bit_cast(bf16x8, sc);
        }
    }
    const bf16_t* vtb = p.VTA + (long)(b * 2 + kvh) * 64 * NKEY;
    const int srow0 = tid >> 3, sch = (tid & 7) * 8;
    u32x4 rk[2], rv[2];
    auto tile_of = [&](int it) { return it < nloc ? tl0 + it : 64 + (it - nloc); };
    auto gload = [&](int t) {
        const int tok0 = t < 64 ? b * L + t * 64 : NLAT + b * LC + (t - 64) * 64;
#pragma unroll
        for (int i = 0; i < 2; ++i) {
            rk[i] = *(const u32x4*)(p.PROJ + (long)(tok0 + srow0 + i * 32) * PC + P_AK + kvh * 64 + sch);
            rv[i] = *(const u32x4*)(vtb + (long)(srow0 + i * 32) * NKEY + t * 64 + sch);
        }
    };
    auto lstore = [&](int buf) {
        bf16_t* Ks = smem + buf * (2 * 64 * 72); bf16_t* Vs = Ks + 64 * 72;
#pragma unroll
        for (int i = 0; i < 2; ++i) { *(u32x4*)(Ks + (srow0 + i * 32) * 72 + sch) = rk[i]; *(u32x4*)(Vs + (srow0 + i * 32) * 72 + sch) = rv[i]; }
    };
    f32x16 o[2];
#pragma unroll
    for (int dt = 0; dt < 2; ++dt)
#pragma unroll
        for (int e = 0; e < 16; ++e) o[dt][e] = 0.f;
    f32x16 negm; float lsum;
    {
        float qn = 0.f;
#pragma unroll
        for (int s2 = 0; s2 < 4; ++s2) { const u32x4 qq = __builtin_bit_cast(u32x4, qf[s2]);
#pragma unroll
            for (int e = 0; e < 4; ++e) { const float a = bf2f((bf16_t)(qq[e] & 0xffff)), bq = bf2f((bf16_t)(qq[e] >> 16)); qn += a * a + bq * bq; } }
        qn += __shfl_xor(qn, 32);
        const float km = __uint_as_float(p.KMAX[(l * NB + b) * 10 + 8 + kvh]);
        const float sk = p.a_sink[l * 4 + hd] * 1.4426950408889634f;
        const float mb = fmaxf(sqrtf(qn * km), sk);
#pragma unroll
        for (int e = 0; e < 16; ++e) negm[e] = -mb;
        lsum = h == 0 ? __builtin_amdgcn_exp2f(sk - mb) : 0.f;
    }
    __syncthreads();
    gload(tile_of(0)); lstore(0);
    __syncthreads();
    for (int it = 0; it < nt; ++it) {
        if (it + 1 < nt) gload(tile_of(it + 1));
        const int t = tile_of(it);
        const bool local = t < 64;
        const bf16_t* Ks = smem + (it & 1) * (2 * 64 * 72); const bf16_t* Vs = Ks + 64 * 72;
#pragma unroll
        for (int sub = 0; sub < 2; ++sub) {
            const int j0 = t * 64 + sub * 32;
            if (local && (j0 + 31 < q0 - 128 || j0 > q0 + 31 + 128)) continue;
            f32x16 sa = negm;
#pragma unroll
            for (int s2 = 0; s2 < 4; ++s2) {
                const bf16x8 kf = *(const bf16x8*)(Ks + (sub * 32 + c) * 72 + s2 * 16 + h * 8);
                sa = __builtin_amdgcn_mfma_f32_32x32x16_bf16(kf, qf[s2], sa, 0, 0, 0);
            }
            if (local) {
#pragma unroll
                for (int e = 0; e < 16; ++e) { const int j = j0 + 8 * (e >> 2) + 4 * h + (e & 3); const int dj = j - iq; if (dj > 128 || dj < -128) sa[e] = -INFINITY; }
            }
            float ps = 0.f;
            u32x4 a0, a1;
#pragma unroll
            for (int e = 0; e < 4; ++e) {
                const float p0 = __builtin_amdgcn_exp2f(sa[2 * e]), p1 = __builtin_amdgcn_exp2f(sa[2 * e + 1]);
                const float p2 = __builtin_amdgcn_exp2f(sa[8 + 2 * e]), p3 = __builtin_amdgcn_exp2f(sa[8 + 2 * e + 1]);
                ps += (p0 + p1) + (p2 + p3);
                a0[e] = pack_bf16(p0, p1); a1[e] = pack_bf16(p2, p3);
            }
            lsum += ps;
            const bf16x8 pk0 = __builtin_bit_cast(bf16x8, a0), pk1 = __builtin_bit_cast(bf16x8, a1);
#pragma unroll
            for (int dt = 0; dt < 2; ++dt) {
                const bf16x8 v0 = *(const bf16x8*)(Vs + (dt * 32 + c) * 72 + sub * 32 + h * 8);
                const bf16x8 v1 = *(const bf16x8*)(Vs + (dt * 32 + c) * 72 + sub * 32 + 16 + h * 8);
                o[dt] = __builtin_amdgcn_mfma_f32_32x32x16_bf16(v0, pk0, o[dt], 0, 0, 0);
                o[dt] = __builtin_amdgcn_mfma_f32_32x32x16_bf16(v1, pk1, o[dt], 0, 0, 0);
            }
        }
        if (it + 1 < nt) lstore((it + 1) & 1);
        __syncthreads();
    }
    const float inv = 1.f / (lsum + __shfl_xor(lsum, 32));
    bf16_t* op = p.MIXO + (long)tokq * D + hd * 64;
#pragma unroll
    for (int dt = 0; dt < 2; ++dt)
#pragma unroll
        for (int g = 0; g < 4; ++g) {
            uint2 ov; ov.x = pack_bf16(o[dt][4 * g + 0] * inv, o[dt][4 * g + 1] * inv); ov.y = pack_bf16(o[dt][4 * g + 2] * inv, o[dt][4 * g + 3] * inv);
            *(uint2*)(op + dt * 32 + 8 * g + 4 * h) = ov;
        }
}

constexpr int NCH = 34;
constexpr int XT_STRIDE = 136;
__device__ __forceinline__ int chunk_tok0(int b, int cc) { return cc < 2 ? NLAT + b * LC + cc * 128 : b * L + (cc - 2) * 128; }
__device__ __forceinline__ float softplusf(float v) { return fmaxf(v, 0.f) + log1pf(expf(-fabsf(v))); }

__device__ __forceinline__ void ssd_dt_cum(const P& p, int l, int tok0, int head, float* cumv, float* dtv) {
    const int lane = otid() & 63, w = otid() >> 6;
    if (w < 2) {
        const int dir = w;
        const float a = -expf(p.a_log[(l * 2 + dir) * 8 + head]), dtb = p.dt_bias[(l * 2 + dir) * 8 + head];
        const int k0 = 2 * lane, k1 = 2 * lane + 1, i0 = dir ? 127 - k0 : k0, i1 = dir ? 127 - k1 : k1;
        const float dt0 = softplusf(p.DT[(long)(tok0 + i0) * 16 + dir * 8 + head] + dtb), dt1 = softplusf(p.DT[(long)(tok0 + i1) * 16 + dir * 8 + head] + dtb);
        const float la0 = dt0 * a, la1 = dt1 * a;
        float sc = la0 + la1;
#pragma unroll
        for (int off = 1; off < 64; off <<= 1) { const float t = __shfl_up(sc, off); if (lane >= off) sc += t; }
        const float excl = sc - (la0 + la1);
        cumv[dir * 128 + i0] = excl + la0; cumv[dir * 128 + i1] = excl + la0 + la1;
        dtv[dir * 128 + i0] = dt0; dtv[dir * 128 + i1] = dt1;
    }
}
__device__ __forceinline__ void ssd_conv_load(const P& p, int tok0, int cpos, int len, int col0, u32x4 (&raw)[8]) {
    const int tid = otid(), ch8 = (tid & 7) * 8, t0 = (tid >> 3) * 4;
#pragma unroll
    for (int r = 0; r < 8; ++r) {
        const int tt = t0 - 2 + r, pos = cpos + tt;
        u32x4 v = (u32x4){0u, 0u, 0u, 0u};
        if (pos >= 0 && pos < len) v = *(const u32x4*)(p.PROJ + (long)(tok0 + tt) * PC + P_BX + col0 + ch8);
        raw[r] = v;
    }
}
template <bool TR>
__device__ __forceinline__ void ssd_conv_apply(const P& p, int l, int col0, const u32x4 (&raw)[8], bf16_t* dst) {
    const int tid = otid(), ch8 = (tid & 7) * 8, t0 = (tid >> 3) * 4;
    float xr[8][8];
#pragma unroll
    for (int r = 0; r < 8; ++r)
#pragma unroll
        for (int e = 0; e < 4; ++e) { xr[r][2 * e] = bf2f((bf16_t)(raw[r][e] & 0xffff)); xr[r][2 * e + 1] = bf2f((bf16_t)(raw[r][e] >> 16)); }
    float acc[4][8];
    { const float4 b0 = *(const float4*)(p.conv_b + l * 768 + col0 + ch8), b1 = *(const float4*)(p.conv_b + l * 768 + col0 + ch8 + 4);
#pragma unroll
      for (int i = 0; i < 4; ++i) { acc[i][0] = b0.x; acc[i][1] = b0.y; acc[i][2] = b0.z; acc[i][3] = b0.w; acc[i][4] = b1.x; acc[i][5] = b1.y; acc[i][6] = b1.z; acc[i][7] = b1.w; } }
#pragma unroll
    for (int tap = 0; tap < 5; ++tap) {
        const float4 w0 = *(const float4*)(p.conv_w + (l * 5 + tap) * 768 + col0 + ch8), w1 = *(const float4*)(p.conv_w + (l * 5 + tap) * 768 + col0 + ch8 + 4);
        const float wv[8] = {w0.x, w0.y, w0.z, w0.w, w1.x, w1.y, w1.z, w1.w};
#pragma unroll
        for (int i = 0; i < 4; ++i)
#pragma unroll
            for (int e = 0; e < 8; ++e) acc[i][e] += wv[e] * xr[i + tap][e];
    }
#pragma unroll
    for (int i = 0; i < 4; ++i) {
        if (TR) {
#pragma unroll
            for (int e = 0; e < 8; ++e) dst[(ch8 + e) * XT_STRIDE + t0 + i] = f2bf(siluf(acc[i][e]));
        } else {
            u32x4 o;
#pragma unroll
            for (int e = 0; e < 4; ++e) o[e] = pack_bf16(siluf(acc[i][2 * e]), siluf(acc[i][2 * e + 1]));
            *(u32x4*)(dst + (t0 + i) * 72 + ch8) = o;
        }
    }
}

__device__ __forceinline__ void b_ssd_states(const P& p, int l, int unit, bf16_t* smem) {
    const int head = unit & 7, cc = (unit >> 3) % NCH, b = unit / (8 * NCH), g = head >> 2;
    const int tok0 = chunk_tok0(b, cc);
    const int tid = otid(), lane = tid & 63, w = tid >> 6, c = lane & 31, h = lane >> 5;
    bf16_t* xT = smem; bf16_t* BT = smem + 64 * XT_STRIDE;
    float* cumv = (float*)(smem + 2 * 64 * XT_STRIDE); float* dtv = cumv + 256; float* wdt = dtv + 256;
    __syncthreads();
    const int cpos = cc < 2 ? cc * 128 : (cc - 2) * 128, slen = cc < 2 ? LC : L;
    {
        u32x4 rx[8], rb[8];
        ssd_conv_load(p, tok0, cpos, slen, head * 64, rx);
        ssd_conv_load(p, tok0, cpos, slen, 512 + g * 64, rb);
        ssd_dt_cum(p, l, tok0, head, cumv, dtv);
        ssd_conv_apply<true>(p, l, head * 64, rx, xT);
        ssd_conv_apply<true>(p, l, 512 + g * 64, rb, BT);
    }
    __syncthreads();
    { const int dir = tid >> 7, t = tid & 127; const float ce = cumv[dir * 128 + (dir ? 0 : 127)];
      wdt[tid] = __expf(ce - cumv[tid]) * dtv[tid];
      if (t == 0) wt_store(&p.DEC[((long)(b * NCH + cc) * 8 + head) * 2 + dir], __expf(ce)); }
    __syncthreads();
    const int dir = w >> 1, pt = w & 1;
    f32x16 acc[2];
#pragma unroll
    for (int nt = 0; nt < 2; ++nt)
#pragma unroll
        for (int e = 0; e < 16; ++e) acc[nt][e] = 0.f;
#pragma unroll
    for (int ks = 0; ks < 8; ++ks) {
        const u32x4 xr = *(const u32x4*)(xT + (pt * 32 + c) * XT_STRIDE + ks * 16 + h * 8);
        const f32x4 w0 = *(const f32x4*)(wdt + dir * 128 + ks * 16 + h * 8), w1 = *(const f32x4*)(wdt + dir * 128 + ks * 16 + h * 8 + 4);
        u32x4 xs;
        xs[0] = pack_bf16(bf2f((bf16_t)(xr[0] & 0xffff)) * w0[0], bf2f((bf16_t)(xr[0] >> 16)) * w0[1]);
        xs[1] = pack_bf16(bf2f((bf16_t)(xr[1] & 0xffff)) * w0[2], bf2f((bf16_t)(xr[1] >> 16)) * w0[3]);
        xs[2] = pack_bf16(bf2f((bf16_t)(xr[2] & 0xffff)) * w1[0], bf2f((bf16_t)(xr[2] >> 16)) * w1[1]);
        xs[3] = pack_bf16(bf2f((bf16_t)(xr[3] & 0xffff)) * w1[2], bf2f((bf16_t)(xr[3] >> 16)) * w1[3]);
        const bf16x8 xa = __builtin_bit_cast(bf16x8, xs);
#pragma unroll
        for (int nt = 0; nt < 2; ++nt) {
            const bf16x8 bb = *(const bf16x8*)(BT + (nt * 32 + c) * XT_STRIDE + ks * 16 + h * 8);
            acc[nt] = __builtin_amdgcn_mfma_f32_32x32x16_bf16(xa, bb, acc[nt], 0, 0, 0);
        }
    }
    float* st = p.ST + (((long)(b * NCH + cc) * 8 + head) * 2 + dir) * 4096;
#pragma unroll
    for (int nt = 0; nt < 2; ++nt)
#pragma unroll
        for (int e = 0; e < 16; ++e) { const int pr = pt * 32 + 8 * (e >> 2) + 4 * h + (e & 3); wt_store(&st[pr * 64 + nt * 32 + c], acc[nt][e]); }
    unit_publish(p.SYNC + l * 2 + 0);
}

__device__ __forceinline__ void b_ssd_scan(const P& p, int l, int vb) {
    unit_wait(p.SYNC + l * 2 + 0, (unsigned)(NB * NCH * 8));
    const int idx = vb * 256 + otid();
    const int e = idx & 4095, dir = (idx >> 12) & 1, head = (idx >> 13) & 7, b = idx >> 16;
    float stv[NCH], dcv[NCH];
#pragma unroll
    for (int k = 0; k < NCH; ++k) {
        const int cc = dir ? (k < 2 ? 1 - k : 35 - k) : k;
        const long base = ((long)(b * NCH + cc) * 8 + head) * 2 + dir;
        stv[k] = p.ST[base * 4096 + e]; dcv[k] = p.DEC[base];
    }
    float hst = 0.f;
#pragma unroll
    for (int k = 0; k < NCH; ++k) {
        const int cc = dir ? (k < 2 ? 1 - k : 35 - k) : k;
        const long base = ((long)(b * NCH + cc) * 8 + head) * 2 + dir;
        { const float oth = __shfl_xor(hst, 1); if ((e & 1) == 0) wt_store((unsigned*)(p.HS + base * 4096 + e), pack_bf16(hst, oth)); }
        hst = dcv[k] * hst + stv[k];
    }
    unit_publish(p.SYNC + l * 2 + 1);
}

__device__ __forceinline__ void b_ssd_out(const P& p, int l, int unit, bf16_t* smem) {
    const int head = unit & 7, cc = (unit >> 3) % NCH, b = unit / (8 * NCH), g = head >> 2;
    const int tok0 = chunk_tok0(b, cc);
    const int tid = otid(), lane = tid & 63, w = tid >> 6, c = lane & 31, h = lane >> 5;
    bf16_t* Cs = smem; bf16_t* Bs = smem + 128 * 72; bf16_t* xT = smem + 2 * 128 * 72;
    float* cumv = (float*)(smem + 2 * 128 * 72 + 64 * XT_STRIDE); float* dtv = cumv + 256;
    __syncthreads();
    const int cpos = cc < 2 ? cc * 128 : (cc - 2) * 128, slen = cc < 2 ? LC : L;
    const int t = 32 * w + c;
    const bf16_t* zp = p.PROJ + (long)(tok0 + t) * PC + P_BZ + head * 64;
    {
        u32x4 rc[8], rb[8], rx[8];
        ssd_conv_load(p, tok0, cpos, slen, 640 + g * 64, rc);
        ssd_conv_load(p, tok0, cpos, slen, 512 + g * 64, rb);
        ssd_dt_cum(p, l, tok0, head, cumv, dtv);
        ssd_conv_apply<false>(p, l, 640 + g * 64, rc, Cs);
        ssd_conv_load(p, tok0, cpos, slen, head * 64, rx);
        ssd_conv_apply<false>(p, l, 512 + g * 64, rb, Bs);
        ssd_conv_apply<true>(p, l, head * 64, rx, xT);
    }
    unit_wait(p.SYNC + l * 2 + 1, (unsigned)(NB * 8 * 2 * 4096 / 256));
    bf16x8 cf[4];
#pragma unroll
    for (int ks = 0; ks < 4; ++ks) cf[ks] = *(const bf16x8*)(Cs + t * 72 + ks * 16 + h * 8);
    f32x16 gT[4];
#pragma unroll
    for (int st = 0; st < 4; ++st) {
#pragma unroll
        for (int e = 0; e < 16; ++e) gT[st][e] = 0.f;
#pragma unroll
        for (int ks = 0; ks < 4; ++ks) {
            const bf16x8 bfr = *(const bf16x8*)(Bs + (st * 32 + c) * 72 + ks * 16 + h * 8);
            gT[st] = __builtin_amdgcn_mfma_f32_32x32x16_bf16(bfr, cf[ks], gT[st], 0, 0, 0);
        }
    }
    f32x16 tot[2];
#pragma unroll
    for (int pt = 0; pt < 2; ++pt)
#pragma unroll
        for (int e = 0; e < 16; ++e) tot[pt][e] = 0.f;
#pragma unroll
    for (int dir = 0; dir < 2; ++dir) {
        const float ct = cumv[dir * 128 + t];
        bf16x8 hsf[4][2];
        {
            const bf16_t* hs = p.HS + (((long)(b * NCH + cc) * 8 + head) * 2 + dir) * 4096;
#pragma unroll
            for (int ks = 0; ks < 4; ++ks)
#pragma unroll
                for (int pt = 0; pt < 2; ++pt) hsf[ks][pt] = *(const bf16x8*)(hs + (pt * 32 + c) * 64 + ks * 16 + h * 8);
        }
#pragma unroll
        for (int st = 0; st < 4; ++st) {
            const bool need = dir ? (st >= w) : (st <= w);
            if (need) {
#pragma unroll
                for (int k2 = 0; k2 < 2; ++k2) {
                    float mv[8];
#pragma unroll
                    for (int j = 0; j < 8; ++j) {
                        const int sidx = st * 32 + 16 * k2 + 8 * (j >> 2) + 4 * h + (j & 3);
                        const float cs = cumv[dir * 128 + sidx], ds = dtv[dir * 128 + sidx];
                        const bool ok = (st != w) || (dir ? (sidx >= t) : (sidx <= t));
                        const float arg = ok ? ct - cs : -__builtin_inff();
                        mv[j] = gT[st][8 * k2 + j] * __expf(arg) * ds;
                    }
                    u32x4 pm; pm[0] = pack_bf16(mv[0], mv[1]); pm[1] = pack_bf16(mv[2], mv[3]); pm[2] = pack_bf16(mv[4], mv[5]); pm[3] = pack_bf16(mv[6], mv[7]);
                    const bf16x8 pmb = __builtin_bit_cast(bf16x8, pm);
#pragma unroll
                    for (int pt = 0; pt < 2; ++pt) {
                        const bf16_t* xr = xT + (pt * 32 + c) * XT_STRIDE + st * 32 + 16 * k2 + 4 * h;
                        const uint2 lo = *(const uint2*)xr, hi = *(const uint2*)(xr + 8);
                        const u32x4 xa = (u32x4){lo.x, lo.y, hi.x, hi.y};
                        tot[pt] = __builtin_amdgcn_mfma_f32_32x32x16_bf16(__builtin_bit_cast(bf16x8, xa), pmb, tot[pt], 0, 0, 0);
                    }
                }
            }
        }
        const float et = __expf(ct);
#pragma unroll
        for (int ks = 0; ks < 4; ++ks) {
            const u32x4 cr = __builtin_bit_cast(u32x4, cf[ks]);
            u32x4 cs4;
#pragma unroll
            for (int e = 0; e < 4; ++e) cs4[e] = pack_bf16(bf2f((bf16_t)(cr[e] & 0xffff)) * et, bf2f((bf16_t)(cr[e] >> 16)) * et);
            const bf16x8 cfs = __builtin_bit_cast(bf16x8, cs4);
#pragma unroll
            for (int pt = 0; pt < 2; ++pt) {
                tot[pt] = __builtin_amdgcn_mfma_f32_32x32x16_bf16(hsf[ks][pt], cfs, tot[pt], 0, 0, 0);
            }
        }
    }
    const float dsk = p.d_skip[(l * 2 + 0) * 8 + head] + p.d_skip[(l * 2 + 1) * 8 + head];
    bf16_t* gp = p.MIXO + (long)(tok0 + t) * D + 256 + head * 64;
    uint2 zr[2][4];
#pragma unroll
    for (int pt = 0; pt < 2; ++pt)
#pragma unroll
        for (int gq = 0; gq < 4; ++gq) zr[pt][gq] = *(const uint2*)(zp + pt * 32 + 8 * gq + 4 * h);
    float ss = 0.f;
#pragma unroll
    for (int pt = 0; pt < 2; ++pt)
#pragma unroll
        for (int gq = 0; gq < 4; ++gq) {
            const int p0 = pt * 32 + 8 * gq + 4 * h;
            const uint2 zq = zr[pt][gq];
            const float zv[4] = {bf2f((bf16_t)(zq.x & 0xffff)), bf2f((bf16_t)(zq.x >> 16)), bf2f((bf16_t)(zq.y & 0xffff)), bf2f((bf16_t)(zq.y >> 16))};
            float gv[4];
#pragma unroll
            for (int e = 0; e < 4; ++e) { const float y = tot[pt][4 * gq + e] + bf2f(xT[(p0 + e) * XT_STRIDE + t]) * dsk; gv[e] = y * siluf(zv[e]); ss += gv[e] * gv[e]; }
            uint2 ov; ov.x = pack_bf16(gv[0], gv[1]); ov.y = pack_bf16(gv[2], gv[3]);
            *(uint2*)(gp + p0) = ov;
        }
    ss += __shfl_xor(ss, 32);
    if (h == 0) p.SSQ[(long)(tok0 + t) * 8 + head] = ss;
}

__device__ __forceinline__ void b_norm2r(const P& p, int l, int vb, bf16_t* smem) {
    const int tid = otid(), wave = tid >> 6, lane = tid & 63;
    constexpr int HST = D + 16;
    bf16_t* Hs = smem;
    float* red = (float*)(smem + 16 * HST);
    float* lgs = red + 4 * 16 * 48;
    __syncthreads();
#pragma unroll 1
    for (int i4 = 0; i4 < 4; ++i4) {
        const int tl = wave * 4 + i4, tok = vb * 16 + tl;
        float v[16];
        const float* src = p.X + (long)tok * D;
#pragma unroll
        for (int i = 0; i < 4; ++i) { const float4 t = *(const float4*)(src + i * 256 + lane * 4); v[i * 4 + 0] = t.x; v[i * 4 + 1] = t.y; v[i * 4 + 2] = t.z; v[i * 4 + 3] = t.w; }
        float ss = 0.f;
#pragma unroll
        for (int i = 0; i < 16; ++i) ss += v[i] * v[i];
        ss = wave_sum(ss);
        const float r = rsqrtf(ss * (1.f / D) + EPS);
        const float* m = p.MOD + ((long)l * 5 + tok_modrow(tok)) * 6 * D;
        const float* nw = p.norm2_w + l * D;
        bf16_t* ho = p.H + (long)tok * D;
#pragma unroll
        for (int i = 0; i < 4; ++i) {
            const int k = i * 256 + lane * 4;
            const float4 w4 = *(const float4*)(nw + k), sc = *(const float4*)(m + 4 * D + k), sh = *(const float4*)(m + 3 * D + k);
            uint2 o;
            o.x = pack_bf16(v[i * 4 + 0] * r * w4.x * (1.f + sc.x) + sh.x, v[i * 4 + 1] * r * w4.y * (1.f + sc.y) + sh.y);
            o.y = pack_bf16(v[i * 4 + 2] * r * w4.z * (1.f + sc.z) + sh.z, v[i * 4 + 3] * r * w4.w * (1.f + sc.w) + sh.w);
            *(uint2*)(ho + k) = o;
            *(uint2*)(Hs + tl * HST + k) = o;
        }
    }
    __syncthreads();
    {
        const int lr = lane & 15, lq = lane >> 4;
        const bf16_t* wr = p.WT_R + ((long)l * 128 + lr) * D + wave * 256 + lq * 8;
        const bf16_t* hr = Hs + lr * HST + wave * 256 + lq * 8;
        f32x4 acc[3];
#pragma unroll
        for (int ni = 0; ni < 3; ++ni) acc[ni] = (f32x4){0.f, 0.f, 0.f, 0.f};
#pragma unroll
        for (int half = 0; half < 2; ++half) {
            bf16x8 wb[4][3];
#pragma unroll
            for (int ks = 0; ks < 4; ++ks)
#pragma unroll
                for (int ni = 0; ni < 3; ++ni) wb[ks][ni] = *(const bf16x8*)(wr + (long)ni * 16 * D + (half * 4 + ks) * 32);
#pragma unroll
            for (int ks = 0; ks < 4; ++ks) {
                const bf16x8 xa = *(const bf16x8*)(hr + (half * 4 + ks) * 32);
#pragma unroll
                for (int ni = 0; ni < 3; ++ni) acc[ni] = __builtin_amdgcn_mfma_f32_16x16x32_bf16(wb[ks][ni], xa, acc[ni], 0, 0, 0);
            }
        }
#pragma unroll
        for (int ni = 0; ni < 3; ++ni) *(f32x4*)(red + (wave * 16 + lr) * 48 + ni * 16 + lq * 4) = acc[ni];
    }
    __syncthreads();
#pragma unroll
    for (int i = 0; i < 3; ++i) {
        const int idx = tid + i * 256, t = idx / 48, j = idx % 48;
        lgs[t * 49 + j] = (red[(0 * 16 + t) * 48 + j] + red[(1 * 16 + t) * 48 + j]) + (red[(2 * 16 + t) * 48 + j] + red[(3 * 16 + t) * 48 + j]);
    }
    __syncthreads();
    if (tid < 16) {
        const int tok = vb * 16 + tid;
        const float* lg = lgs + tid * 49;
        int gs = 0; float gm = lg[0];
#pragma unroll
        for (int j = 1; j < 4; ++j) { const float v = lg[j]; if (v > gm) { gm = v; gs = j; } }
        float den = 0.f;
#pragma unroll
        for (int j = 0; j < 4; ++j) den += expf(lg[j] - gm);
        const float gp = 1.f / den;
        float e0 = -3.4e38f, e1 = -3.4e38f; int i0 = 0, i1 = 0;
#pragma unroll
        for (int j = 0; j < 8; ++j) {
            const float val = lg[4 + gs * 8 + j];
            if (val > e0) { e1 = e0; i1 = i0; e0 = val; i0 = j; }
            else if (val > e1) { e1 = val; i1 = j; }
        }
        const float x1 = expf(e1 - e0), w0 = gp / (1.f + x1), w1 = gp * x1 / (1.f + x1);
        const int ex0 = gs * 8 + i0, ex1 = gs * 8 + i1;
        int* cnt = p.cnt + l * NEXP;
        const int rk0 = atomicAdd(&cnt[ex0], 1); p.list[(long)ex0 * NTOK + rk0] = tok * 2 + 0; p.gatew[tok * 2 + 0] = w0;
        const int rk1 = atomicAdd(&cnt[ex1], 1); p.list[(long)ex1 * NTOK + rk1] = tok * 2 + 1; p.gatew[tok * 2 + 1] = w1;
    }
}

struct MoeTile { int e, mt, cnt, off; };
__device__ __forceinline__ int moe_row_tiles(const int* cnt) { int t = 0; for (int e = 0; e < NEXP; ++e) t += (cnt[e] + 127) >> 7; return t; }
__device__ __forceinline__ MoeTile moe_find_tile(const int* cnt, int tile) {
    MoeTile t; t.e = -1; t.mt = 0; t.cnt = 0; t.off = 0;
    int acc_t = 0, off = 0;
    for (int e = 0; e < NEXP; ++e) {
        const int c = cnt[e], nt = (c + 127) >> 7;
        if (t.e < 0 && tile < acc_t + nt) { t.e = e; t.mt = tile - acc_t; t.cnt = c; t.off = off; }
        acc_t += nt; off += c;
    }
    return t;
}
struct RowGather { const bf16_t* base; const int* lst; int n; __device__ __forceinline__ const bf16_t* operator()(int r) const { return base + (long)(lst[r < n ? r : n - 1] >> 1) * D; } };
struct RowLimit { const bf16_t* base; long ld; int n; __device__ __forceinline__ const bf16_t* operator()(int r) const { return base + (long)(r < n ? r : n - 1) * ld; } };
template <int NI> struct RowGateUp { const bf16_t* wg; const bf16_t* wu; __device__ __forceinline__ const bf16_t* operator()(int n) const {
    const int wn = n / (NI * 16), f = (n >> 4) % NI, j = n & 15, col = wn * (NI * 8) + (f % (NI / 2)) * 16 + j; return wg + (long)(f / (NI / 2)) * (wu - wg) + (long)col * D; } };

template <int NI>
__device__ __forceinline__ void b_moe_up(const P& p, int l, int rt, int h0, bf16_t* smem) {
    const MoeTile t = moe_find_tile(p.cnt + l * NEXP, rt);
    if (t.e < 0) return;
    const int nrow = min(128, t.cnt - t.mt * 128);
    RowGather ra{p.H, p.list + (long)t.e * NTOK + t.mt * 128, nrow};
    const long wofs = (((long)l * NEXP + t.e) * DEXP + h0) * D;
    RowGateUp<NI> rb{p.WT_G + wofs, p.WT_U + wofs};
    bf16_t* out = p.HID + (long)(t.off + t.mt * 128) * DEXP + h0;
    auto epi = [&](const f32x4 (&acc)[4][NI], int wm, int wn, int lr, int lq) {
#pragma unroll
        for (int mi = 0; mi < 4; ++mi) {
            const int r = wm * 64 + mi * 16 + lr;
            if (r < nrow) {
#pragma unroll
                for (int f = 0; f < NI / 2; ++f) {
                    const f32x4 gt = acc[mi][f], up = acc[mi][NI / 2 + f];
                    float hv[4];
#pragma unroll
                    for (int e = 0; e < 4; ++e) hv[e] = siluf(gt[e]) * up[e];
                    uint2 o; o.x = pack_bf16(hv[0], hv[1]); o.y = pack_bf16(hv[2], hv[3]);
                    *(uint2*)(out + (long)r * DEXP + wn * (NI * 8) + f * 16 + lq * 4) = o;
                }
            }
        }
    };
    if constexpr (NI == 8) gemm_tile32<4, 8>(ra, rb, D, smem, epi); else gemm_tile<4, NI>(ra, rb, D, smem, epi);
}

template <int NI>
__device__ __forceinline__ void b_moe_down(const P& p, int l, int rt, int n0, bf16_t* smem) {
    const MoeTile t = moe_find_tile(p.cnt + l * NEXP, rt);
    if (t.e < 0) return;
    const int nrow = min(128, t.cnt - t.mt * 128);
    const int slot0 = t.off + t.mt * 128;
    RowLimit ra{p.HID + (long)slot0 * DEXP, DEXP, nrow};
    RowLin rb{p.WT_D + (((long)l * NEXP + t.e) * D + n0) * DEXP, DEXP};
    const int* lst = p.list + (long)t.e * NTOK + t.mt * 128;
    int asg[4]; float gwv[4];
    {
        const int lane = otid() & 63, w = otid() >> 6;
#pragma unroll
        for (int mi = 0; mi < 4; ++mi) { const int r = (w >> 1) * 64 + mi * 16 + (lane & 15); asg[mi] = lst[r < nrow ? r : nrow - 1]; gwv[mi] = p.gatew[asg[mi]]; }
    }
    auto epi = [&](const f32x4 (&acc)[4][NI], int wm, int wn, int lr, int lq) {
#pragma unroll
        for (int mi = 0; mi < 4; ++mi) {
            const int r = wm * 64 + mi * 16 + lr;
            if (r < nrow) {
                const float gw = gwv[mi];
                if (n0 == 0 && wn == 0 && lq == 0) p.pos[asg[mi]] = slot0 + r;
#pragma unroll
                for (int ni = 0; ni < NI; ++ni) {
                    const int n = n0 + wn * (NI * 16) + ni * 16 + lq * 4;
                    const f32x4 a = acc[mi][ni];
                    uint2 o; o.x = pack_bf16(a[0] * gw, a[1] * gw); o.y = pack_bf16(a[2] * gw, a[3] * gw);
                    *(uint2*)(p.YS + (long)(slot0 + r) * D + n) = o;
                }
            }
        }
    };
    if constexpr (NI == 8) gemm_tile32<4, 8>(ra, rb, DEXP, smem, epi); else gemm_tile<4, NI>(ra, rb, DEXP, smem, epi);
}

__device__ __forceinline__ void b_final(const P& p, int vb) {
    const int wave = otid() >> 6, lane = otid() & 63;
    const int tok = vb * 4 + wave;
    if (tok >= NLAT) return;
    float v[16];
    const float* src = p.X + (long)tok * D;
#pragma unroll
    for (int i = 0; i < 4; ++i) { const float4 t = *(const float4*)(src + i * 256 + lane * 4); v[i * 4 + 0] = t.x; v[i * 4 + 1] = t.y; v[i * 4 + 2] = t.z; v[i * 4 + 3] = t.w; }
    {
        const bf16_t* ys0 = p.YS + (long)p.pos[tok * 2 + 0] * D; const bf16_t* ys1 = p.YS + (long)p.pos[tok * 2 + 1] * D;
        const float* g2 = p.MOD + ((long)(DEPTH - 1) * 5 + tok_modrow(tok)) * 6 * D + 5 * D;
#pragma unroll
        for (int i = 0; i < 4; ++i) {
            const uint2 t = *(const uint2*)(ys0 + i * 256 + lane * 4), u = *(const uint2*)(ys1 + i * 256 + lane * 4);
            const float4 g = *(const float4*)(g2 + i * 256 + lane * 4);
            v[i * 4 + 0] += (bf2f((bf16_t)(t.x & 0xffff)) + bf2f((bf16_t)(u.x & 0xffff))) * g.x; v[i * 4 + 1] += (bf2f((bf16_t)(t.x >> 16)) + bf2f((bf16_t)(u.x >> 16))) * g.y;
            v[i * 4 + 2] += (bf2f((bf16_t)(t.y & 0xffff)) + bf2f((bf16_t)(u.y & 0xffff))) * g.z; v[i * 4 + 3] += (bf2f((bf16_t)(t.y >> 16)) + bf2f((bf16_t)(u.y >> 16))) * g.w;
        }
    }
    float ss = 0.f;
#pragma unroll
    for (int i = 0; i < 16; ++i) ss += v[i] * v[i];
    ss = wave_sum(ss);
    const float r = rsqrtf(ss * (1.f / D) + EPS);
    float* o = p.out + (long)tok * D;
#pragma unroll
    for (int i = 0; i < 4; ++i) { const float4 w = *(const float4*)(p.final_w + i * 256 + lane * 4);
        *(float4*)(o + i * 256 + lane * 4) = make_float4(v[i * 4 + 0] * r * w.x, v[i * 4 + 1] * r * w.y, v[i * 4 + 2] * r * w.z, v[i * 4 + 3] * r * w.w); }
}


#define XB_TMO      128
#define XB_XCNT(j)  (256  + 64 * (j))
#define XB_XSUB(j)  (1280 + 64 * (j))
#define XB_XGEN(j)  (2304 + 64 * (j))
#define XB_TOP      3328
#define XB_TOPGEN   3392
#define XCD_BAR_WORDS 3456
#define XB_SPIN_CAP (1u << 22)
__device__ __forceinline__ unsigned xb_ld(unsigned* p)              { return __hip_atomic_load(p, __ATOMIC_RELAXED, __HIP_MEMORY_SCOPE_AGENT); }
__device__ __forceinline__ unsigned xb_add(unsigned* p, unsigned v) { return __hip_atomic_fetch_add(p, v, __ATOMIC_RELAXED, __HIP_MEMORY_SCOPE_AGENT); }
__device__ __forceinline__ unsigned xb_xcc_id() { return (unsigned)__builtin_amdgcn_s_getreg((3 << 11) | 20) & 0xFu; }
#define XB_SPIN(cond, bar) do { unsigned _sp = 0; while (cond) { __builtin_amdgcn_s_sleep(1); \
    if ((++_sp & 255u) == 0u) { if (xb_ld(&(bar)[XB_TMO])) break; if (_sp > XB_SPIN_CAP) { atomicAdd(&(bar)[XB_TMO], 1u); break; } } } } while (0)
struct XcdBarrier { unsigned* bar; unsigned x; volatile LAS unsigned* st; };
__device__ __forceinline__ XcdBarrier xcd_barrier_post(unsigned* bar, volatile LAS unsigned* st) {
    XcdBarrier b; b.bar = bar; b.x = xb_xcc_id(); b.st = st;
    if (threadIdx.x == 0) (void)xb_add(&bar[XB_XCNT(b.x)], 1u);
    return b;
}
__device__ __forceinline__ void xcd_barrier_complete(unsigned* bar, unsigned x, unsigned& nloc, unsigned& nx) {
    const unsigned G = gridDim.x * gridDim.y * gridDim.z;
    unsigned sum, cnt, mine, sp = 0u;
    for (;;) {
        sum = 0u; cnt = 0u; mine = 0u;
#pragma unroll
        for (unsigned j = 0; j < 16; ++j) { const unsigned c = xb_ld(&bar[XB_XCNT(j)]); sum += c; cnt += (c > 0u) ? 1u : 0u; mine = (j == x) ? c : mine; }
        if (sum == G) break;
        __builtin_amdgcn_s_sleep(1);
        if ((++sp & 255u) == 0u) { if (xb_ld(&bar[XB_TMO])) break; if (sp > XB_SPIN_CAP) { atomicAdd(&bar[XB_TMO], 1u); break; } }
    }
    nloc = mine > 0u ? mine : 1u; nx = cnt > 0u ? cnt : 1u;
}
__device__ __forceinline__ void xcd_barrier(const XcdBarrier& b) {
    asm volatile("s_waitcnt vmcnt(0)" ::: "memory");
    __syncthreads();
    if (threadIdx.x == 0) {
        unsigned* bar = b.bar;
        __builtin_amdgcn_s_waitcnt(0);
        unsigned bx = __builtin_amdgcn_readfirstlane(b.x); asm volatile("" : "+s"(bx));
        unsigned nloc = b.st[0], nx = b.st[1];
        if (nloc == 0u) { xcd_barrier_complete(bar, bx, nloc, nx); b.st[0] = nloc; b.st[1] = nx; }
        const unsigned old = xb_add(&bar[XB_XSUB(bx)], 1u);
        const unsigned gen = old / nloc;
        if (old + 1u == (gen + 1u) * nloc) {
            __builtin_amdgcn_fence(__ATOMIC_RELEASE, "agent");
            asm volatile("s_waitcnt vmcnt(0)" ::: "memory");
            const unsigned og = xb_add(&bar[XB_TOP], 1u);
            const unsigned tg = og / nx;
            if (og + 1u == (tg + 1u) * nx) xb_add(&bar[XB_TOPGEN], 1u);
            else XB_SPIN(xb_ld(&bar[XB_TOPGEN]) == tg, bar);
            __builtin_amdgcn_fence(__ATOMIC_ACQUIRE, "agent");
            xb_add(&bar[XB_XGEN(bx)], 1u);
            asm volatile("s_waitcnt vmcnt(0)" ::: "memory");
        } else {
            XB_SPIN(xb_ld(&bar[XB_XGEN(bx)]) == gen, bar);
            __builtin_amdgcn_fence(__ATOMIC_ACQUIRE, "agent");
            asm volatile("s_waitcnt vmcnt(0)" ::: "memory");
        }
    }
    __syncthreads();
}

#define FOR_VB(n) for (int vb = blockIdx.x; vb < (n); vb += gridDim.x)
#define FOR_VB_XCD(n) for (int _ch = ((n) + 7) >> 3, _j = (int)blockIdx.x >> 3, vb = ((int)blockIdx.x & 7) * _ch + _j; _j < _ch; _j += (int)gridDim.x >> 3, vb += (int)gridDim.x >> 3) if (vb < (n))
#define FOR_VB_OFF(n, off) for (int vb = (int)((blockIdx.x + gridDim.x - ((off) % gridDim.x)) % gridDim.x); vb < (n); vb += gridDim.x)
__global__ void __launch_bounds__(256, 2) k_mega(P p) {
    extern __shared__ __attribute__((aligned(16))) unsigned char dynlds[];
    bf16_t* smem = (bf16_t*)dynlds;
    uint4* xbw = (uint4*)(dynlds + SMEM_BYTES);
    float (*tt)[65] = (float (*)[65])smem;
    if (threadIdx.x == 0) *xbw = make_uint4(0u, 0u, 0u, 0u);
    __syncthreads();
    const XcdBarrier xb = xcd_barrier_post(p.bar, (volatile LAS unsigned*)xbw);
    if (threadIdx.x == 0) {
        const unsigned key = (xb.x << 8) | ((unsigned)__builtin_amdgcn_s_getreg((7 << 11) | (8 << 6) | 4) & 0xFFu);
        ((volatile LAS unsigned*)xbw)[4] = xb_add(&p.cuslot[key], 1u) & 1u;
    }
    __syncthreads();
    const int slot = __builtin_amdgcn_readfirstlane((int)((volatile LAS unsigned*)xbw)[4]);
    if (blockIdx.x == 0 && otid() < DEPTH * NEXP) p.cnt[otid()] = 0;
    if (blockIdx.x == 1 && otid() < DEPTH * NB * 10) p.KMAX[otid()] = 0u;
    if (blockIdx.x == 2) for (int i = otid(); i < SY_LAYER + DEPTH * SY_STRIDE; i += 256) p.SYNC[i] = 0u;
    FOR_VB(6) b_rope_table(p, vb);
    FOR_VB(DEPTH * 6 * D / 64) b_mod(p, vb, (float*)smem);
    __syncthreads();
    constexpr int CI1 = 28 * 16 / 4, CI2 = 12 * 16 / 4, CVO = (D / 64) * (D / 64) / 4;
    auto prep_in = [&](int bz, int off) {
        FOR_VB_OFF(CI1, off) b_convT_stream(bz * CI1 + vb, p.w_in, p.WT_IN, D, 1792, nullptr, IN_COLS, 0, 0, (long)D * IN_COLS, (long)PCW * D);
        FOR_VB_OFF(CI2, off + CI1) b_convT_stream(bz * CI2 + vb, p.w_in, p.WT_IN, D, 768, nullptr, IN_COLS, 1808, 1792, (long)D * IN_COLS, (long)PCW * D);
        FOR_VB_OFF(16, off + CI1 + CI2) b_convT(tt, 0, vb, bz, p.w_in, p.WT_IN, D, IN_COLS, OLD_BDT, 16, PC, (long)D * IN_COLS, (long)PCW * D);
    };
    prep_in(0, 0);
    FOR_VB(1 * 16 * DEPTH) b_convT(tt, 0, vb % 16, vb / 16, p.w_grouter, p.WT_R, D, 4, 0, 4, 0, (long)D * 4, (long)128 * D);
    FOR_VB(1 * 16 * DEPTH) b_convT(tt, 0, vb % 16, vb / 16, p.w_router, p.WT_R, D, 32, 0, 32, 4, (long)D * 32, (long)128 * D);
    xcd_barrier(xb);
    for (int l = 0; l < DEPTH; ++l) {
        const bool last = (l == DEPTH - 1);
        const int ntok = last ? NLAT : NTOK;
        FOR_VB(NTOK / 16) b_norm1(p, l, vb);
        {
            constexpr int NT = PCW / 128, MPX = (NTOK / 128) / 8, CH = MPX * NT, M0 = (MPX + 1) / 2, M1 = MPX - M0;
            for (int j = (int)blockIdx.x >> 3; j < CH; j += (int)gridDim.x >> 3) {
                const int jj = j < M0 * NT ? j : j - M0 * NT, mh = j < M0 * NT ? M0 : M1, m = (j < M0 * NT ? 0 : M0) + jj % mh, n = jj / mh;
                b_inproj(p, l, (((int)blockIdx.x & 7) * MPX + m) * NT + n, smem);
            }
        }
        xcd_barrier(xb);
        {
            const int nst = NB * NCH * 8, nsc = NB * 8 * 2 * 4096 / 256;
            const int ncu = NB * 4 * (L / 128) + (last ? 0 : NB * 4 * 2);
            FOR_VB_OFF(nst, 0) b_ssd_states(p, l, vb, smem);
            constexpr int CVL = NEXP * (D / 64) * (DEXP / 64) / 4;
#pragma unroll 1
            for (int step = 0; step < 2; ++step) {
                if ((step ^ slot) == 0) {
                    FOR_VB_OFF(ncu, nst) b_attnC(p, l, vb, smem);
                } else {
                    for (int vb = l * CVL + (int)blockIdx.x; vb < (l + 1) * CVL; vb += (int)gridDim.x) b_convT_stream(vb, p.w_gate, p.WT_G, D, DEXP);
                    for (int vb = l * CVL + (int)blockIdx.x; vb < (l + 1) * CVL; vb += (int)gridDim.x) b_convT_stream(vb, p.w_up, p.WT_U, D, DEXP);
                    for (int vb = l * CVL + (int)blockIdx.x; vb < (l + 1) * CVL; vb += (int)gridDim.x) b_convT_stream(vb, p.w_down, p.WT_D, DEXP, D);
                    FOR_VB_OFF(CVO, 192) b_convT_stream(l * CVO + vb, p.w_out, p.WT_OUT, D, D, p.b_norm_w);
                    if (l + 1 < DEPTH) prep_in(l + 1, 192 + CVO);
                }
                if (step == 0) { FOR_VB_OFF(nsc, nst + ncu) b_ssd_scan(p, l, vb); }
            }
            FOR_VB_OFF(ncu, nst + nsc + ncu) b_attnA(p, l, vb, smem);
            FOR_VB_OFF(nst, nst + nsc + 2 * ncu) { if (last && ((vb >> 3) % NCH) < 2) continue; b_ssd_out(p, l, vb, smem); }
        }
        xcd_barrier(xb);
        {
            const int ch = (ntok / 128) * (D / 128) / 8, bpx = (int)gridDim.x >> 3, j = (int)blockIdx.x >> 3, xc = (int)blockIdx.x & 7;
            const int rem = ch % bpx, nfull = (rem * 8 <= bpx) ? ch - rem : ch;
            for (int t = j; t < nfull; t += bpx) { const int vb = xc * ch + t; b_outproj<4, 4>(p, l, (vb >> 3) * 128, (vb & 7) * 128, smem); }
            for (int q = j; q < (ch - nfull) * 8; q += bpx) { const int vb = xc * ch + nfull + (q >> 3), sub = q & 7; b_outproj<2, 1>(p, l, (vb >> 3) * 128 + (sub >> 2) * 64, (vb & 7) * 128 + (sub & 3) * 32, smem); }
        }
        xcd_barrier(xb);
        FOR_VB(ntok / 16) b_norm2r(p, l, vb, smem);
        xcd_barrier(xb);
        const int nbig = moe_row_tiles(p.cnt + l * NEXP) * 4, mch = (nbig + 7) >> 3, bpx = (int)gridDim.x >> 3, mj = (int)blockIdx.x >> 3;
        const int mlo = ((int)blockIdx.x & 7) * mch, mcnt = max(min(mlo + mch, nbig) - mlo, 0), mrem = mcnt % bpx;
        const int msplit = (mrem == 0) ? 1 : (mrem * 4 <= bpx) ? 4 : (mrem * 2 <= bpx) ? 2 : 1, mfull = msplit > 1 ? mcnt - mrem : mcnt;
        for (int t = mj; t < mfull; t += bpx) { const int bt = mlo + t; b_moe_up<8>(p, l, bt >> 2, (bt & 3) * 128, smem); }
        if (msplit == 4) { for (int q = mj; q < mrem * 4; q += bpx) { const int bt = mlo + mfull + (q >> 2); b_moe_up<2>(p, l, bt >> 2, (bt & 3) * 128 + (q & 3) * 32, smem); } }
        else if (msplit == 2) { for (int q = mj; q < mrem * 2; q += bpx) { const int bt = mlo + mfull + (q >> 1); b_moe_up<4>(p, l, bt >> 2, (bt & 3) * 128 + (q & 1) * 64, smem); } }
        xcd_barrier(xb);
        for (int t = mj; t < mfull; t += bpx) { const int bt = mlo + t; b_moe_down<8>(p, l, bt >> 2, (bt & 3) * 256, smem); }
        if (msplit == 4) { for (int q = mj; q < mrem * 4; q += bpx) { const int bt = mlo + mfull + (q >> 2); b_moe_down<2>(p, l, bt >> 2, (bt & 3) * 256 + (q & 3) * 64, smem); } }
        else if (msplit == 2) { for (int q = mj; q < mrem * 2; q += bpx) { const int bt = mlo + mfull + (q >> 1); b_moe_down<4>(p, l, bt >> 2, (bt & 3) * 256 + (q & 1) * 128, smem); } }
        xcd_barrier(xb);
    }
    FOR_VB(NLAT / 4) b_final(p, vb);
}

extern "C" void kernel_launch(void* const* d_in, const int* in_sizes, int n_in, void* d_out, int out_size, void* d_ws, size_t ws_size, hipStream_t stream) {
    P p{};
    const float** f = (const float**)&p;
    for (int i = 0; i < 25; ++i) f[i] = (const float*)d_in[i];
    p.out = (float*)d_out;
    char* w = (char*)d_ws; size_t off = 0;
    auto take = [&](size_t bytes) { char* r = w + off; off += (bytes + 255) & ~(size_t)255; return r; };
    p.X = (float*)take((size_t)NTOK * D * 4);
    p.MOD = (float*)take((size_t)DEPTH * 5 * 6 * D * 4);
    p.DT = (float*)take((size_t)NTOK * 16 * 4);
    p.SSQ = (float*)take((size_t)NTOK * 8 * 4);
    p.SYNC = (unsigned*)take((size_t)(SY_LAYER + DEPTH * SY_STRIDE) * 4);
    p.ST = (float*)take((size_t)NB * NCH * 16 * 4096 * 4);
    p.DEC = (float*)take((size_t)NB * NCH * 16 * 4);
    p.HS = (bf16_t*)take((size_t)NB * NCH * 16 * 4096 * 2);
    p.gatew = (float*)take((size_t)NTOK * 2 * 4);
    p.H = (bf16_t*)take((size_t)NTOK * D * 2);
    p.PROJ = (bf16_t*)take((size_t)NTOK * PC * 2);
    p.WT_IN = (bf16_t*)take((size_t)DEPTH * PCW * D * 2);
    p.WT_R = (bf16_t*)take((size_t)DEPTH * 128 * D * 2);
    p.WT_OUT = (bf16_t*)take((size_t)DEPTH * D * D * 2);
    p.WT_G = (bf16_t*)take((size_t)DEPTH * NEXP * DEXP * D * 2);
    p.WT_U = (bf16_t*)take((size_t)DEPTH * NEXP * DEXP * D * 2);
    p.WT_D = (bf16_t*)take((size_t)DEPTH * NEXP * DEXP * D * 2);
    p.MIXO = (bf16_t*)take((size_t)NTOK * D * 2);
    p.HID = (bf16_t*)take((size_t)(NTOK * 2 + 128) * DEXP * 2);
    p.YS = (bf16_t*)take((size_t)(NTOK * 2 + 128) * D * 2);
    p.cnt = (int*)take((size_t)DEPTH * NEXP * 4);
    p.list = (int*)take((size_t)NEXP * NTOK * 4);
    p.pos = (int*)take((size_t)NTOK * 2 * 4);
    p.VT = (bf16_t*)take((size_t)NB * 4 * 64 * NKEY * 2);
    p.VTA = (bf16_t*)take((size_t)NB * 2 * 64 * NKEY * 2);
    p.bar = (unsigned*)take((size_t)(XCD_BAR_WORDS + 4096) * 4); p.cuslot = p.bar + XCD_BAR_WORDS;
    p.ROPE = (float*)take((size_t)64 * 24 * 2 * 4);
    p.KMAX = (unsigned*)take((size_t)DEPTH * NB * 10 * 4);
    if (off > ws_size) { fprintf(stderr, "workspace too small: need %zu have %zu\n", off, ws_size); return; }

    (void)hipMemsetAsync(p.bar, 0, (XCD_BAR_WORDS + 4096) * 4, stream);
    static int grid_blocks = 0;
    if (!grid_blocks) {
        int dev = 0, cus = 0, per_cu = 0;
        (void)hipGetDevice(&dev);
        (void)hipDeviceGetAttribute(&cus, hipDeviceAttributeMultiprocessorCount, dev);
        if (hipFuncSetAttribute((const void*)k_mega, hipFuncAttributeMaxDynamicSharedMemorySize, LDS_BYTES) != hipSuccess) fprintf(stderr, "hipFuncSetAttribute(LDS %d) failed\n", LDS_BYTES);
        (void)hipOccupancyMaxActiveBlocksPerMultiprocessor(&per_cu, k_mega, 256, LDS_BYTES);
        if (per_cu > 2) per_cu = 2;
        grid_blocks = cus * per_cu;
    }
    void* args[] = {&p};
    hipError_t e = hipLaunchCooperativeKernel((void*)k_mega, dim3(grid_blocks), dim3(256), args, LDS_BYTES, stream);
    if (e != hipSuccess) fprintf(stderr, "cooperative launch failed: %s (grid %d)\n", hipGetErrorString(e), grid_blocks);
}
```

```cpp
#include <hip/hip_runtime.h>
#include <cstdio>
#include <cstdint>

typedef unsigned short bf16_t;
typedef short bf16x8 __attribute__((ext_vector_type(8)));
typedef float f32x4 __attribute__((ext_vector_type(4)));
typedef unsigned u32x4 __attribute__((ext_vector_type(4)));
typedef float f32x16 __attribute__((ext_vector_type(16)));

constexpr int D = 1024, NB = 4, L = 4096, LC = 256, NLAT = NB * L, NCTX = NB * LC, NTOK = NLAT + NCTX, DEPTH = 4;
constexpr int IN_COLS = 2576, OLD_BDT = 1792;
constexpr int PC = 2560;
constexpr int PCW = 2688;
constexpr int P_AQ = 0, P_AK = 256, P_AV = 384, P_BZ = 512, P_BX = 1024, P_CQ = 1792, P_CK = 2048, P_CV = 2304;
constexpr int NEXP = 32, DEXP = 512;
constexpr int NKEY = L + LC;
constexpr int NKT = NKEY / 64;
constexpr float EPS = 1e-6f;

__device__ __forceinline__ int otid() { int t = threadIdx.x; asm volatile("" : "+v"(t)); return t; }
typedef __bf16 bf16n2 __attribute__((ext_vector_type(2)));
__device__ __forceinline__ bf16_t f2bf(float f) { return __builtin_bit_cast(bf16_t, (__bf16)f); }
__device__ __forceinline__ unsigned pack_bf16(float a, float b) { const bf16n2 v = {(__bf16)a, (__bf16)b}; return __builtin_bit_cast(unsigned, v); }
__device__ __forceinline__ float bf2f(bf16_t h) { return __uint_as_float(((unsigned)h) << 16); }
__device__ __forceinline__ float wave_sum(float v) {
#pragma unroll
    for (int o = 32; o > 0; o >>= 1) v += __shfl_xor(v, o);
    return v;
}
__device__ __forceinline__ float siluf(float v) { return v * __builtin_amdgcn_rcpf(1.f + __expf(-v)); }
__device__ __forceinline__ int tok_modrow(int tok) { return tok < NLAT ? tok / L : NB; }

struct P {
    const float *x, *c, *ctx, *c_ctx, *w_mod, *b_mod, *norm1_w, *norm2_w, *w_in, *w_out, *a_sink, *conv_w, *conv_b, *dt_bias, *a_log, *d_skip,
        *b_norm_w, *c_lambda, *c_subln_w, *w_grouter, *w_router, *w_gate, *w_up, *w_down, *final_w;
    float* out;
    float* X; float* MOD; float* DT; float* SSQ; float* gatew; float* ST; float* DEC; float* ROPE;
    bf16_t *H, *PROJ, *WT_IN, *WT_OUT, *WT_G, *WT_U, *WT_D, *MIXO, *HID, *YS, *VT, *VTA, *HS, *WT_R;
    int *cnt, *list, *pos;
    unsigned* bar; unsigned* cuslot;
    unsigned* SYNC;
    unsigned* KMAX;
};

__device__ __forceinline__ void b_convT(float (*t)[65], int bx, int by, int bz, const float* __restrict__ src, bf16_t* __restrict__ dst, int K, int ld_src, int c0, int ncols, int n_dst0,
                                        long src_bstride, long dst_bstride) {
    src += (long)bz * src_bstride; dst += (long)bz * dst_bstride;
    const int kb = by * 64, nb = bx * 64, tid = otid();
    const int c4 = (tid & 15) * 4, kr0 = tid >> 4;
#pragma unroll
    for (int i = 0; i < 4; ++i) {
        const int kr = kr0 + i * 16;
        float4 v = make_float4(0.f, 0.f, 0.f, 0.f);
        if (nb + c4 < ncols) v = *(const float4*)(src + (long)(kb + kr) * ld_src + c0 + nb + c4);
        t[kr][c4] = v.x; t[kr][c4 + 1] = v.y; t[kr][c4 + 2] = v.z; t[kr][c4 + 3] = v.w;
    }
    __syncthreads();
    const int n = tid >> 2, kq = (tid & 3) * 16;
    if (nb + n < ncols) {
        unsigned o[8];
#pragma unroll
        for (int j = 0; j < 8; ++j) o[j] = (unsigned)f2bf(t[kq + 2 * j][n]) | ((unsigned)f2bf(t[kq + 2 * j + 1][n]) << 16);
        bf16_t* d = dst + (long)(n_dst0 + nb + n) * K + kb + kq;
        *(u32x4*)d = (u32x4){o[0], o[1], o[2], o[3]};
        *(u32x4*)(d + 8) = (u32x4){o[4], o[5], o[6], o[7]};
    }
    __syncthreads();
}

__device__ __forceinline__ void b_convT_stream(int vb, const float* __restrict__ src, bf16_t* __restrict__ dst, int K, int N, const float* rowscale = nullptr,
                                               int ld_src = 0, int c0 = 0, int n_dst0 = 0, long src_ms = 0, long dst_ms = 0) {
    const int tid = otid(), lane = tid & 63;
    const int gw = vb * 4 + (tid >> 6);
    const int nbs = N >> 6, kbs = K >> 6;
    const int mat = gw / (nbs * kbs), r = gw % (nbs * kbs), kb = r / nbs, nb = r % nbs;
    const int kq = lane & 3, n4l = lane >> 2;
    if (ld_src == 0) { ld_src = N; src_ms = (long)K * N; dst_ms = (long)K * N; }
    const float* sp = src + mat * src_ms + (long)(kb * 64 + kq * 8) * ld_src + c0 + nb * 64 + n4l * 4;
    float4 v[16];
#pragma unroll
    for (int j = 0; j < 16; ++j) v[j] = *(const float4*)(sp + (long)((j & 7) + (j >> 3) * 32) * ld_src);
    if (rowscale) {
        const int k0 = kb * 64 + kq * 8;
        if (k0 >= 256 && k0 < 768) {
#pragma unroll
            for (int j = 0; j < 16; ++j) { const float sc = rowscale[mat * 512 + k0 - 256 + (j & 7) + (j >> 3) * 32]; v[j].x *= sc; v[j].y *= sc; v[j].z *= sc; v[j].w *= sc; }
        }
    }
    bf16_t* dp = dst + mat * dst_ms + (long)(n_dst0 + nb * 64 + n4l * 4) * K + kb * 64 + kq * 8;
    u32x4 o0, o1;
#pragma unroll
    for (int j = 0; j < 4; ++j) { o0[j] = pack_bf16(v[2 * j].x, v[2 * j + 1].x); o1[j] = pack_bf16(v[8 + 2 * j].x, v[8 + 2 * j + 1].x); }
    *(u32x4*)dp = o0; *(u32x4*)(dp + 32) = o1;
#pragma unroll
    for (int j = 0; j < 4; ++j) { o0[j] = pack_bf16(v[2 * j].y, v[2 * j + 1].y); o1[j] = pack_bf16(v[8 + 2 * j].y, v[8 + 2 * j + 1].y); }
    *(u32x4*)(dp + K) = o0; *(u32x4*)(dp + K + 32) = o1;
#pragma unroll
    for (int j = 0; j < 4; ++j) { o0[j] = pack_bf16(v[2 * j].z, v[2 * j + 1].z); o1[j] = pack_bf16(v[8 + 2 * j].z, v[8 + 2 * j + 1].z); }
    *(u32x4*)(dp + 2 * K) = o0; *(u32x4*)(dp + 2 * K + 32) = o1;
#pragma unroll
    for (int j = 0; j < 4; ++j) { o0[j] = pack_bf16(v[2 * j].w, v[2 * j + 1].w); o1[j] = pack_bf16(v[8 + 2 * j].w, v[8 + 2 * j + 1].w); }
    *(u32x4*)(dp + 3 * K) = o0; *(u32x4*)(dp + 3 * K + 32) = o1;
}

__device__ __forceinline__ void b_rope_table(const P& p, int vb) {
    const int idx = vb * 256 + otid();
    if (idx >= 64 * 24) return;
    const int pos = idx / 24, f = idx % 24;
    const float fr = f < 16 ? __expf(-(float)f * (1.f / 16.f) * 9.210340371976184f) : __expf(-(float)(f - 16) * (1.f / 8.f) * 9.210340371976184f);
    float sn, cs; sincosf((float)pos * fr, &sn, &cs);
    p.ROPE[idx * 2] = cs; p.ROPE[idx * 2 + 1] = sn;
}

__device__ __forceinline__ void b_mod(const P& p, int vb, float* red) {
    const int tid = otid(), lane = tid & 63, kq = tid >> 6, ks = lane >> 4, c4 = (lane & 15) * 4;
    const int idx = vb * 64 + c4;
    const int l = idx / (6 * D), n = idx % (6 * D);
    float acc[5][4];
#pragma unroll
    for (int r = 0; r < 5; ++r)
#pragma unroll
        for (int e = 0; e < 4; ++e) acc[r][e] = 0.f;
    const float* w = p.w_mod + (long)l * D * 6 * D + n;
#pragma unroll 8
    for (int k = kq * 256 + ks; k < kq * 256 + 256; k += 4) {
        const float4 wv = *(const float4*)(w + (long)k * 6 * D);
#pragma unroll
        for (int r = 0; r < 5; ++r) {
            const float cv = siluf((r < 4) ? p.c[r * D + k] : p.c_ctx[k]);
            acc[r][0] += cv * wv.x; acc[r][1] += cv * wv.y; acc[r][2] += cv * wv.z; acc[r][3] += cv * wv.w;
        }
    }
#pragma unroll
    for (int r = 0; r < 5; ++r)
#pragma unroll
        for (int e = 0; e < 4; ++e) { float v = acc[r][e]; v += __shfl_xor(v, 16); v += __shfl_xor(v, 32); acc[r][e] = v; }
    __syncthreads();
    if (ks == 0) {
#pragma unroll
        for (int r = 0; r < 5; ++r) *(float4*)(red + (kq * 5 + r) * 64 + c4) = make_float4(acc[r][0], acc[r][1], acc[r][2], acc[r][3]);
    }
    __syncthreads();
    if (tid < 64) {
        const int col = tid, i2 = vb * 64 + col, n2 = i2 % (6 * D);
        const float bv = p.b_mod[l * 6 * D + n2];
#pragma unroll
        for (int r = 0; r < 5; ++r) p.MOD[((long)l * 5 + r) * 6 * D + n2] = ((red[(0 * 5 + r) * 64 + col] + red[(1 * 5 + r) * 64 + col]) + (red[(2 * 5 + r) * 64 + col] + red[(3 * 5 + r) * 64 + col])) + bv;
    }
}

__device__ __forceinline__ void wt_store(float* ptr, float v) { __hip_atomic_store(ptr, v, __ATOMIC_RELAXED, __HIP_MEMORY_SCOPE_AGENT); }
__device__ __forceinline__ void wt_store(unsigned* ptr, unsigned v) { __hip_atomic_store(ptr, v, __ATOMIC_RELAXED, __HIP_MEMORY_SCOPE_AGENT); }
__device__ __forceinline__ void wt_store8(void* ptr, unsigned lo, unsigned hi) { __hip_atomic_store((unsigned long long*)ptr, ((unsigned long long)hi << 32) | lo, __ATOMIC_RELAXED, __HIP_MEMORY_SCOPE_AGENT); }
__device__ __forceinline__ void unit_publish(unsigned* cnt) {
    asm volatile("s_waitcnt vmcnt(0)" ::: "memory");
    __syncthreads();
    if (threadIdx.x == 0) (void)__hip_atomic_fetch_add(cnt, 1u, __ATOMIC_RELAXED, __HIP_MEMORY_SCOPE_AGENT);
}
__device__ __forceinline__ void unit_wait(unsigned* cnt, unsigned target) {
    if (threadIdx.x == 0) {
        unsigned sp = 0;
        while (__hip_atomic_load(cnt, __ATOMIC_RELAXED, __HIP_MEMORY_SCOPE_AGENT) < target) { __builtin_amdgcn_s_sleep(2); if (++sp > (1u << 24)) break; }
        __builtin_amdgcn_fence(__ATOMIC_ACQUIRE, "agent");
        asm volatile("s_waitcnt vmcnt(0)" ::: "memory");
    }
    __syncthreads();
}

__device__ __forceinline__ void unit_wait_nf(unsigned* cnt, unsigned target) {
    if (threadIdx.x == 0) {
        unsigned sp = 0;
        while (__hip_atomic_load(cnt, __ATOMIC_RELAXED, __HIP_MEMORY_SCOPE_AGENT) < target) { __builtin_amdgcn_s_sleep(2); if (++sp > (1u << 24)) break; }
    }
    __syncthreads();
    asm volatile("" ::: "memory");
}
constexpr int SY_LAYER = 64, SY_STRIDE = 1024, SY_N1 = 0, SY_OP = 136, SY_N2 = 272, SY_UP = 408;
__device__ __forceinline__ unsigned* sync_ctr(const P& p, int l, int which, int idx) { return p.SYNC + SY_LAYER + l * SY_STRIDE + which + idx; }

__device__ __forceinline__ void b_norm1(const P& p, int l, int vb) {
    const int wave = otid() >> 6, lane = otid() & 63;
#pragma unroll 1
    for (int i4 = 0; i4 < 4; ++i4) {
        const int tok = vb * 16 + wave * 4 + i4;
        float v[16];
        const float* src = (l == 0) ? (tok < NLAT ? p.x + (long)tok * D : p.ctx + (long)(tok - NLAT) * D) : p.X + (long)tok * D;
#pragma unroll
        for (int i = 0; i < 4; ++i) { const float4 t = *(const float4*)(src + i * 256 + lane * 4); v[i * 4 + 0] = t.x; v[i * 4 + 1] = t.y; v[i * 4 + 2] = t.z; v[i * 4 + 3] = t.w; }
        if (l > 0) {
            const bf16_t* ys0 = p.YS + (long)p.pos[tok * 2 + 0] * D; const bf16_t* ys1 = p.YS + (long)p.pos[tok * 2 + 1] * D;
            const float* g2 = p.MOD + ((long)(l - 1) * 5 + tok_modrow(tok)) * 6 * D + 5 * D;
#pragma unroll
            for (int i = 0; i < 4; ++i) {
                const uint2 t = *(const uint2*)(ys0 + i * 256 + lane * 4), u = *(const uint2*)(ys1 + i * 256 + lane * 4);
                const float4 g = *(const float4*)(g2 + i * 256 + lane * 4);
                v[i * 4 + 0] += (bf2f((bf16_t)(t.x & 0xffff)) + bf2f((bf16_t)(u.x & 0xffff))) * g.x; v[i * 4 + 1] += (bf2f((bf16_t)(t.x >> 16)) + bf2f((bf16_t)(u.x >> 16))) * g.y;
                v[i * 4 + 2] += (bf2f((bf16_t)(t.y & 0xffff)) + bf2f((bf16_t)(u.y & 0xffff))) * g.z; v[i * 4 + 3] += (bf2f((bf16_t)(t.y >> 16)) + bf2f((bf16_t)(u.y >> 16))) * g.w;
            }
        }
        float* xo = p.X + (long)tok * D;
#pragma unroll
        for (int i = 0; i < 4; ++i) *(float4*)(xo + i * 256 + lane * 4) = make_float4(v[i * 4 + 0], v[i * 4 + 1], v[i * 4 + 2], v[i * 4 + 3]);
        float ss = 0.f;
#pragma unroll
        for (int i = 0; i < 16; ++i) ss += v[i] * v[i];
        ss = wave_sum(ss);
        const float r = rsqrtf(ss * (1.f / D) + EPS);
        const float* m = p.MOD + ((long)l * 5 + tok_modrow(tok)) * 6 * D;
        const float* nw = p.norm1_w + l * D;
        bf16_t* ho = p.H + (long)tok * D;
#pragma unroll
        for (int i = 0; i < 4; ++i) {
            const int k = i * 256 + lane * 4;
            const float4 w4 = *(const float4*)(nw + k), sc = *(const float4*)(m + D + k), sh = *(const float4*)(m + k);
            wt_store8(ho + k, pack_bf16(v[i * 4 + 0] * r * w4.x * (1.f + sc.x) + sh.x, v[i * 4 + 1] * r * w4.y * (1.f + sc.y) + sh.y),
                              pack_bf16(v[i * 4 + 2] * r * w4.z * (1.f + sc.z) + sh.z, v[i * 4 + 3] * r * w4.w * (1.f + sc.w) + sh.w));
        }
    }
    unit_publish(sync_ctr(p, l, SY_N1, vb >> 3));
}

#define LAS __attribute__((address_space(3)))
constexpr int LDS_STRIDE = 72;
constexpr int SMEM_BYTES = 65536;
constexpr int LDS_BYTES = SMEM_BYTES + 256;
struct NoHook { template <class A> __device__ __forceinline__ void operator()(int, A&) const {} };
template <int MI = 4, int NI = 4, class RowA, class RowB, class Epi, class Hook = NoHook>
__device__ __forceinline__ void gemm_tile(const RowA& ra, const RowB& rb, int K, bf16_t* smem, const Epi& epi, const Hook& hook = Hook()) {
    LAS unsigned char* lds = (LAS unsigned char*)smem;
    const int tid = otid(), lane = tid & 63, w = __builtin_amdgcn_readfirstlane(tid >> 6), wm = w >> 1, wn = w & 1, lr = lane & 15, lq = lane >> 4;
    f32x4 acc[MI][NI];
#pragma unroll
    for (int i = 0; i < MI; ++i)
#pragma unroll
        for (int j = 0; j < NI; ++j) acc[i][j] = (f32x4){0.f, 0.f, 0.f, 0.f};
    const bf16_t* pa[MI]; const bf16_t* pb[NI];
    const int kcs = ((lane & 7) ^ ((lane >> 3) & 7)) * 8;
#pragma unroll
    for (int i = 0; i < MI; ++i) pa[i] = ra((i * 4 + w) * 8 + (lane >> 3)) + kcs;
#pragma unroll
    for (int i = 0; i < NI; ++i) pb[i] = rb((i * 4 + w) * 8 + (lane >> 3)) + kcs;
    auto stage = [&](int buf, int k0) {
#pragma unroll
        for (int i = 0; i < MI; ++i) __builtin_amdgcn_global_load_lds((const unsigned*)(pa[i] + k0), (LAS unsigned*)(lds + buf * 32768 + (i * 4 + w) * 1024), 16, 0, 0);
#pragma unroll
        for (int i = 0; i < NI; ++i) __builtin_amdgcn_global_load_lds((const unsigned*)(pb[i] + k0), (LAS unsigned*)(lds + buf * 32768 + 16384 + (i * 4 + w) * 1024), 16, 0, 0);
    };
    const int aoff = (wm * MI * 16 + lr) * 128 + ((lq ^ (lr & 7)) << 4), boff = 16384 + (wn * NI * 16 + lr) * 128 + ((lq ^ (lr & 7)) << 4);
    const int nk = K >> 6;
    __syncthreads();
    stage(0, 0);
    for (int kt = 0; kt < nk; ++kt) {
        asm volatile("s_waitcnt vmcnt(0)" ::: "memory");
        __syncthreads();
        if (kt + 1 < nk) stage((kt + 1) & 1, (kt + 1) * 64);
        hook(kt, acc);
        const LAS unsigned char* bs = lds + (kt & 1) * 32768;
#pragma unroll
        for (int ks = 0; ks < 2; ++ks) {
            bf16x8 xa[MI], wb[NI];
#pragma unroll
            for (int i = 0; i < MI; ++i) xa[i] = *(const LAS bf16x8*)(bs + (aoff ^ (ks << 6)) + i * 2048);
#pragma unroll
            for (int i = 0; i < NI; ++i) wb[i] = *(const LAS bf16x8*)(bs + (boff ^ (ks << 6)) + i * 2048);
#pragma unroll
            for (int mi = 0; mi < MI; ++mi)
#pragma unroll
                for (int ni = 0; ni < NI; ++ni) acc[mi][ni] = __builtin_amdgcn_mfma_f32_16x16x32_bf16(wb[ni], xa[mi], acc[mi][ni], 0, 0, 0);
        }
    }
    epi(acc, wm, wn, lr, lq);
}

template <int MI, int NI, class RowA, class RowB, class Epi>
__device__ __forceinline__ void gemm_tile32(const RowA& ra, const RowB& rb, int K, bf16_t* smem, const Epi& epi) {
    LAS unsigned char* lds = (LAS unsigned char*)smem;
    const int tid = otid(), lane = tid & 63, w = __builtin_amdgcn_readfirstlane(tid >> 6), wm = w >> 1, wn = w & 1, lr = lane & 15, lq = lane >> 4;
    constexpr int ABYTES = MI * 32 * 64, STG = (MI + NI) * 32 * 64, PA = MI / 2, PB = NI / 2;
    f32x4 acc[MI][NI];
#pragma unroll
    for (int i = 0; i < MI; ++i)
#pragma unroll
        for (int j = 0; j < NI; ++j) acc[i][j] = (f32x4){0.f, 0.f, 0.f, 0.f};
    const bf16_t* pa[PA]; const bf16_t* pb[PB];
    const int kcs = ((lane & 3) ^ ((4 - ((lane >> 4) & 3)) & 3)) * 8;
#pragma unroll
    for (int i = 0; i < PA; ++i) pa[i] = ra((i * 4 + w) * 16 + (lane >> 2)) + kcs;
#pragma unroll
    for (int i = 0; i < PB; ++i) pb[i] = rb((i * 4 + w) * 16 + (lane >> 2)) + kcs;
    auto stage = [&](int buf, int k0) {
#pragma unroll
        for (int i = 0; i < PA; ++i) __builtin_amdgcn_global_load_lds((const unsigned*)(pa[i] + k0), (LAS unsigned*)(lds + buf * STG + (i * 4 + w) * 1024), 16, 0, 0);
#pragma unroll
        for (int i = 0; i < PB; ++i) __builtin_amdgcn_global_load_lds((const unsigned*)(pb[i] + k0), (LAS unsigned*)(lds + buf * STG + ABYTES + (i * 4 + w) * 1024), 16, 0, 0);
    };
    const int fsw = (lq ^ ((4 - ((lr >> 2) & 3)) & 3)) << 4;
    const int aoff = (wm * MI * 16 + lr) * 64 + fsw, boff = ABYTES + (wn * NI * 16 + lr) * 64 + fsw;
    const int nk = K >> 5;
    __syncthreads();
    stage(0, 0);
    for (int kt = 0; kt < nk; ++kt) {
        asm volatile("s_waitcnt vmcnt(0)" ::: "memory");
        __syncthreads();
        if (kt + 1 < nk) stage((kt + 1) & 1, (kt + 1) * 32);
        const LAS unsigned char* bs = lds + (kt & 1) * STG;
        bf16x8 xa[MI], wb[NI];
#pragma unroll
        for (int i = 0; i < MI; ++i) xa[i] = *(const LAS bf16x8*)(bs + aoff + i * 1024);
#pragma unroll
        for (int i = 0; i < NI; ++i) wb[i] = *(const LAS bf16x8*)(bs + boff + i * 1024);
#pragma unroll
        for (int mi = 0; mi < MI; ++mi)
#pragma unroll
            for (int ni = 0; ni < NI; ++ni) acc[mi][ni] = __builtin_amdgcn_mfma_f32_16x16x32_bf16(wb[ni], xa[mi], acc[mi][ni], 0, 0, 0);
    }
    epi(acc, wm, wn, lr, lq);
}

struct RowLin { const bf16_t* base; long ld; __device__ __forceinline__ const bf16_t* operator()(int r) const { return base + (long)r * ld; } };

__device__ __forceinline__ void b_inproj(const P& p, int l, int vb, bf16_t* smem) {
    const int mt = vb / (PCW / 128), nt = vb % (PCW / 128);
    RowLin ra{p.H + (long)mt * 128 * D, D}, rb{p.WT_IN + ((long)l * PCW + nt * 128) * D, D};
    unit_wait_nf(sync_ctr(p, l, SY_N1, mt), 8u);
    if (nt == 20) {
        auto epi_dt = [&](const f32x4 (&acc)[4][1], int wm, int wn, int lr, int lq) {
            if (wn == 0) {
#pragma unroll
                for (int mi = 0; mi < 4; ++mi) *(f32x4*)(p.DT + (long)(mt * 128 + wm * 64 + mi * 16 + lr) * 16 + lq * 4) = acc[mi][0];
            }
        };
        gemm_tile<4, 1>(ra, rb, D, smem, epi_dt);
        return;
    }
    const bool latent = mt < NLAT / 128;
    const int kind = (nt == 20) ? 3 : (nt == 3 || nt == 18 || nt == 19) ? 2 : (latent && nt <= 2) ? 0 : (latent && nt >= 14 && nt <= 17) ? 1 : 4;
    constexpr int OS = 136;
    auto epi = [&](f32x4 (&acc)[4][4], int wm, int wn, int lr, int lq) {
        if (kind == 3) {
            if (wn == 0) {
#pragma unroll
                for (int mi = 0; mi < 4; ++mi) *(f32x4*)(p.DT + (long)(mt * 128 + wm * 64 + mi * 16 + lr) * 16 + lq * 4) = acc[mi][0];
            }
            return;
        }
        if (nt == 2 || nt == 16 || nt == 17) {
            const int b = latent ? mt / (L / 128) : (mt - NLAT / 128) / (LC / 128);
#pragma unroll
            for (int half = 0; half < 2; ++half) {
                float mxv = 0.f;
#pragma unroll
                for (int mi = 0; mi < 4; ++mi) {
                    float ssq = 0.f;
#pragma unroll
                    for (int n2 = 0; n2 < 2; ++n2)
#pragma unroll
                        for (int e = 0; e < 4; ++e) { const float v = acc[mi][2 * half + n2][e]; ssq += v * v; }
                    ssq += __shfl_xor(ssq, 16); ssq += __shfl_xor(ssq, 32);
                    mxv = fmaxf(mxv, ssq);
                }
                if (nt == 2) {
                    const float other = mxv;
                    (void)other;
                }
                if (nt != 2) {
#pragma unroll
                    for (int o = 1; o < 16; o <<= 1) mxv = fmaxf(mxv, __shfl_xor(mxv, o));
                    if ((otid() & 63) == 0) atomicMax(&p.KMAX[(l * NB + b) * 10 + (nt - 16) * 4 + wn * 2 + half], __float_as_uint(mxv));
                }
            }
            if (nt == 2) {
                float mxv = 0.f;
#pragma unroll
                for (int mi = 0; mi < 4; ++mi) {
                    float ssq = 0.f;
#pragma unroll
                    for (int ni = 0; ni < 4; ++ni)
#pragma unroll
                        for (int e = 0; e < 4; ++e) { const float v = acc[mi][ni][e]; ssq += v * v; }
                    ssq += __shfl_xor(ssq, 16); ssq += __shfl_xor(ssq, 32);
                    mxv = fmaxf(mxv, ssq);
                }
#pragma unroll
                for (int o = 1; o < 16; o <<= 1) mxv = fmaxf(mxv, __shfl_xor(mxv, o));
                if ((otid() & 63) == 0) atomicMax(&p.KMAX[(l * NB + b) * 10 + 8 + wn], __float_as_uint(mxv));
            }
        }
        if (kind == 0) {
#pragma unroll
            for (int mi = 0; mi < 4; ++mi) {
                const int i = (mt * 128 + wm * 64 + mi * 16 + lr) & (L - 1);
#pragma unroll
                for (int hf = 0; hf < 2; ++hf) {
                    const int pos = hf ? (i & 63) : (i >> 6);
                    const float* tb = p.ROPE + (pos * 24 + lq * 4) * 2;
                    const f32x4 t0 = *(const f32x4*)tb, t1 = *(const f32x4*)(tb + 4);
                    const float cs[4] = {t0[0], t0[2], t1[0], t1[2]}, sn[4] = {t0[1], t0[3], t1[1], t1[3]};
#pragma unroll
                    for (int e = 0; e < 4; ++e) {
                        const float u1 = acc[mi][2 * hf][e], u2 = acc[mi][2 * hf + 1][e];
                        acc[mi][2 * hf][e] = u1 * cs[e] - u2 * sn[e]; acc[mi][2 * hf + 1][e] = u1 * sn[e] + u2 * cs[e];
                    }
                }
            }
        } else if (kind == 1) {
#pragma unroll
            for (int mi = 0; mi < 4; ++mi) {
                const int i = (mt * 128 + wm * 64 + mi * 16 + lr) & (L - 1);
#pragma unroll
                for (int hf = 0; hf < 2; ++hf) {
                    const int pos = hf ? (i & 63) : (i >> 6);
                    const float* tb = p.ROPE + (pos * 24 + 16 + (lq & 1) * 4) * 2;
                    const f32x4 t0 = *(const f32x4*)tb, t1 = *(const f32x4*)(tb + 4);
                    const float cs[4] = {t0[0], t0[2], t1[0], t1[2]}, sn[4] = {t0[1], t0[3], t1[1], t1[3]};
#pragma unroll
                    for (int n2 = 0; n2 < 2; ++n2) {
                        const int ni = 2 * n2 + hf;
#pragma unroll
                        for (int e = 0; e < 4; ++e) {
                            const float v = acc[mi][ni][e], pv = __shfl_xor(v, 32);
                            acc[mi][ni][e] = lq < 2 ? v * cs[e] - pv * sn[e] : pv * sn[e] + v * cs[e];
                        }
                    }
                }
            }
        }
        __syncthreads();
        if (kind == 2) {
#pragma unroll
            for (int mi = 0; mi < 4; ++mi) {
                const int m = wm * 64 + mi * 16 + lr, mp = (m & ~12) | ((m & 4) << 1) | ((m & 8) >> 1);
#pragma unroll
                for (int ni = 0; ni < 4; ++ni)
#pragma unroll
                    for (int e = 0; e < 4; ++e) smem[(wn * 64 + ni * 16 + lq * 4 + e) * OS + mp] = f2bf(acc[mi][ni][e]);
            }
        } else {
#pragma unroll
            for (int mi = 0; mi < 4; ++mi)
#pragma unroll
                for (int ni = 0; ni < 4; ++ni) {
                    const f32x4 a = acc[mi][ni];
                    uint2 o; o.x = pack_bf16(a[0], a[1]); o.y = pack_bf16(a[2], a[3]);
                    *(uint2*)(smem + (wm * 64 + mi * 16 + lr) * OS + wn * 64 + ni * 16 + lq * 4) = o;
                }
        }
        __syncthreads();
        const int tid = otid();
        if (kind == 2) {
            const int nh = nt == 3 ? 2 : 4, hbase = nt == 3 ? 0 : (nt - 18) * 2;
            bf16_t* vtb = nt == 3 ? p.VTA : p.VT;
            const int b = latent ? mt / (L / 128) : (mt - NLAT / 128) / (LC / 128);
            const int key0 = latent ? (mt % (L / 128)) * 128 : L + ((mt - NLAT / 128) % (LC / 128)) * 128;
#pragma unroll
            for (int i2 = 0; i2 < 8; ++i2) {
                const int idx = tid + i2 * 256, n = idx >> 4, mc = (idx & 15) * 8;
                const u32x4 v = *(const u32x4*)(smem + n * OS + mc);
                *(u32x4*)(vtb + ((long)(b * nh + hbase + (n >> 6)) * 64 + (n & 63)) * NKEY + key0 + mc) = v;
            }
        } else {
            bf16_t* out = p.PROJ + (long)mt * 128 * PC + nt * 128;
#pragma unroll
            for (int i2 = 0; i2 < 8; ++i2) {
                const int idx = tid + i2 * 256, m = idx >> 4, nc = (idx & 15) * 8;
                *(u32x4*)(out + (long)m * PC + nc) = *(const u32x4*)(smem + m * OS + nc);
            }
        }
    };
    gemm_tile(ra, rb, D, smem, epi);
}

template <int MI, int NI>
__device__ __forceinline__ void b_outproj(const P& p, int l, int row0, int col0, bf16_t* smem) {
    RowLin ra{p.MIXO + (long)row0 * D, D}, rb{p.WT_OUT + ((long)l * D + col0) * D, D};
    auto epi = [&](const f32x4 (&acc)[MI][NI], int wm, int wn, int lr, int lq) {
#pragma unroll
        for (int mi = 0; mi < MI; ++mi) {
            const int tok = row0 + wm * MI * 16 + mi * 16 + lr;
            const float* g1 = p.MOD + ((long)l * 5 + tok_modrow(tok)) * 6 * D + 2 * D;
#pragma unroll
            for (int ni = 0; ni < NI; ++ni) {
                const int n = col0 + wn * NI * 16 + ni * 16 + lq * 4;
                const float4 g = *(const float4*)(g1 + n);
                float4* xp = (float4*)(p.X + (long)tok * D + n);
                float4 xv = *xp; const f32x4 a = acc[mi][ni];
                xv.x += g.x * a[0]; xv.y += g.y * a[1]; xv.z += g.z * a[2]; xv.w += g.w * a[3];
                *xp = xv;
            }
        }
    };
    float rs0[MI], rs1[MI];
    {
        const int lane = otid() & 63, w = otid() >> 6, wm0 = w >> 1, lr0 = lane & 15;
#pragma unroll
        for (int mi = 0; mi < MI; ++mi) {
            const float* sq = p.SSQ + (long)(row0 + wm0 * MI * 16 + mi * 16 + lr0) * 8;
            const f32x4 s0 = *(const f32x4*)sq, s1 = *(const f32x4*)(sq + 4);
            rs0[mi] = rsqrtf(((s0[0] + s0[1]) + (s0[2] + s0[3])) * (1.f / 256.f) + EPS); rs1[mi] = rsqrtf(((s1[0] + s1[1]) + (s1[2] + s1[3])) * (1.f / 256.f) + EPS);
        }
    }
    auto hook = [&](int kt, f32x4 (&acc)[MI][NI]) {
        if (kt == 4 || kt == 8 || kt == 12) {
#pragma unroll
            for (int mi = 0; mi < MI; ++mi) {
                const float f = kt == 4 ? 1.f / rs0[mi] : kt == 8 ? rs0[mi] / rs1[mi] : rs1[mi];
#pragma unroll
                for (int ni = 0; ni < NI; ++ni) acc[mi][ni] *= f;
            }
        }
    };
    gemm_tile<MI, NI>(ra, rb, D, smem, epi, hook);
}


__device__ __forceinline__ void b_attnC(const P& p, int l, int unit, bf16_t* smem) {
    const int tid = otid(), lane = tid & 63, w = tid >> 6, c = lane & 31, h = lane >> 5;
    const bool ctxq = unit >= NB * 4 * (L / 128);
    int b, hh, qb;
    if (!ctxq) { qb = unit & 31; hh = (unit >> 5) & 3; b = unit >> 7; }
    else { const int u = unit - NB * 4 * (L / 128); qb = u & 1; hh = (u >> 1) & 3; b = u >> 3; }
    const int tokq = (ctxq ? NLAT + b * LC : b * L) + qb * 128 + w * 32 + c;
    const int t0 = ctxq ? 64 : 0, nt = ctxq ? 4 : NKT;
    const float lambda_init = 0.8f - 0.6f * expf(-0.3f * (float)l);
    const float* cl = p.c_lambda + l * 128;
    const float d1 = wave_sum(h == 0 ? cl[c] * cl[32 + c] : 0.f), d2 = wave_sum(h == 0 ? cl[64 + c] * cl[96 + c] : 0.f);
    const float lam = expf(d1) - expf(d2) + lambda_init;
    bf16x8 qf[2][2];
    {
        const float qs = 0.17677669529663687f * 1.4426950408889634f;
        const bf16_t* qp = p.PROJ + (long)tokq * PC + P_CQ + hh * 64;
#pragma unroll
        for (int m = 0; m < 2; ++m)
#pragma unroll
            for (int s2 = 0; s2 < 2; ++s2) {
                const u32x4 raw = *(const u32x4*)(qp + m * 32 + s2 * 16 + h * 8);
                u32x4 sc;
#pragma unroll
                for (int e = 0; e < 4; ++e) sc[e] = pack_bf16(bf2f((bf16_t)(raw[e] & 0xffff)) * qs, bf2f((bf16_t)(raw[e] >> 16)) * qs);
                qf[m][s2] = __builtin_bit_cast(bf16x8, sc);
            }
    }
    LAS unsigned char* lds = (LAS unsigned char*)smem;
    const bf16_t* vtb = p.VT + (long)(b * 4 + hh) * 64 * NKEY;
    const int wu = __builtin_amdgcn_readfirstlane(w);
    int srow[2], schk[2];
#pragma unroll
    for (int i = 0; i < 2; ++i) { srow[i] = (wu * 2 + i) * 8 + (lane >> 3); schk[i] = ((lane & 7) ^ ((srow[i] >> 1) & 7)) * 8; }
    auto dma = [&](int buf, int t) {
        const int tok0 = t < 64 ? b * L + t * 64 : NLAT + b * LC + (t - 64) * 64;
#pragma unroll
        for (int i = 0; i < 2; ++i) {
            __builtin_amdgcn_global_load_lds((const unsigned*)(p.PROJ + (long)(tok0 + srow[i]) * PC + P_CK + hh * 64 + schk[i]), (LAS unsigned*)(lds + buf * 16384 + (wu * 2 + i) * 1024), 16, 0, 0);
            __builtin_amdgcn_global_load_lds((const unsigned*)(vtb + (long)srow[i] * NKEY + t * 64 + schk[i]), (LAS unsigned*)(lds + buf * 16384 + 8192 + (wu * 2 + i) * 1024), 16, 0, 0);
        }
    };
    f32x16 o[2][2];
#pragma unroll
    for (int m = 0; m < 2; ++m)
#pragma unroll
        for (int dt = 0; dt < 2; ++dt)
#pragma unroll
            for (int e = 0; e < 16; ++e) o[m][dt][e] = 0.f;
    float negm[2];
    float lsum[2] = {0.f, 0.f};
#pragma unroll
    for (int m = 0; m < 2; ++m) {
        float qn = 0.f;
#pragma unroll
        for (int s2 = 0; s2 < 2; ++s2) { const u32x4 qq = __builtin_bit_cast(u32x4, qf[m][s2]);
#pragma unroll
            for (int e = 0; e < 4; ++e) { const float a = bf2f((bf16_t)(qq[e] & 0xffff)), bq = bf2f((bf16_t)(qq[e] >> 16)); qn += a * a + bq * bq; } }
        qn += __shfl_xor(qn, 32);
        const float km = __uint_as_float(p.KMAX[(l * NB + b) * 10 + hh * 2 + m]);
        negm[m] = -sqrtf(qn * km);
    }
    f32x16 negv;
    { const float nm = fminf(negm[0], negm[1]);
#pragma unroll
      for (int e = 0; e < 16; ++e) negv[e] = nm; }
    const int swz = (c >> 1) & 7;
    const int krow = c * 128, fo0 = ((0 + h) ^ swz) << 4, fo1 = ((2 + h) ^ swz) << 4, fo2 = ((4 + h) ^ swz) << 4, fo3 = ((6 + h) ^ swz) << 4;
    __syncthreads();
    dma(0, t0);
    for (int it = 0; it < nt; ++it) {
        asm volatile("s_waitcnt vmcnt(0)" ::: "memory");
        __syncthreads();
        if (it + 1 < nt) dma((it + 1) & 1, t0 + it + 1);
        const LAS unsigned char* Ks = lds + (it & 1) * 16384; const LAS unsigned char* Vs = Ks + 8192;
        auto qk = [&](int sub, int m) -> f32x16 {
            const LAS unsigned char* kr = Ks + sub * 4096 + krow;
            const bf16x8 k0 = *(const LAS bf16x8*)(kr + (m ? fo2 : fo0)), k1 = *(const LAS bf16x8*)(kr + (m ? fo3 : fo1));
            const f32x16 sa = __builtin_amdgcn_mfma_f32_32x32x16_bf16(k0, qf[m][0], negv, 0, 0, 0);
            return __builtin_amdgcn_mfma_f32_32x32x16_bf16(k1, qf[m][1], sa, 0, 0, 0);
        };
        f32x16 sa = qk(0, 0);
        bf16x8 vf[2][2];
#pragma unroll
        for (int j = 0; j < 4; ++j) {
            const int sub = j >> 1, m = j & 1;
            if (m == 0) {
#pragma unroll
                for (int dt = 0; dt < 2; ++dt) {
                    const LAS unsigned char* vr = Vs + dt * 4096 + krow;
                    vf[dt][0] = *(const LAS bf16x8*)(vr + (sub ? fo2 : fo0)); vf[dt][1] = *(const LAS bf16x8*)(vr + (sub ? fo3 : fo1));
                }
            }
            f32x16 san;
            if (j < 3) san = qk((j + 1) >> 1, (j + 1) & 1);
            float ps = 0.f;
            u32x4 a0, a1;
#pragma unroll
            for (int e = 0; e < 4; ++e) {
                const float p0 = __builtin_amdgcn_exp2f(sa[2 * e]), p1 = __builtin_amdgcn_exp2f(sa[2 * e + 1]);
                const float p2 = __builtin_amdgcn_exp2f(sa[8 + 2 * e]), p3 = __builtin_amdgcn_exp2f(sa[8 + 2 * e + 1]);
                ps = (((ps + p0) + p1) + p2) + p3;
                a0[e] = pack_bf16(p0, p1); a1[e] = pack_bf16(p2, p3);
            }
            lsum[m] += ps; asm volatile("" : "+v"(lsum[m]));
            const bf16x8 pk0 = __builtin_bit_cast(bf16x8, a0), pk1 = __builtin_bit_cast(bf16x8, a1);
#pragma unroll
            for (int dt = 0; dt < 2; ++dt) {
                o[m][dt] = __builtin_amdgcn_mfma_f32_32x32x16_bf16(vf[dt][0], pk0, o[m][dt], 0, 0, 0);
                o[m][dt] = __builtin_amdgcn_mfma_f32_32x32x16_bf16(vf[dt][1], pk1, o[m][dt], 0, 0, 0);
            }
            if (j < 3) sa = san;
            __builtin_amdgcn_sched_barrier(0);
        }
    }
    __syncthreads();
    const float l0 = lsum[0] + __shfl_xor(lsum[0], 32), l1 = lsum[1] + __shfl_xor(lsum[1], 32);
    const float c0 = 1.f / l0, c1 = -lam / l1;
    float ss = 0.f;
#pragma unroll
    for (int dt = 0; dt < 2; ++dt)
#pragma unroll
        for (int e = 0; e < 16; ++e) { const float v = o[0][dt][e] * c0 + o[1][dt][e] * c1; o[0][dt][e] = v; ss += v * v; }
    ss += __shfl_xor(ss, 32);
    const float r = rsqrtf(ss * (1.f / 64.f) + EPS) * (1.f - lambda_init);
    bf16_t* op = p.MIXO + (long)tokq * D + 768 + hh * 64;
    int lw = l * 64; asm volatile("" : "+v"(lw));
#pragma unroll
    for (int dt = 0; dt < 2; ++dt)
#pragma unroll
        for (int g = 0; g < 4; ++g) {
            const int dv = dt * 32 + 8 * g + 4 * h;
            const float4 wv = *(const float4*)(p.c_subln_w + lw + dv);
            uint2 ov; ov.x = pack_bf16(o[0][dt][4 * g + 0] * r * wv.x, o[0][dt][4 * g + 1] * r * wv.y);
            ov.y = pack_bf16(o[0][dt][4 * g + 2] * r * wv.z, o[0][dt][4 * g + 3] * r * wv.w);
            *(uint2*)(op + dv) = ov;
        }
}


__device__ __forceinline__ void b_attnA(const P& p, int l, int unit, bf16_t* smem) {
    const int tid = otid(), lane = tid & 63, w = tid >> 6, c = lane & 31, h = lane >> 5;
    const bool ctxq = unit >= NB * 4 * (L / 128);
    int b, hd, qb;
    if (!ctxq) { qb = unit & 31; hd = (unit >> 5) & 3; b = unit >> 7; }
    else { const int u = unit - NB * 4 * (L / 128); qb = u & 1; hd = (u >> 1) & 3; b = u >> 3; }
    const int kvh = hd >> 1;
    const int q0 = qb * 128 + w * 32, iq = q0 + c;
    const int tokq = (ctxq ? NLAT + b * LC : b * L) + iq;
    const int tl0 = ctxq ? 0 : max(0, 2 * qb - 2), tl1 = ctxq ? -1 : min(63, 2 * qb + 3), nloc = tl1 - tl0 + 1, nt = nloc + 4;
    bf16x8 qf[4];
    {
        const float qs = 0.125f * 1.4426950408889634f;
        const bf16_t* qp = p.PROJ + (long)tokq * PC + P_AQ + hd * 64;
#pragma unroll
        for (int s2 = 0; s2 < 4; ++s2) {
            const u32x4 raw = *(const u32x4*)(qp + s2 * 16 + h * 8);
            u32x4 sc;
#pragma unroll
            for (int e = 0; e < 4; ++e) sc[e] = pack_bf16(bf2f((bf16_t)(raw[e] & 0xffff)) * qs, bf2f((bf16_t)(raw[e] >> 16)) * qs);
            qf[s2] = __builtin_bit_cast(bf16x8, sc);
        }
    }
    const bf16_t* vtb = p.VTA + (long)(b * 2 + kvh) * 64 * NKEY;
    const int srow0 = tid >> 3, sch = (tid & 7) * 8;
    u32x4 rk[2], rv[2];
    auto tile_of = [&](int it) { return it < nloc ? tl0 + it : 64 + (it - nloc); };
    auto gload = [&](int t) {
        const int tok0 = t < 64 ? b * L + t * 64 : NLAT + b * LC + (t - 64) * 64;
#pragma unroll
        for (int i = 0; i < 2; ++i) {
            rk[i] = *(const u32x4*)(p.PROJ + (long)(tok0 + srow0 + i * 32) * PC + P_AK + kvh * 64 + sch);
            rv[i] = *(const u32x4*)(vtb + (long)(srow0 + i * 32) * NKEY + t * 64 + sch);
        }
    };
    auto lstore = [&](int buf) {
        bf16_t* Ks = smem + buf * (2 * 64 * 72); bf16_t* Vs = Ks + 64 * 72;
#pragma unroll
        for (int i = 0; i < 2; ++i) { *(u32x4*)(Ks + (srow0 + i * 32) * 72 + sch) = rk[i]; *(u32x4*)(Vs + (srow0 + i * 32) * 72 + sch) = rv[i]; }
    };
    f32x16 o[2];
#pragma unroll
    for (int dt = 0; dt < 2; ++dt)
#pragma unroll
        for (int e = 0; e < 16; ++e) o[dt][e] = 0.f;
    f32x16 negm; float lsum;
    {
        float qn = 0.f;
#pragma unroll
        for (int s2 = 0; s2 < 4; ++s2) { const u32x4 qq = __builtin_bit_cast(u32x4, qf[s2]);
#pragma unroll
            for (int e = 0; e < 4; ++e) { const float a = bf2f((bf16_t)(qq[e] & 0xffff)), bq = bf2f((bf16_t)(qq[e] >> 16)); qn += a * a + bq * bq; } }
        qn += __shfl_xor(qn, 32);
        const float km = __uint_as_float(p.KMAX[(l * NB + b) * 10 + 8 + kvh]);
        const float sk = p.a_sink[l * 4 + hd] * 1.4426950408889634f;
        const float mb = fmaxf(sqrtf(qn * km), sk);
#pragma unroll
        for (int e = 0; e < 16; ++e) negm[e] = -mb;
        lsum = h == 0 ? __builtin_amdgcn_exp2f(sk - mb) : 0.f;
    }
    __syncthreads();
    gload(tile_of(0)); lstore(0);
    __syncthreads();
    for (int it = 0; it < nt; ++it) {
        if (it + 1 < nt) gload(tile_of(it + 1));
        const int t = tile_of(it);
        const bool local = t < 64;
        const bf16_t* Ks = smem + (it & 1) * (2 * 64 * 72); const bf16_t* Vs = Ks + 64 * 72;
#pragma unroll
        for (int sub = 0; sub < 2; ++sub) {
            const int j0 = t * 64 + sub * 32;
            if (local && (j0 + 31 < q0 - 128 || j0 > q0 + 31 + 128)) continue;
            f32x16 sa = negm;
#pragma unroll
            for (int s2 = 0; s2 < 4; ++s2) {
                const bf16x8 kf = *(const bf16x8*)(Ks + (sub * 32 + c) * 72 + s2 * 16 + h * 8);
                sa = __builtin_amdgcn_mfma_f32_32x32x16_bf16(kf, qf[s2], sa, 0, 0, 0);
            }
            if (local) {
#pragma unroll
                for (int e = 0; e < 16; ++e) { const int j = j0 + 8 * (e >> 2) + 4 * h + (e & 3); const int dj = j - iq; if (dj > 128 || dj < -128) sa[e] = -INFINITY; }
            }
            float ps = 0.f;
            u32x4 a0, a1;
#pragma unroll
            for (int e = 0; e < 4; ++e) {
                const float p0 = __builtin_amdgcn_exp2f(sa[2 * e]), p1 = __builtin_amdgcn_exp2f(sa[2 * e + 1]);
                const float p2 = __builtin_amdgcn_exp2f(sa[8 + 2 * e]), p3 = __builtin_amdgcn_exp2f(sa[8 + 2 * e + 1]);
                ps += (p0 + p1) + (p2 + p3);
                a0[e] = pack_bf16(p0, p1); a1[e] = pack_bf16(p2, p3);
            }
            lsum += ps;
            const bf16x8 pk0 = __builtin_bit_cast(bf16x8, a0), pk1 = __builtin_bit_cast(bf16x8, a1);
#pragma unroll
            for (int dt = 0; dt < 2; ++dt) {
                const bf16x8 v0 = *(const bf16x8*)(Vs + (dt * 32 + c) * 72 + sub * 32 + h * 8);
                const bf16x8 v1 = *(const bf16x8*)(Vs + (dt * 32 + c) * 72 + sub * 32 + 16 + h * 8);
                o[dt] = __builtin_amdgcn_mfma_f32_32x32x16_bf16(v0, pk0, o[dt], 0, 0, 0);
                o[dt] = __builtin_amdgcn_mfma_f32_32x32x16_bf16(v1, pk1, o[dt], 0, 0, 0);
            }
        }
        if (it + 1 < nt) lstore((it + 1) & 1);
        __syncthreads();
    }
    const float inv = 1.f / (lsum + __shfl_xor(lsum, 32));
    bf16_t* op = p.MIXO + (long)tokq * D + hd * 64;
#pragma unroll
    for (int dt = 0; dt < 2; ++dt)
#pragma unroll
        for (int g = 0; g < 4; ++g) {
            uint2 ov; ov.x = pack_bf16(o[dt][4 * g + 0] * inv, o[dt][4 * g + 1] * inv); ov.y = pack_bf16(o[dt][4 * g + 2] * inv, o[dt][4 * g + 3] * inv);
            *(uint2*)(op + dt * 32 + 8 * g + 4 * h) = ov;
        }
}

constexpr int NCH = 34;
constexpr int XT_STRIDE = 136;
__device__ __forceinline__ int chunk_tok0(int b, int cc) { return cc < 2 ? NLAT + b * LC + cc * 128 : b * L + (cc - 2) * 128; }
__device__ __forceinline__ float softplusf(float v) { return fmaxf(v, 0.f) + log1pf(expf(-fabsf(v))); }

__device__ __forceinline__ void ssd_dt_cum(const P& p, int l, int tok0, int head, float* cumv, float* dtv) {
    const int lane = otid() & 63, w = otid() >> 6;
    if (w < 2) {
        const int dir = w;
        const float a = -expf(p.a_log[(l * 2 + dir) * 8 + head]), dtb = p.dt_bias[(l * 2 + dir) * 8 + head];
        const int k0 = 2 * lane, k1 = 2 * lane + 1, i0 = dir ? 127 - k0 : k0, i1 = dir ? 127 - k1 : k1;
        const float dt0 = softplusf(p.DT[(long)(tok0 + i0) * 16 + dir * 8 + head] + dtb), dt1 = softplusf(p.DT[(long)(tok0 + i1) * 16 + dir * 8 + head] + dtb);
        const float la0 = dt0 * a, la1 = dt1 * a;
        float sc = la0 + la1;
#pragma unroll
        for (int off = 1; off < 64; off <<= 1) { const float t = __shfl_up(sc, off); if (lane >= off) sc += t; }
        const float excl = sc - (la0 + la1);
        cumv[dir * 128 + i0] = excl + la0; cumv[dir * 128 + i1] = excl + la0 + la1;
        dtv[dir * 128 + i0] = dt0; dtv[dir * 128 + i1] = dt1;
    }
}
__device__ __forceinline__ void ssd_conv_load(const P& p, int tok0, int cpos, int len, int col0, u32x4 (&raw)[8]) {
    const int tid = otid(), ch8 = (tid & 7) * 8, t0 = (tid >> 3) * 4;
#pragma unroll
    for (int r = 0; r < 8; ++r) {
        const int tt = t0 - 2 + r, pos = cpos + tt;
        u32x4 v = (u32x4){0u, 0u, 0u, 0u};
        if (pos >= 0 && pos < len) v = *(const u32x4*)(p.PROJ + (long)(tok0 + tt) * PC + P_BX + col0 + ch8);
        raw[r] = v;
    }
}
template <bool TR>
__device__ __forceinline__ void ssd_conv_apply(const P& p, int l, int col0, const u32x4 (&raw)[8], bf16_t* dst) {
    const int tid = otid(), ch8 = (tid & 7) * 8, t0 = (tid >> 3) * 4;
    float xr[8][8];
#pragma unroll
    for (int r = 0; r < 8; ++r)
#pragma unroll
        for (int e = 0; e < 4; ++e) { xr[r][2 * e] = bf2f((bf16_t)(raw[r][e] & 0xffff)); xr[r][2 * e + 1] = bf2f((bf16_t)(raw[r][e] >> 16)); }
    float acc[4][8];
    { const float4 b0 = *(const float4*)(p.conv_b + l * 768 + col0 + ch8), b1 = *(const float4*)(p.conv_b + l * 768 + col0 + ch8 + 4);
#pragma unroll
      for (int i = 0; i < 4; ++i) { acc[i][0] = b0.x; acc[i][1] = b0.y; acc[i][2] = b0.z; acc[i][3] = b0.w; acc[i][4] = b1.x; acc[i][5] = b1.y; acc[i][6] = b1.z; acc[i][7] = b1.w; } }
#pragma unroll
    for (int tap = 0; tap < 5; ++tap) {
        const float4 w0 = *(const float4*)(p.conv_w + (l * 5 + tap) * 768 + col0 + ch8), w1 = *(const float4*)(p.conv_w + (l * 5 + tap) * 768 + col0 + ch8 + 4);
        const float wv[8] = {w0.x, w0.y, w0.z, w0.w, w1.x, w1.y, w1.z, w1.w};
#pragma unroll
        for (int i = 0; i < 4; ++i)
#pragma unroll
            for (int e = 0; e < 8; ++e) acc[i][e] += wv[e] * xr[i + tap][e];
    }
#pragma unroll
    for (int i = 0; i < 4; ++i) {
        if (TR) {
#pragma unroll
            for (int e = 0; e < 8; ++e) dst[(ch8 + e) * XT_STRIDE + t0 + i] = f2bf(siluf(acc[i][e]));
        } else {
            u32x4 o;
#pragma unroll
            for (int e = 0; e < 4; ++e) o[e] = pack_bf16(siluf(acc[i][2 * e]), siluf(acc[i][2 * e + 1]));
            *(u32x4*)(dst + (t0 + i) * 72 + ch8) = o;
        }
    }
}

__device__ __forceinline__ void b_ssd_states(const P& p, int l, int unit, bf16_t* smem) {
    const int head = unit & 7, cc = (unit >> 3) % NCH, b = unit / (8 * NCH), g = head >> 2;
    const int tok0 = chunk_tok0(b, cc);
    const int tid = otid(), lane = tid & 63, w = tid >> 6, c = lane & 31, h = lane >> 5;
    bf16_t* xT = smem; bf16_t* BT = smem + 64 * XT_STRIDE;
    float* cumv = (float*)(smem + 2 * 64 * XT_STRIDE); float* dtv = cumv + 256; float* wdt = dtv + 256;
    __syncthreads();
    const int cpos = cc < 2 ? cc * 128 : (cc - 2) * 128, slen = cc < 2 ? LC : L;
    {
        u32x4 rx[8], rb[8];
        ssd_conv_load(p, tok0, cpos, slen, head * 64, rx);
        ssd_conv_load(p, tok0, cpos, slen, 512 + g * 64, rb);
        ssd_dt_cum(p, l, tok0, head, cumv, dtv);
        ssd_conv_apply<true>(p, l, head * 64, rx, xT);
        ssd_conv_apply<true>(p, l, 512 + g * 64, rb, BT);
    }
    __syncthreads();
    { const int dir = tid >> 7, t = tid & 127; const float ce = cumv[dir * 128 + (dir ? 0 : 127)];
      wdt[tid] = __expf(ce - cumv[tid]) * dtv[tid];
      if (t == 0) wt_store(&p.DEC[((long)(b * NCH + cc) * 8 + head) * 2 + dir], __expf(ce)); }
    __syncthreads();
    const int dir = w >> 1, pt = w & 1;
    f32x16 acc[2];
#pragma unroll
    for (int nt = 0; nt < 2; ++nt)
#pragma unroll
        for (int e = 0; e < 16; ++e) acc[nt][e] = 0.f;
#pragma unroll
    for (int ks = 0; ks < 8; ++ks) {
        const u32x4 xr = *(const u32x4*)(xT + (pt * 32 + c) * XT_STRIDE + ks * 16 + h * 8);
        const f32x4 w0 = *(const f32x4*)(wdt + dir * 128 + ks * 16 + h * 8), w1 = *(const f32x4*)(wdt + dir * 128 + ks * 16 + h * 8 + 4);
        u32x4 xs;
        xs[0] = pack_bf16(bf2f((bf16_t)(xr[0] & 0xffff)) * w0[0], bf2f((bf16_t)(xr[0] >> 16)) * w0[1]);
        xs[1] = pack_bf16(bf2f((bf16_t)(xr[1] & 0xffff)) * w0[2], bf2f((bf16_t)(xr[1] >> 16)) * w0[3]);
        xs[2] = pack_bf16(bf2f((bf16_t)(xr[2] & 0xffff)) * w1[0], bf2f((bf16_t)(xr[2] >> 16)) * w1[1]);
        xs[3] = pack_bf16(bf2f((bf16_t)(xr[3] & 0xffff)) * w1[2], bf2f((bf16_t)(xr[3] >> 16)) * w1[3]);
        const bf16x8 xa = __builtin_bit_cast(bf16x8, xs);
#pragma unroll
        for (int nt = 0; nt < 2; ++nt) {
            const bf16x8 bb = *(const bf16x8*)(BT + (nt * 32 + c) * XT_STRIDE + ks * 16 + h * 8);
            acc[nt] = __builtin_amdgcn_mfma_f32_32x32x16_bf16(xa, bb, acc[nt], 0, 0, 0);
        }
    }
    float* st = p.ST + (((long)(b * NCH + cc) * 8 + head) * 2 + dir) * 4096;
#pragma unroll
    for (int nt = 0; nt < 2; ++nt)
#pragma unroll
        for (int e = 0; e < 16; ++e) { const int pr = pt * 32 + 8 * (e >> 2) + 4 * h + (e & 3); wt_store(&st[pr * 64 + nt * 32 + c], acc[nt][e]); }
    unit_publish(p.SYNC + l * 2 + 0);
}

__device__ __forceinline__ void b_ssd_scan(const P& p, int l, int vb) {
    unit_wait(p.SYNC + l * 2 + 0, (unsigned)(NB * NCH * 8));
    const int idx = vb * 256 + otid();
    const int e = idx & 4095, dir = (idx >> 12) & 1, head = (idx >> 13) & 7, b = idx >> 16;
    float stv[NCH], dcv[NCH];
#pragma unroll
    for (int k = 0; k < NCH; ++k) {
        const int cc = dir ? (k < 2 ? 1 - k : 35 - k) : k;
        const long base = ((long)(b * NCH + cc) * 8 + head) * 2 + dir;
        stv[k] = p.ST[base * 4096 + e]; dcv[k] = p.DEC[base];
    }
    float hst = 0.f;
#pragma unroll
    for (int k = 0; k < NCH; ++k) {
        const int cc = dir ? (k < 2 ? 1 - k : 35 - k) : k;
        const long base = ((long)(b * NCH + cc) * 8 + head) * 2 + dir;
        { const float oth = __shfl_xor(hst, 1); if ((e & 1) == 0) wt_store((unsigned*)(p.HS + base * 4096 + e), pack_bf16(hst, oth)); }
        hst = dcv[k] * hst + stv[k];
    }
    unit_publish(p.SYNC + l * 2 + 1);
}

__device__ __forceinline__ void b_ssd_out(const P& p, int l, int unit, bf16_t* smem) {
    const int head = unit & 7, cc = (unit >> 3) % NCH, b = unit / (8 * NCH), g = head >> 2;
    const int tok0 = chunk_tok0(b, cc);
    const int tid = otid(), lane = tid & 63, w = tid >> 6, c = lane & 31, h = lane >> 5;
    bf16_t* Cs = smem; bf16_t* Bs = smem + 128 * 72; bf16_t* xT = smem + 2 * 128 * 72;
    float* cumv = (float*)(smem + 2 * 128 * 72 + 64 * XT_STRIDE); float* dtv = cumv + 256;
    __syncthreads();
    const int cpos = cc < 2 ? cc * 128 : (cc - 2) * 128, slen = cc < 2 ? LC : L;
    const int t = 32 * w + c;
    const bf16_t* zp = p.PROJ + (long)(tok0 + t) * PC + P_BZ + head * 64;
    {
        u32x4 rc[8], rb[8], rx[8];
        ssd_conv_load(p, tok0, cpos, slen, 640 + g * 64, rc);
        ssd_conv_load(p, tok0, cpos, slen, 512 + g * 64, rb);
        ssd_dt_cum(p, l, tok0, head, cumv, dtv);
        ssd_conv_apply<false>(p, l, 640 + g * 64, rc, Cs);
        ssd_conv_load(p, tok0, cpos, slen, head * 64, rx);
        ssd_conv_apply<false>(p, l, 512 + g * 64, rb, Bs);
        ssd_conv_apply<true>(p, l, head * 64, rx, xT);
    }
    unit_wait(p.SYNC + l * 2 + 1, (unsigned)(NB * 8 * 2 * 4096 / 256));
    bf16x8 cf[4];
#pragma unroll
    for (int ks = 0; ks < 4; ++ks) cf[ks] = *(const bf16x8*)(Cs + t * 72 + ks * 16 + h * 8);
    f32x16 gT[4];
#pragma unroll
    for (int st = 0; st < 4; ++st) {
#pragma unroll
        for (int e = 0; e < 16; ++e) gT[st][e] = 0.f;
#pragma unroll
        for (int ks = 0; ks < 4; ++ks) {
            const bf16x8 bfr = *(const bf16x8*)(Bs + (st * 32 + c) * 72 + ks * 16 + h * 8);
            gT[st] = __builtin_amdgcn_mfma_f32_32x32x16_bf16(bfr, cf[ks], gT[st], 0, 0, 0);
        }
    }
    f32x16 tot[2];
#pragma unroll
    for (int pt = 0; pt < 2; ++pt)
#pragma unroll
        for (int e = 0; e < 16; ++e) tot[pt][e] = 0.f;
#pragma unroll
    for (int dir = 0; dir < 2; ++dir) {
        const float ct = cumv[dir * 128 + t];
        bf16x8 hsf[4][2];
        {
            const bf16_t* hs = p.HS + (((long)(b * NCH + cc) * 8 + head) * 2 + dir) * 4096;
#pragma unroll
            for (int ks = 0; ks < 4; ++ks)
#pragma unroll
                for (int pt = 0; pt < 2; ++pt) hsf[ks][pt] = *(const bf16x8*)(hs + (pt * 32 + c) * 64 + ks * 16 + h * 8);
        }
#pragma unroll
        for (int st = 0; st < 4; ++st) {
            const bool need = dir ? (st >= w) : (st <= w);
            if (need) {
#pragma unroll
                for (int k2 = 0; k2 < 2; ++k2) {
                    float mv[8];
#pragma unroll
                    for (int j = 0; j < 8; ++j) {
                        const int sidx = st * 32 + 16 * k2 + 8 * (j >> 2) + 4 * h + (j & 3);
                        const float cs = cumv[dir * 128 + sidx], ds = dtv[dir * 128 + sidx];
                        const bool ok = (st != w) || (dir ? (sidx >= t) : (sidx <= t));
                        const float arg = ok ? ct - cs : -__builtin_inff();
                        mv[j] = gT[st][8 * k2 + j] * __expf(arg) * ds;
                    }
                    u32x4 pm; pm[0] = pack_bf16(mv[0], mv[1]); pm[1] = pack_bf16(mv[2], mv[3]); pm[2] = pack_bf16(mv[4], mv[5]); pm[3] = pack_bf16(mv[6], mv[7]);
                    const bf16x8 pmb = __builtin_bit_cast(bf16x8, pm);
#pragma unroll
                    for (int pt = 0; pt < 2; ++pt) {
                        const bf16_t* xr = xT + (pt * 32 + c) * XT_STRIDE + st * 32 + 16 * k2 + 4 * h;
                        const uint2 lo = *(const uint2*)xr, hi = *(const uint2*)(xr + 8);
                        const u32x4 xa = (u32x4){lo.x, lo.y, hi.x, hi.y};
                        tot[pt] = __builtin_amdgcn_mfma_f32_32x32x16_bf16(__builtin_bit_cast(bf16x8, xa), pmb, tot[pt], 0, 0, 0);
                    }
                }
            }
        }
        const float et = __expf(ct);
#pragma unroll
        for (int ks = 0; ks < 4; ++ks) {
            const u32x4 cr = __builtin_bit_cast(u32x4, cf[ks]);
            u32x4 cs4;
#pragma unroll
            for (int e = 0; e < 4; ++e) cs4[e] = pack_bf16(bf2f((bf16_t)(cr[e] & 0xffff)) * et, bf2f((bf16_t)(cr[e] >> 16)) * et);
            const bf16x8 cfs = __builtin_bit_cast(bf16x8, cs4);
#pragma unroll
            for (int pt = 0; pt < 2; ++pt) {
                tot[pt] = __builtin_amdgcn_mfma_f32_32x32x16_bf16(hsf[ks][pt], cfs, tot[pt], 0, 0, 0);
            }
        }
    }
    const float dsk = p.d_skip[(l * 2 + 0) * 8 + head] + p.d_skip[(l * 2 + 1) * 8 + head];
    bf16_t* gp = p.MIXO + (long)(tok0 + t) * D + 256 + head * 64;
    uint2 zr[2][4];
#pragma unroll
    for (int pt = 0; pt < 2; ++pt)
#pragma unroll
        for (int gq = 0; gq < 4; ++gq) zr[pt][gq] = *(const uint2*)(zp + pt * 32 + 8 * gq + 4 * h);
    float ss = 0.f;
#pragma unroll
    for (int pt = 0; pt < 2; ++pt)
#pragma unroll
        for (int gq = 0; gq < 4; ++gq) {
            const int p0 = pt * 32 + 8 * gq + 4 * h;
            const uint2 zq = zr[pt][gq];
            const float zv[4] = {bf2f((bf16_t)(zq.x & 0xffff)), bf2f((bf16_t)(zq.x >> 16)), bf2f((bf16_t)(zq.y & 0xffff)), bf2f((bf16_t)(zq.y >> 16))};
            float gv[4];
#pragma unroll
            for (int e = 0; e < 4; ++e) { const float y = tot[pt][4 * gq + e] + bf2f(xT[(p0 + e) * XT_STRIDE + t]) * dsk; gv[e] = y * siluf(zv[e]); ss += gv[e] * gv[e]; }
            uint2 ov; ov.x = pack_bf16(gv[0], gv[1]); ov.y = pack_bf16(gv[2], gv[3]);
            *(uint2*)(gp + p0) = ov;
        }
    ss += __shfl_xor(ss, 32);
    if (h == 0) p.SSQ[(long)(tok0 + t) * 8 + head] = ss;
}

__device__ __forceinline__ void b_norm2r(const P& p, int l, int vb, bf16_t* smem) {
    const int tid = otid(), wave = tid >> 6, lane = tid & 63;
    constexpr int HST = D + 16;
    bf16_t* Hs = smem;
    float* red = (float*)(smem + 16 * HST);
    float* lgs = red + 4 * 16 * 48;
    __syncthreads();
#pragma unroll 1
    for (int i4 = 0; i4 < 4; ++i4) {
        const int tl = wave * 4 + i4, tok = vb * 16 + tl;
        float v[16];
        const float* src = p.X + (long)tok * D;
#pragma unroll
        for (int i = 0; i < 4; ++i) { const float4 t = *(const float4*)(src + i * 256 + lane * 4); v[i * 4 + 0] = t.x; v[i * 4 + 1] = t.y; v[i * 4 + 2] = t.z; v[i * 4 + 3] = t.w; }
        float ss = 0.f;
#pragma unroll
        for (int i = 0; i < 16; ++i) ss += v[i] * v[i];
        ss = wave_sum(ss);
        const float r = rsqrtf(ss * (1.f / D) + EPS);
        const float* m = p.MOD + ((long)l * 5 + tok_modrow(tok)) * 6 * D;
        const float* nw = p.norm2_w + l * D;
        bf16_t* ho = p.H + (long)tok * D;
#pragma unroll
        for (int i = 0; i < 4; ++i) {
            const int k = i * 256 + lane * 4;
            const float4 w4 = *(const float4*)(nw + k), sc = *(const float4*)(m + 4 * D + k), sh = *(const float4*)(m + 3 * D + k);
            uint2 o;
            o.x = pack_bf16(v[i * 4 + 0] * r * w4.x * (1.f + sc.x) + sh.x, v[i * 4 + 1] * r * w4.y * (1.f + sc.y) + sh.y);
            o.y = pack_bf16(v[i * 4 + 2] * r * w4.z * (1.f + sc.z) + sh.z, v[i * 4 + 3] * r * w4.w * (1.f + sc.w) + sh.w);
            *(uint2*)(ho + k) = o;
            *(uint2*)(Hs + tl * HST + k) = o;
        }
    }
    __syncthreads();
    {
        const int lr = lane & 15, lq = lane >> 4;
        const bf16_t* wr = p.WT_R + ((long)l * 128 + lr) * D + wave * 256 + lq * 8;
        const bf16_t* hr = Hs + lr * HST + wave * 256 + lq * 8;
        f32x4 acc[3];
#pragma unroll
        for (int ni = 0; ni < 3; ++ni) acc[ni] = (f32x4){0.f, 0.f, 0.f, 0.f};
#pragma unroll
        for (int half = 0; half < 2; ++half) {
            bf16x8 wb[4][3];
#pragma unroll
            for (int ks = 0; ks < 4; ++ks)
#pragma unroll
                for (int ni = 0; ni < 3; ++ni) wb[ks][ni] = *(const bf16x8*)(wr + (long)ni * 16 * D + (half * 4 + ks) * 32);
#pragma unroll
            for (int ks = 0; ks < 4; ++ks) {
                const bf16x8 xa = *(const bf16x8*)(hr + (half * 4 + ks) * 32);
#pragma unroll
                for (int ni = 0; ni < 3; ++ni) acc[ni] = __builtin_amdgcn_mfma_f32_16x16x32_bf16(wb[ks][ni], xa, acc[ni], 0, 0, 0);
            }
        }
#pragma unroll
        for (int ni = 0; ni < 3; ++ni) *(f32x4*)(red + (wave * 16 + lr) * 48 + ni * 16 + lq * 4) = acc[ni];
    }
    __syncthreads();
#pragma unroll
    for (int i = 0; i < 3; ++i) {
        const int idx = tid + i * 256, t = idx / 48, j = idx % 48;
        lgs[t * 49 + j] = (red[(0 * 16 + t) * 48 + j] + red[(1 * 16 + t) * 48 + j]) + (red[(2 * 16 + t) * 48 + j] + red[(3 * 16 + t) * 48 + j]);
    }
    __syncthreads();
    if (tid < 16) {
        const int tok = vb * 16 + tid;
        const float* lg = lgs + tid * 49;
        int gs = 0; float gm = lg[0];
#pragma unroll
        for (int j = 1; j < 4; ++j) { const float v = lg[j]; if (v > gm) { gm = v; gs = j; } }
        float den = 0.f;
#pragma unroll
        for (int j = 0; j < 4; ++j) den += expf(lg[j] - gm);
        const float gp = 1.f / den;
        float e0 = -3.4e38f, e1 = -3.4e38f; int i0 = 0, i1 = 0;
#pragma unroll
        for (int j = 0; j < 8; ++j) {
            const float val = lg[4 + gs * 8 + j];
            if (val > e0) { e1 = e0; i1 = i0; e0 = val; i0 = j; }
            else if (val > e1) { e1 = val; i1 = j; }
        }
        const float x1 = expf(e1 - e0), w0 = gp / (1.f + x1), w1 = gp * x1 / (1.f + x1);
        const int ex0 = gs * 8 + i0, ex1 = gs * 8 + i1;
        int* cnt = p.cnt + l * NEXP;
        const int rk0 = atomicAdd(&cnt[ex0], 1); p.list[(long)ex0 * NTOK + rk0] = tok * 2 + 0; p.gatew[tok * 2 + 0] = w0;
        const int rk1 = atomicAdd(&cnt[ex1], 1); p.list[(long)ex1 * NTOK + rk1] = tok * 2 + 1; p.gatew[tok * 2 + 1] = w1;
    }
}

struct MoeTile { int e, mt, cnt, off; };
__device__ __forceinline__ int moe_row_tiles(const int* cnt) { int t = 0; for (int e = 0; e < NEXP; ++e) t += (cnt[e] + 127) >> 7; return t; }
__device__ __forceinline__ MoeTile moe_find_tile(const int* cnt, int tile) {
    MoeTile t; t.e = -1; t.mt = 0; t.cnt = 0; t.off = 0;
    int acc_t = 0, off = 0;
    for (int e = 0; e < NEXP; ++e) {
        const int c = cnt[e], nt = (c + 127) >> 7;
        if (t.e < 0 && tile < acc_t + nt) { t.e = e; t.mt = tile - acc_t; t.cnt = c; t.off = off; }
        acc_t += nt; off += c;
    }
    return t;
}
struct RowGather { const bf16_t* base; const int* lst; int n; __device__ __forceinline__ const bf16_t* operator()(int r) const { return base + (long)(lst[r < n ? r : n - 1] >> 1) * D; } };
struct RowLimit { const bf16_t* base; long ld; int n; __device__ __forceinline__ const bf16_t* operator()(int r) const { return base + (long)(r < n ? r : n - 1) * ld; } };
template <int NI> struct RowGateUp { const bf16_t* wg; const bf16_t* wu; __device__ __forceinline__ const bf16_t* operator()(int n) const {
    const int wn = n / (NI * 16), f = (n >> 4) % NI, j = n & 15, col = wn * (NI * 8) + (f % (NI / 2)) * 16 + j; return wg + (long)(f / (NI / 2)) * (wu - wg) + (long)col * D; } };

template <int NI>
__device__ __forceinline__ void b_moe_up(const P& p, int l, int rt, int h0, bf16_t* smem) {
    const MoeTile t = moe_find_tile(p.cnt + l * NEXP, rt);
    if (t.e < 0) return;
    const int nrow = min(128, t.cnt - t.mt * 128);
    RowGather ra{p.H, p.list + (long)t.e * NTOK + t.mt * 128, nrow};
    const long wofs = (((long)l * NEXP + t.e) * DEXP + h0) * D;
    RowGateUp<NI> rb{p.WT_G + wofs, p.WT_U + wofs};
    bf16_t* out = p.HID + (long)(t.off + t.mt * 128) * DEXP + h0;
    auto epi = [&](const f32x4 (&acc)[4][NI], int wm, int wn, int lr, int lq) {
#pragma unroll
        for (int mi = 0; mi < 4; ++mi) {
            const int r = wm * 64 + mi * 16 + lr;
            if (r < nrow) {
#pragma unroll
                for (int f = 0; f < NI / 2; ++f) {
                    const f32x4 gt = acc[mi][f], up = acc[mi][NI / 2 + f];
                    float hv[4];
#pragma unroll
                    for (int e = 0; e < 4; ++e) hv[e] = siluf(gt[e]) * up[e];
                    uint2 o; o.x = pack_bf16(hv[0], hv[1]); o.y = pack_bf16(hv[2], hv[3]);
                    *(uint2*)(out + (long)r * DEXP + wn * (NI * 8) + f * 16 + lq * 4) = o;
                }
            }
        }
    };
    if constexpr (NI == 8) gemm_tile32<4, 8>(ra, rb, D, smem, epi); else gemm_tile<4, NI>(ra, rb, D, smem, epi);
}

template <int NI>
__device__ __forceinline__ void b_moe_down(const P& p, int l, int rt, int n0, bf16_t* smem) {
    const MoeTile t = moe_find_tile(p.cnt + l * NEXP, rt);
    if (t.e < 0) return;
    const int nrow = min(128, t.cnt - t.mt * 128);
    const int slot0 = t.off + t.mt * 128;
    RowLimit ra{p.HID + (long)slot0 * DEXP, DEXP, nrow};
    RowLin rb{p.WT_D + (((long)l * NEXP + t.e) * D + n0) * DEXP, DEXP};
    const int* lst = p.list + (long)t.e * NTOK + t.mt * 128;
    int asg[4]; float gwv[4];
    {
        const int lane = otid() & 63, w = otid() >> 6;
#pragma unroll
        for (int mi = 0; mi < 4; ++mi) { const int r = (w >> 1) * 64 + mi * 16 + (lane & 15); asg[mi] = lst[r < nrow ? r : nrow - 1]; gwv[mi] = p.gatew[asg[mi]]; }
    }
    auto epi = [&](const f32x4 (&acc)[4][NI], int wm, int wn, int lr, int lq) {
#pragma unroll
        for (int mi = 0; mi < 4; ++mi) {
            const int r = wm * 64 + mi * 16 + lr;
            if (r < nrow) {
                const float gw = gwv[mi];
                if (n0 == 0 && wn == 0 && lq == 0) p.pos[asg[mi]] = slot0 + r;
#pragma unroll
                for (int ni = 0; ni < NI; ++ni) {
                    const int n = n0 + wn * (NI * 16) + ni * 16 + lq * 4;
                    const f32x4 a = acc[mi][ni];
                    uint2 o; o.x = pack_bf16(a[0] * gw, a[1] * gw); o.y = pack_bf16(a[2] * gw, a[3] * gw);
                    *(uint2*)(p.YS + (long)(slot0 + r) * D + n) = o;
                }
            }
        }
    };
    if constexpr (NI == 8) gemm_tile32<4, 8>(ra, rb, DEXP, smem, epi); else gemm_tile<4, NI>(ra, rb, DEXP, smem, epi);
}

__device__ __forceinline__ void b_final(const P& p, int vb) {
    const int wave = otid() >> 6, lane = otid() & 63;
    const int tok = vb * 4 + wave;
    if (tok >= NLAT) return;
    float v[16];
    const float* src = p.X + (long)tok * D;
#pragma unroll
    for (int i = 0; i < 4; ++i) { const float4 t = *(const float4*)(src + i * 256 + lane * 4); v[i * 4 + 0] = t.x; v[i * 4 + 1] = t.y; v[i * 4 + 2] = t.z; v[i * 4 + 3] = t.w; }
    {
        const bf16_t* ys0 = p.YS + (long)p.pos[tok * 2 + 0] * D; const bf16_t* ys1 = p.YS + (long)p.pos[tok * 2 + 1] * D;
        const float* g2 = p.MOD + ((long)(DEPTH - 1) * 5 + tok_modrow(tok)) * 6 * D + 5 * D;
#pragma unroll
        for (int i = 0; i < 4; ++i) {
            const uint2 t = *(const uint2*)(ys0 + i * 256 + lane * 4), u = *(const uint2*)(ys1 + i * 256 + lane * 4);
            const float4 g = *(const float4*)(g2 + i * 256 + lane * 4);
            v[i * 4 + 0] += (bf2f((bf16_t)(t.x & 0xffff)) + bf2f((bf16_t)(u.x & 0xffff))) * g.x; v[i * 4 + 1] += (bf2f((bf16_t)(t.x >> 16)) + bf2f((bf16_t)(u.x >> 16))) * g.y;
            v[i * 4 + 2] += (bf2f((bf16_t)(t.y & 0xffff)) + bf2f((bf16_t)(u.y & 0xffff))) * g.z; v[i * 4 + 3] += (bf2f((bf16_t)(t.y >> 16)) + bf2f((bf16_t)(u.y >> 16))) * g.w;
        }
    }
    float ss = 0.f;
#pragma unroll
    for (int i = 0; i < 16; ++i) ss += v[i] * v[i];
    ss = wave_sum(ss);
    const float r = rsqrtf(ss * (1.f / D) + EPS);
    float* o = p.out + (long)tok * D;
#pragma unroll
    for (int i = 0; i < 4; ++i) { const float4 w = *(const float4*)(p.final_w + i * 256 + lane * 4);
        *(float4*)(o + i * 256 + lane * 4) = make_float4(v[i * 4 + 0] * r * w.x, v[i * 4 + 1] * r * w.y, v[i * 4 + 2] * r * w.z, v[i * 4 + 3] * r * w.w); }
}


#define XB_TMO      128
#define XB_XCNT(j)  (256  + 64 * (j))
#define XB_XSUB(j)  (1280 + 64 * (j))
#define XB_XGEN(j)  (2304 + 64 * (j))
#define XB_TOP      3328
#define XB_TOPGEN   3392
#define XCD_BAR_WORDS 3456
#define XB_SPIN_CAP (1u << 22)
__device__ __forceinline__ unsigned xb_ld(unsigned* p)              { return __hip_atomic_load(p, __ATOMIC_RELAXED, __HIP_MEMORY_SCOPE_AGENT); }
__device__ __forceinline__ unsigned xb_add(unsigned* p, unsigned v) { return __hip_atomic_fetch_add(p, v, __ATOMIC_RELAXED, __HIP_MEMORY_SCOPE_AGENT); }
__device__ __forceinline__ unsigned xb_xcc_id() { return (unsigned)__builtin_amdgcn_s_getreg((3 << 11) | 20) & 0xFu; }
#define XB_SPIN(cond, bar) do { unsigned _sp = 0; while (cond) { __builtin_amdgcn_s_sleep(1); \
    if ((++_sp & 255u) == 0u) { if (xb_ld(&(bar)[XB_TMO])) break; if (_sp > XB_SPIN_CAP) { atomicAdd(&(bar)[XB_TMO], 1u); break; } } } } while (0)
struct XcdBarrier { unsigned* bar; unsigned x; volatile LAS unsigned* st; };
__device__ __forceinline__ XcdBarrier xcd_barrier_post(unsigned* bar, volatile LAS unsigned* st) {
    XcdBarrier b; b.bar = bar; b.x = xb_xcc_id(); b.st = st;
    if (threadIdx.x == 0) (void)xb_add(&bar[XB_XCNT(b.x)], 1u);
    return b;
}
__device__ __forceinline__ void xcd_barrier_complete(unsigned* bar, unsigned x, unsigned& nloc, unsigned& nx) {
    const unsigned G = gridDim.x * gridDim.y * gridDim.z;
    unsigned sum, cnt, mine, sp = 0u;
    for (;;) {
        sum = 0u; cnt = 0u; mine = 0u;
#pragma unroll
        for (unsigned j = 0; j < 16; ++j) { const unsigned c = xb_ld(&bar[XB_XCNT(j)]); sum += c; cnt += (c > 0u) ? 1u : 0u; mine = (j == x) ? c : mine; }
        if (sum == G) break;
        __builtin_amdgcn_s_sleep(1);
        if ((++sp & 255u) == 0u) { if (xb_ld(&bar[XB_TMO])) break; if (sp > XB_SPIN_CAP) { atomicAdd(&bar[XB_TMO], 1u); break; } }
    }
    nloc = mine > 0u ? mine : 1u; nx = cnt > 0u ? cnt : 1u;
}
__device__ __forceinline__ void xcd_barrier(const XcdBarrier& b) {
    asm volatile("s_waitcnt vmcnt(0)" ::: "memory");
    __syncthreads();
    if (threadIdx.x == 0) {
        unsigned* bar = b.bar;
        __builtin_amdgcn_s_waitcnt(0);
        unsigned bx = __builtin_amdgcn_readfirstlane(b.x); asm volatile("" : "+s"(bx));
        unsigned nloc = b.st[0], nx = b.st[1];
        if (nloc == 0u) { xcd_barrier_complete(bar, bx, nloc, nx); b.st[0] = nloc; b.st[1] = nx; }
        const unsigned old = xb_add(&bar[XB_XSUB(bx)], 1u);
        const unsigned gen = old / nloc;
        if (old + 1u == (gen + 1u) * nloc) {
            __builtin_amdgcn_fence(__ATOMIC_RELEASE, "agent");
            asm volatile("s_waitcnt vmcnt(0)" ::: "memory");
            const unsigned og = xb_add(&bar[XB_TOP], 1u);
            const unsigned tg = og / nx;
            if (og + 1u == (tg + 1u) * nx) xb_add(&bar[XB_TOPGEN], 1u);
            else XB_SPIN(xb_ld(&bar[XB_TOPGEN]) == tg, bar);
            __builtin_amdgcn_fence(__ATOMIC_ACQUIRE, "agent");
            xb_add(&bar[XB_XGEN(bx)], 1u);
            asm volatile("s_waitcnt vmcnt(0)" ::: "memory");
        } else {
            XB_SPIN(xb_ld(&bar[XB_XGEN(bx)]) == gen, bar);
            __builtin_amdgcn_fence(__ATOMIC_ACQUIRE, "agent");
            asm volatile("s_waitcnt vmcnt(0)" ::: "memory");
        }
    }
    __syncthreads();
}

#define FOR_VB(n) for (int vb = blockIdx.x; vb < (n); vb += gridDim.x)
#define FOR_VB_XCD(n) for (int _ch = ((n) + 7) >> 3, _j = (int)blockIdx.x >> 3, vb = ((int)blockIdx.x & 7) * _ch + _j; _j < _ch; _j += (int)gridDim.x >> 3, vb += (int)gridDim.x >> 3) if (vb < (n))
#define FOR_VB_OFF(n, off) for (int vb = (int)((blockIdx.x + gridDim.x - ((off) % gridDim.x)) % gridDim.x); vb < (n); vb += gridDim.x)
__global__ void __launch_bounds__(256, 2) k_mega(P p) {
    extern __shared__ __attribute__((aligned(16))) unsigned char dynlds[];
    bf16_t* smem = (bf16_t*)dynlds;
    uint4* xbw = (uint4*)(dynlds + SMEM_BYTES);
    float (*tt)[65] = (float (*)[65])smem;
    if (threadIdx.x == 0) *xbw = make_uint4(0u, 0u, 0u, 0u);
    __syncthreads();
    const XcdBarrier xb = xcd_barrier_post(p.bar, (volatile LAS unsigned*)xbw);
    if (threadIdx.x == 0) {
        const unsigned key = (xb.x << 8) | ((unsigned)__builtin_amdgcn_s_getreg((7 << 11) | (8 << 6) | 4) & 0xFFu);
        ((volatile LAS unsigned*)xbw)[4] = xb_add(&p.cuslot[key], 1u) & 1u;
    }
    __syncthreads();
    const int slot = __builtin_amdgcn_readfirstlane((int)((volatile LAS unsigned*)xbw)[4]);
    if (blockIdx.x == 0 && otid() < DEPTH * NEXP) p.cnt[otid()] = 0;
    if (blockIdx.x == 1 && otid() < DEPTH * NB * 10) p.KMAX[otid()] = 0u;
    if (blockIdx.x == 2) for (int i = otid(); i < SY_LAYER + DEPTH * SY_STRIDE; i += 256) p.SYNC[i] = 0u;
    FOR_VB(6) b_rope_table(p, vb);
    FOR_VB(DEPTH * 6 * D / 64) b_mod(p, vb, (float*)smem);
    __syncthreads();
    constexpr int CI1 = 28 * 16 / 4, CI2 = 12 * 16 / 4, CVO = (D / 64) * (D / 64) / 4;
    auto prep_in = [&](int bz, int off) {
        FOR_VB_OFF(CI1, off) b_convT_stream(bz * CI1 + vb, p.w_in, p.WT_IN, D, 1792, nullptr, IN_COLS, 0, 0, (long)D * IN_COLS, (long)PCW * D);
        FOR_VB_OFF(CI2, off + CI1) b_convT_stream(bz * CI2 + vb, p.w_in, p.WT_IN, D, 768, nullptr, IN_COLS, 1808, 1792, (long)D * IN_COLS, (long)PCW * D);
        FOR_VB_OFF(16, off + CI1 + CI2) b_convT(tt, 0, vb, bz, p.w_in, p.WT_IN, D, IN_COLS, OLD_BDT, 16, PC, (long)D * IN_COLS, (long)PCW * D);
    };
    prep_in(0, 0);
    FOR_VB(1 * 16 * DEPTH) b_convT(tt, 0, vb % 16, vb / 16, p.w_grouter, p.WT_R, D, 4, 0, 4, 0, (long)D * 4, (long)128 * D);
    FOR_VB(1 * 16 * DEPTH) b_convT(tt, 0, vb % 16, vb / 16, p.w_router, p.WT_R, D, 32, 0, 32, 4, (long)D * 32, (long)128 * D);
    xcd_barrier(xb);
    for (int l = 0; l < DEPTH; ++l) {
        const bool last = (l == DEPTH - 1);
        const int ntok = last ? NLAT : NTOK;
        FOR_VB(NTOK / 16) b_norm1(p, l, vb);
        {
            constexpr int NT = PCW / 128, MPX = (NTOK / 128) / 8, CH = MPX * NT, M0 = (MPX + 1) / 2, M1 = MPX - M0;
            for (int j = (int)blockIdx.x >> 3; j < CH; j += (int)gridDim.x >> 3) {
                const int jj = j < M0 * NT ? j : j - M0 * NT, mh = j < M0 * NT ? M0 : M1, m = (j < M0 * NT ? 0 : M0) + jj % mh, n = jj / mh;
                b_inproj(p, l, (((int)blockIdx.x & 7) * MPX + m) * NT + n, smem);
            }
        }
        xcd_barrier(xb);
        {
            const int nst = NB * NCH * 8, nsc = NB * 8 * 2 * 4096 / 256;
            const int ncu = NB * 4 * (L / 128) + (last ? 0 : NB * 4 * 2);
            FOR_VB_OFF(nst, 0) b_ssd_states(p, l, vb, smem);
            constexpr int CVL = NEXP * (D / 64) * (DEXP / 64) / 4;
#pragma unroll 1
            for (int step = 0; step < 2; ++step) {
                if ((step ^ slot) == 0) {
                    FOR_VB_OFF(ncu, nst) b_attnC(p, l, vb, smem);
                } else {
                    for (int vb = l * CVL + (int)blockIdx.x; vb < (l + 1) * CVL; vb += (int)gridDim.x) b_convT_stream(vb, p.w_gate, p.WT_G, D, DEXP);
                    for (int vb = l * CVL + (int)blockIdx.x; vb < (l + 1) * CVL; vb += (int)gridDim.x) b_convT_stream(vb, p.w_up, p.WT_U, D, DEXP);
                    for (int vb = l * CVL + (int)blockIdx.x; vb < (l + 1) * CVL; vb += (int)gridDim.x) b_convT_stream(vb, p.w_down, p.WT_D, DEXP, D);
                    FOR_VB_OFF(CVO, 192) b_convT_stream(l * CVO + vb, p.w_out, p.WT_OUT, D, D, p.b_norm_w);
                    if (l + 1 < DEPTH) prep_in(l + 1, 192 + CVO);
                }
                if (step == 0) { FOR_VB_OFF(nsc, nst + ncu) b_ssd_scan(p, l, vb); }
            }
            FOR_VB_OFF(ncu, nst + nsc + ncu) b_attnA(p, l, vb, smem);
            FOR_VB_OFF(nst, nst + nsc + 2 * ncu) { if (last && ((vb >> 3) % NCH) < 2) continue; b_ssd_out(p, l, vb, smem); }
        }
        xcd_barrier(xb);
        {
            const int ch = (ntok / 128) * (D / 128) / 8, bpx = (int)gridDim.x >> 3, j = (int)blockIdx.x >> 3, xc = (int)blockIdx.x & 7;
            const int rem = ch % bpx, nfull = (rem * 8 <= bpx) ? ch - rem : ch;
            for (int t = j; t < nfull; t += bpx) { const int vb = xc * ch + t; b_outproj<4, 4>(p, l, (vb >> 3) * 128, (vb & 7) * 128, smem); }
            for (int q = j; q < (ch - nfull) * 8; q += bpx) { const int vb = xc * ch + nfull + (q >> 3), sub = q & 7; b_outproj<2, 1>(p, l, (vb >> 3) * 128 + (sub >> 2) * 64, (vb & 7) * 128 + (sub & 3) * 32, smem); }
        }
        xcd_barrier(xb);
        FOR_VB(ntok / 16) b_norm2r(p, l, vb, smem);
        xcd_barrier(xb);
        const int nbig = moe_row_tiles(p.cnt + l * NEXP) * 4, mch = (nbig + 7) >> 3, bpx = (int)gridDim.x >> 3, mj = (int)blockIdx.x >> 3;
        const int mlo = ((int)blockIdx.x & 7) * mch, mcnt = max(min(mlo + mch, nbig) - mlo, 0), mrem = mcnt % bpx;
        const int msplit = (mrem == 0) ? 1 : (mrem * 4 <= bpx) ? 4 : (mrem * 2 <= bpx) ? 2 : 1, mfull = msplit > 1 ? mcnt - mrem : mcnt;
        for (int t = mj; t < mfull; t += bpx) { const int bt = mlo + t; b_moe_up<8>(p, l, bt >> 2, (bt & 3) * 128, smem); }
        if (msplit == 4) { for (int q = mj; q < mrem * 4; q += bpx) { const int bt = mlo + mfull + (q >> 2); b_moe_up<2>(p, l, bt >> 2, (bt & 3) * 128 + (q & 3) * 32, smem); } }
        else if (msplit == 2) { for (int q = mj; q < mrem * 2; q += bpx) { const int bt = mlo + mfull + (q >> 1); b_moe_up<4>(p, l, bt >> 2, (bt & 3) * 128 + (q & 1) * 64, smem); } }
        xcd_barrier(xb);
        for (int t = mj; t < mfull; t += bpx) { const int bt = mlo + t; b_moe_down<8>(p, l, bt >> 2, (bt & 3) * 256, smem); }
        if (msplit == 4) { for (int q = mj; q < mrem * 4; q += bpx) { const int bt = mlo + mfull + (q >> 2); b_moe_down<2>(p, l, bt >> 2, (bt & 3) * 256 + (q & 3) * 64, smem); } }
        else if (msplit == 2) { for (int q = mj; q < mrem * 2; q += bpx) { const int bt = mlo + mfull + (q >> 1); b_moe_down<4>(p, l, bt >> 2, (bt & 3) * 256 + (q & 1) * 128, smem); } }
        xcd_barrier(xb);
    }
    FOR_VB(NLAT / 4) b_final(p, vb);
}

extern "C" void kernel_launch(void* const* d_in, const int* in_sizes, int n_in, void* d_out, int out_size, void* d_ws, size_t ws_size, hipStream_t stream) {
    P p{};
    const float** f = (const float**)&p;
    for (int i = 0; i < 25; ++i) f[i] = (const float*)d_in[i];
    p.out = (float*)d_out;
    char* w = (char*)d_ws; size_t off = 0;
    auto take = [&](size_t bytes) { char* r = w + off; off += (bytes + 255) & ~(size_t)255; return r; };
    p.X = (float*)take((size_t)NTOK * D * 4);
    p.MOD = (float*)take((size_t)DEPTH * 5 * 6 * D * 4);
    p.DT = (float*)take((size_t)NTOK * 16 * 4);
    p.SSQ = (float*)take((size_t)NTOK * 8 * 4);
    p.SYNC = (unsigned*)take((size_t)(SY_LAYER + DEPTH * SY_STRIDE) * 4);
    p.ST = (float*)take((size_t)NB * NCH * 16 * 4096 * 4);
    p.DEC = (float*)take((size_t)NB * NCH * 16 * 4);
    p.HS = (bf16_t*)take((size_t)NB * NCH * 16 * 4096 * 2);
    p.gatew = (float*)take((size_t)NTOK * 2 * 4);
    p.H = (bf16_t*)take((size_t)NTOK * D * 2);
    p.PROJ = (bf16_t*)take((size_t)NTOK * PC * 2);
    p.WT_IN = (bf16_t*)take((size_t)DEPTH * PCW * D * 2);
    p.WT_R = (bf16_t*)take((size_t)DEPTH * 128 * D * 2);
    p.WT_OUT = (bf16_t*)take((size_t)DEPTH * D * D * 2);
    p.WT_G = (bf16_t*)take((size_t)DEPTH * NEXP * DEXP * D * 2);
    p.WT_U = (bf16_t*)take((size_t)DEPTH * NEXP * DEXP * D * 2);
    p.WT_D = (bf16_t*)take((size_t)DEPTH * NEXP * DEXP * D * 2);
    p.MIXO = (bf16_t*)take((size_t)NTOK * D * 2);
    p.HID = (bf16_t*)take((size_t)(NTOK * 2 + 128) * DEXP * 2);
    p.YS = (bf16_t*)take((size_t)(NTOK * 2 + 128) * D * 2);
    p.cnt = (int*)take((size_t)DEPTH * NEXP * 4);
    p.list = (int*)take((size_t)NEXP * NTOK * 4);
    p.pos = (int*)take((size_t)NTOK * 2 * 4);
    p.VT = (bf16_t*)take((size_t)NB * 4 * 64 * NKEY * 2);
    p.VTA = (bf16_t*)take((size_t)NB * 2 * 64 * NKEY * 2);
    p.bar = (unsigned*)take((size_t)(XCD_BAR_WORDS + 4096) * 4); p.cuslot = p.bar + XCD_BAR_WORDS;
    p.ROPE = (float*)take((size_t)64 * 24 * 2 * 4);
    p.KMAX = (unsigned*)take((size_t)DEPTH * NB * 10 * 4);
    if (off > ws_size) { fprintf(stderr, "workspace too small: need %zu have %zu\n", off, ws_size); return; }

    (void)hipMemsetAsync(p.bar, 0, (XCD_BAR_WORDS + 4096) * 4, stream);
    static int grid_blocks = 0;
    if (!grid_blocks) {
        int dev = 0, cus = 0, per_cu = 0;
        (void)hipGetDevice(&dev);
        (void)hipDeviceGetAttribute(&cus, hipDeviceAttributeMultiprocessorCount, dev);
        if (hipFuncSetAttribute((const void*)k_mega, hipFuncAttributeMaxDynamicSharedMemorySize, LDS_BYTES) != hipSuccess) fprintf(stderr, "hipFuncSetAttribute(LDS %d) failed\n", LDS_BYTES);
        (void)hipOccupancyMaxActiveBlocksPerMultiprocessor(&per_cu, k_mega, 256, LDS_BYTES);
        if (per_cu > 2) per_cu = 2;
        grid_blocks = cus * per_cu;
    }
    void* args[] = {&p};
    hipError_t e = hipLaunchCooperativeKernel((void*)k_mega, dim3(grid_blocks), dim3(256), args, LDS_BYTES, stream);
    if (e != hipSuccess) fprintf(stderr, "cooperative launch failed: %s (grid %d)\n", hipGetErrorString(e), grid_blocks);
}
```

```cpp
#include <hip/hip_runtime.h>
#include <cstdio>
#include <cstdint>

typedef unsigned short bf16_t;
typedef short bf16x8 __attribute__((ext_vector_type(8)));
typedef float f32x4 __attribute__((ext_vector_type(4)));
typedef unsigned u32x4 __attribute__((ext_vector_type(4)));
typedef float f32x16 __attribute__((ext_vector_type(16)));

constexpr int D = 1024, NB = 4, L = 4096, LC = 256, NLAT = NB * L, NCTX = NB * LC, NTOK = NLAT + NCTX, DEPTH = 4;
constexpr int IN_COLS = 2576, OLD_BDT = 1792;
constexpr int PC = 2560;
constexpr int PCW = 2688;
constexpr int P_AQ = 0, P_AK = 256, P_AV = 384, P_BZ = 512, P_BX = 1024, P_CQ = 1792, P_CK = 2048, P_CV = 2304;
constexpr int NEXP = 32, DEXP = 512;
constexpr int NKEY = L + LC;
constexpr int NKT = NKEY / 64;
constexpr float EPS = 1e-6f;

__device__ __forceinline__ int otid() { int t = threadIdx.x; asm volatile("" : "+v"(t)); return t; }
typedef __bf16 bf16n2 __attribute__((ext_vector_type(2)));
__device__ __forceinline__ bf16_t f2bf(float f) { return __builtin_bit_cast(bf16_t, (__bf16)f); }
__device__ __forceinline__ unsigned pack_bf16(float a, float b) { const bf16n2 v = {(__bf16)a, (__bf16)b}; return __builtin_bit_cast(unsigned, v); }
__device__ __forceinline__ float bf2f(bf16_t h) { return __uint_as_float(((unsigned)h) << 16); }
__device__ __forceinline__ float wave_sum(float v) {
#pragma unroll
    for (int o = 32; o > 0; o >>= 1) v += __shfl_xor(v, o);
    return v;
}
__device__ __forceinline__ float siluf(float v) { return v * __builtin_amdgcn_rcpf(1.f + __expf(-v)); }
__device__ __forceinline__ int tok_modrow(int tok) { return tok < NLAT ? tok / L : NB; }

struct P {
    const float *x, *c, *ctx, *c_ctx, *w_mod, *b_mod, *norm1_w, *norm2_w, *w_in, *w_out, *a_sink, *conv_w, *conv_b, *dt_bias, *a_log, *d_skip,
        *b_norm_w, *c_lambda, *c_subln_w, *w_grouter, *w_router, *w_gate, *w_up, *w_down, *final_w;
    float* out;
    float* X; float* MOD; float* DT; float* SSQ; float* gatew; float* ST; float* DEC; float* ROPE;
    bf16_t *H, *PROJ, *WT_IN, *WT_OUT, *WT_G, *WT_U, *WT_D, *MIXO, *HID, *YS, *VT, *VTA, *HS, *WT_R;
    int *cnt, *list, *pos;
    unsigned* bar; unsigned* cuslot;
    unsigned* SYNC;
    unsigned* KMAX;
};

__device__ __forceinline__ void b_convT(float (*t)[65], int bx, int by, int bz, const float* __restrict__ src, bf16_t* __restrict__ dst, int K, int ld_src, int c0, int ncols, int n_dst0,
                                        long src_bstride, long dst_bstride) {
    src += (long)bz * src_bstride; dst += (long)bz * dst_bstride;
    const int kb = by * 64, nb = bx * 64, tid = otid();
    const int c4 = (tid & 15) * 4, kr0 = tid >> 4;
#pragma unroll
    for (int i = 0; i < 4; ++i) {
        const int kr = kr0 + i * 16;
        float4 v = make_float4(0.f, 0.f, 0.f, 0.f);
        if (nb + c4 < ncols) v = *(const float4*)(src + (long)(kb + kr) * ld_src + c0 + nb + c4);
        t[kr][c4] = v.x; t[kr][c4 + 1] = v.y; t[kr][c4 + 2] = v.z; t[kr][c4 + 3] = v.w;
    }
    __syncthreads();
    const int n = tid >> 2, kq = (tid & 3) * 16;
    if (nb + n < ncols) {
        unsigned o[8];
#pragma unroll
        for (int j = 0; j < 8; ++j) o[j] = (unsigned)f2bf(t[kq + 2 * j][n]) | ((unsigned)f2bf(t[kq + 2 * j + 1][n]) << 16);
        bf16_t* d = dst + (long)(n_dst0 + nb + n) * K + kb + kq;
        *(u32x4*)d = (u32x4){o[0], o[1], o[2], o[3]};
        *(u32x4*)(d + 8) = (u32x4){o[4], o[5], o[6], o[7]};
    }
    __syncthreads();
}

__device__ __forceinline__ void b_convT_stream(int vb, const float* __restrict__ src, bf16_t* __restrict__ dst, int K, int N, const float* rowscale = nullptr,
                                               int ld_src = 0, int c0 = 0, int n_dst0 = 0, long src_ms = 0, long dst_ms = 0) {
    const int tid = otid(), lane = tid & 63;
    const int gw = vb * 4 + (tid >> 6);
    const int nbs = N >> 6, kbs = K >> 6;
    const int mat = gw / (nbs * kbs), r = gw % (nbs * kbs), kb = r / nbs, nb = r % nbs;
    const int kq = lane & 3, n4l = lane >> 2;
    if (ld_src == 0) { ld_src = N; src_ms = (long)K * N; dst_ms = (long)K * N; }
    const float* sp = src + mat * src_ms + (long)(kb * 64 + kq * 8) * ld_src + c0 + nb * 64 + n4l * 4;
    float4 v[16];
#pragma unroll
    for (int j = 0; j < 16; ++j) v[j] = *(const float4*)(sp + (long)((j & 7) + (j >> 3) * 32) * ld_src);
    if (rowscale) {
        const int k0 = kb * 64 + kq * 8;
        if (k0 >= 256 && k0 < 768) {
#pragma unroll
            for (int j = 0; j < 16; ++j) { const float sc = rowscale[mat * 512 + k0 - 256 + (j & 7) + (j >> 3) * 32]; v[j].x *= sc; v[j].y *= sc; v[j].z *= sc; v[j].w *= sc; }
        }
    }
    bf16_t* dp = dst + mat * dst_ms + (long)(n_dst0 + nb * 64 + n4l * 4) * K + kb * 64 + kq * 8;
    u32x4 o0, o1;
#pragma unroll
    for (int j = 0; j < 4; ++j) { o0[j] = pack_bf16(v[2 * j].x, v[2 * j + 1].x); o1[j] = pack_bf16(v[8 + 2 * j].x, v[8 + 2 * j + 1].x); }
    *(u32x4*)dp = o0; *(u32x4*)(dp + 32) = o1;
#pragma unroll
    for (int j = 0; j < 4; ++j) { o0[j] = pack_bf16(v[2 * j].y, v[2 * j + 1].y); o1[j] = pack_bf16(v[8 + 2 * j].y, v[8 + 2 * j + 1].y); }
    *(u32x4*)(dp + K) = o0; *(u32x4*)(dp + K + 32) = o1;
#pragma unroll
    for (int j = 0; j < 4; ++j) { o0[j] = pack_bf16(v[2 * j].z, v[2 * j + 1].z); o1[j] = pack_bf16(v[8 + 2 * j].z, v[8 + 2 * j + 1].z); }
    *(u32x4*)(dp + 2 * K) = o0; *(u32x4*)(dp + 2 * K + 32) = o1;
#pragma unroll
    for (int j = 0; j < 4; ++j) { o0[j] = pack_bf16(v[2 * j].w, v[2 * j + 1].w); o1[j] = pack_bf16(v[8 + 2 * j].w, v[8 + 2 * j + 1].w); }
    *(u32x4*)(dp + 3 * K) = o0; *(u32x4*)(dp + 3 * K + 32) = o1;
}

__device__ __forceinline__ void b_rope_table(const P& p, int vb) {
    const int idx = vb * 256 + otid();
    if (idx >= 64 * 24) return;
    const int pos = idx / 24, f = idx % 24;
    const float fr = f < 16 ? __expf(-(float)f * (1.f / 16.f) * 9.210340371976184f) : __expf(-(float)(f - 16) * (1.f / 8.f) * 9.210340371976184f);
    float sn, cs; sincosf((float)pos * fr, &sn, &cs);
    p.ROPE[idx * 2] = cs; p.ROPE[idx * 2 + 1] = sn;
}

__device__ __forceinline__ void b_mod(const P& p, int vb, float* red) {
    const int tid = otid(), lane = tid & 63, kq = tid >> 6, ks = lane >> 4, c4 = (lane & 15) * 4;
    const int idx = vb * 64 + c4;
    const int l = idx / (6 * D), n = idx % (6 * D);
    float acc[5][4];
#pragma unroll
    for (int r = 0; r < 5; ++r)
#pragma unroll
        for (int e = 0; e < 4; ++e) acc[r][e] = 0.f;
    const float* w = p.w_mod + (long)l * D * 6 * D + n;
#pragma unroll 8
    for (int k = kq * 256 + ks; k < kq * 256 + 256; k += 4) {
        const float4 wv = *(const float4*)(w + (long)k * 6 * D);
#pragma unroll
        for (int r = 0; r < 5; ++r) {
            const float cv = siluf((r < 4) ? p.c[r * D + k] : p.c_ctx[k]);
            acc[r][0] += cv * wv.x; acc[r][1] += cv * wv.y; acc[r][2] += cv * wv.z; acc[r][3] += cv * wv.w;
        }
    }
#pragma unroll
    for (int r = 0; r < 5; ++r)
#pragma unroll
        for (int e = 0; e < 4; ++e) { float v = acc[r][e]; v += __shfl_xor(v, 16); v += __shfl_xor(v, 32); acc[r][e] = v; }
    __syncthreads();
    if (ks == 0) {
#pragma unroll
        for (int r = 0; r < 5; ++r) *(float4*)(red + (kq * 5 + r) * 64 + c4) = make_float4(acc[r][0], acc[r][1], acc[r][2], acc[r][3]);
    }
    __syncthreads();
    if (tid < 64) {
        const int col = tid, i2 = vb * 64 + col, n2 = i2 % (6 * D);
        const float bv = p.b_mod[l * 6 * D + n2];
#pragma unroll
        for (int r = 0; r < 5; ++r) p.MOD[((long)l * 5 + r) * 6 * D + n2] = ((red[(0 * 5 + r) * 64 + col] + red[(1 * 5 + r) * 64 + col]) + (red[(2 * 5 + r) * 64 + col] + red[(3 * 5 + r) * 64 + col])) + bv;
    }
}

__device__ __forceinline__ void wt_store(float* ptr, float v) { __hip_atomic_store(ptr, v, __ATOMIC_RELAXED, __HIP_MEMORY_SCOPE_AGENT); }
__device__ __forceinline__ void wt_store(unsigned* ptr, unsigned v) { __hip_atomic_store(ptr, v, __ATOMIC_RELAXED, __HIP_MEMORY_SCOPE_AGENT); }
__device__ __forceinline__ void wt_store8(void* ptr, unsigned lo, unsigned hi) { __hip_atomic_store((unsigned long long*)ptr, ((unsigned long long)hi << 32) | lo, __ATOMIC_RELAXED, __HIP_MEMORY_SCOPE_AGENT); }
__device__ __forceinline__ void unit_publish(unsigned* cnt) {
    asm volatile("s_waitcnt vmcnt(0)" ::: "memory");
    __syncthreads();
    if (threadIdx.x == 0) (void)__hip_atomic_fetch_add(cnt, 1u, __ATOMIC_RELAXED, __HIP_MEMORY_SCOPE_AGENT);
}
__device__ __forceinline__ void unit_wait(unsigned* cnt, unsigned target) {
    if (threadIdx.x == 0) {
        unsigned sp = 0;
        while (__hip_atomic_load(cnt, __ATOMIC_RELAXED, __HIP_MEMORY_SCOPE_AGENT) < target) { __builtin_amdgcn_s_sleep(2); if (++sp > (1u << 24)) break; }
        __builtin_amdgcn_fence(__ATOMIC_ACQUIRE, "agent");
        asm volatile("s_waitcnt vmcnt(0)" ::: "memory");
    }
    __syncthreads();
}

__device__ __forceinline__ void unit_wait_nf(unsigned* cnt, unsigned target) {
    if (threadIdx.x == 0) {
        unsigned sp = 0;
        while (__hip_atomic_load(cnt, __ATOMIC_RELAXED, __HIP_MEMORY_SCOPE_AGENT) < target) { __builtin_amdgcn_s_sleep(2); if (++sp > (1u << 24)) break; }
    }
    __syncthreads();
    asm volatile("" ::: "memory");
}
constexpr int SY_LAYER = 64, SY_STRIDE = 1024, SY_N1 = 0, SY_OP = 136, SY_N2 = 272, SY_UP = 408;
__device__ __forceinline__ unsigned* sync_ctr(const P& p, int l, int which, int idx) { return p.SYNC + SY_LAYER + l * SY_STRIDE + which + idx; }

__device__ __forceinline__ void b_norm1(const P& p, int l, int vb) {
    const int wave = otid() >> 6, lane = otid() & 63;
#pragma unroll 1
    for (int i4 = 0; i4 < 4; ++i4) {
        const int tok = vb * 16 + wave * 4 + i4;
        float v[16];
        const float* src = (l == 0) ? (tok < NLAT ? p.x + (long)tok * D : p.ctx + (long)(tok - NLAT) * D) : p.X + (long)tok * D;
#pragma unroll
        for (int i = 0; i < 4; ++i) { const float4 t = *(const float4*)(src + i * 256 + lane * 4); v[i * 4 + 0] = t.x; v[i * 4 + 1] = t.y; v[i * 4 + 2] = t.z; v[i * 4 + 3] = t.w; }
        if (l > 0) {
            const bf16_t* ys0 = p.YS + (long)p.pos[tok * 2 + 0] * D; const bf16_t* ys1 = p.YS + (long)p.pos[tok * 2 + 1] * D;
            const float* g2 = p.MOD + ((long)(l - 1) * 5 + tok_modrow(tok)) * 6 * D + 5 * D;
#pragma unroll
            for (int i = 0; i < 4; ++i) {
                const uint2 t = *(const uint2*)(ys0 + i * 256 + lane * 4), u = *(const uint2*)(ys1 + i * 256 + lane * 4);
                const float4 g = *(const float4*)(g2 + i * 256 + lane * 4);
                v[i * 4 + 0] += (bf2f((bf16_t)(t.x & 0xffff)) + bf2f((bf16_t)(u.x & 0xffff))) * g.x; v[i * 4 + 1] += (bf2f((bf16_t)(t.x >> 16)) + bf2f((bf16_t)(u.x >> 16))) * g.y;
                v[i * 4 + 2] += (bf2f((bf16_t)(t.y & 0xffff)) + bf2f((bf16_t)(u.y & 0xffff))) * g.z; v[i * 4 + 3] += (bf2f((bf16_t)(t.y >> 16)) + bf2f((bf16_t)(u.y >> 16))) * g.w;
            }
        }
        float* xo = p.X + (long)tok * D;
#pragma unroll
        for (int i = 0; i < 4; ++i) *(float4*)(xo + i * 256 + lane * 4) = make_float4(v[i * 4 + 0], v[i * 4 + 1], v[i * 4 + 2], v[i * 4 + 3]);
        float ss = 0.f;
#pragma unroll
        for (int i = 0; i < 16; ++i) ss += v[i] * v[i];
        ss = wave_sum(ss);
        const float r = rsqrtf(ss * (1.f / D) + EPS);
        const float* m = p.MOD + ((long)l * 5 + tok_modrow(tok)) * 6 * D;
        const float* nw = p.norm1_w + l * D;
        bf16_t* ho = p.H + (long)tok * D;
#pragma unroll
        for (int i = 0; i < 4; ++i) {
            const int k = i * 256 + lane * 4;
            const float4 w4 = *(const float4*)(nw + k), sc = *(const float4*)(m + D + k), sh = *(const float4*)(m + k);
            wt_store8(ho + k, pack_bf16(v[i * 4 + 0] * r * w4.x * (1.f + sc.x) + sh.x, v[i * 4 + 1] * r * w4.y * (1.f + sc.y) + sh.y),
                              pack_bf16(v[i * 4 + 2] * r * w4.z * (1.f + sc.z) + sh.z, v[i * 4 + 3] * r * w4.w * (1.f + sc.w) + sh.w));
        }
    }
    unit_publish(sync_ctr(p, l, SY_N1, vb >> 3));
}

#define LAS __attribute__((address_space(3)))
constexpr int LDS_STRIDE = 72;
constexpr int SMEM_BYTES = 65536;
constexpr int LDS_BYTES = SMEM_BYTES + 256;
struct NoHook { template <class A> __device__ __forceinline__ void operator()(int, A&) const {} };
template <int MI = 4, int NI = 4, class RowA, class RowB, class Epi, class Hook = NoHook>
__device__ __forceinline__ void gemm_tile(const RowA& ra, const RowB& rb, int K, bf16_t* smem, const Epi& epi, const Hook& hook = Hook()) {
    LAS unsigned char* lds = (LAS unsigned char*)smem;
    const int tid = otid(), lane = tid & 63, w = __builtin_amdgcn_readfirstlane(tid >> 6), wm = w >> 1, wn = w & 1, lr = lane & 15, lq = lane >> 4;
    f32x4 acc[MI][NI];
#pragma unroll
    for (int i = 0; i < MI; ++i)
#pragma unroll
        for (int j = 0; j < NI; ++j) acc[i][j] = (f32x4){0.f, 0.f, 0.f, 0.f};
    const bf16_t* pa[MI]; const bf16_t* pb[NI];
    const int kcs = ((lane & 7) ^ ((lane >> 3) & 7)) * 8;
#pragma unroll
    for (int i = 0; i < MI; ++i) pa[i] = ra((i * 4 + w) * 8 + (lane >> 3)) + kcs;
#pragma unroll
    for (int i = 0; i < NI; ++i) pb[i] = rb((i * 4 + w) * 8 + (lane >> 3)) + kcs;
    auto stage = [&](int buf, int k0) {
#pragma unroll
        for (int i = 0; i < MI; ++i) __builtin_amdgcn_global_load_lds((const unsigned*)(pa[i] + k0), (LAS unsigned*)(lds + buf * 32768 + (i * 4 + w) * 1024), 16, 0, 0);
#pragma unroll
        for (int i = 0; i < NI; ++i) __builtin_amdgcn_global_load_lds((const unsigned*)(pb[i] + k0), (LAS unsigned*)(lds + buf * 32768 + 16384 + (i * 4 + w) * 1024), 16, 0, 0);
    };
    const int aoff = (wm * MI * 16 + lr) * 128 + ((lq ^ (lr & 7)) << 4), boff = 16384 + (wn * NI * 16 + lr) * 128 + ((lq ^ (lr & 7)) << 4);
    const int nk = K >> 6;
    __syncthreads();
    stage(0, 0);
    for (int kt = 0; kt < nk; ++kt) {
        asm volatile("s_waitcnt vmcnt(0)" ::: "memory");
        __syncthreads();
        if (kt + 1 < nk) stage((kt + 1) & 1, (kt + 1) * 64);
        hook(kt, acc);
        const LAS unsigned char* bs = lds + (kt & 1) * 32768;
#pragma unroll
        for (int ks = 0; ks < 2; ++ks) {
            bf16x8 xa[MI], wb[NI];
#pragma unroll
            for (int i = 0; i < MI; ++i) xa[i] = *(const LAS bf16x8*)(bs + (aoff ^ (ks << 6)) + i * 2048);
#pragma unroll
            for (int i = 0; i < NI; ++i) wb[i] = *(const LAS bf16x8*)(bs + (boff ^ (ks << 6)) + i * 2048);
#pragma unroll
            for (int mi = 0; mi < MI; ++mi)
#pragma unroll
                for (int ni = 0; ni < NI; ++ni) acc[mi][ni] = __builtin_amdgcn_mfma_f32_16x16x32_bf16(wb[ni], xa[mi], acc[mi][ni], 0, 0, 0);
        }
    }
    epi(acc, wm, wn, lr, lq);
}

template <int MI, int NI, class RowA, class RowB, class Epi>
__device__ __forceinline__ void gemm_tile32(const RowA& ra, const RowB& rb, int K, bf16_t* smem, const Epi& epi) {
    LAS unsigned char* lds = (LAS unsigned char*)smem;
    const int tid = otid(), lane = tid & 63, w = __builtin_amdgcn_readfirstlane(tid >> 6), wm = w >> 1, wn = w & 1, lr = lane & 15, lq = lane >> 4;
    constexpr int ABYTES = MI * 32 * 64, STG = (MI + NI) * 32 * 64, PA = MI / 2, PB = NI / 2;
    f32x4 acc[MI][NI];
#pragma unroll
    for (int i = 0; i < MI; ++i)
#pragma unroll
        for (int j = 0; j < NI; ++j) acc[i][j] = (f32x4){0.f, 0.f, 0.f, 0.f};
    const bf16_t* pa[PA]; const bf16_t* pb[PB];
    const int kcs = ((lane & 3) ^ ((4 - ((lane >> 4) & 3)) & 3)) * 8;
#pragma unroll
    for (int i = 0; i < PA; ++i) pa[i] = ra((i * 4 + w) * 16 + (lane >> 2)) + kcs;
#pragma unroll
    for (int i = 0; i < PB; ++i) pb[i] = rb((i * 4 + w) * 16 + (lane >> 2)) + kcs;
    auto stage = [&](int buf, int k0) {
#pragma unroll
        for (int i = 0; i < PA; ++i) __builtin_amdgcn_global_load_lds((const unsigned*)(pa[i] + k0), (LAS unsigned*)(lds + buf * STG + (i * 4 + w) * 1024), 16, 0, 0);
#pragma unroll
        for (int i = 0; i < PB; ++i) __builtin_amdgcn_global_load_lds((const unsigned*)(pb[i] + k0), (LAS unsigned*)(lds + buf * STG + ABYTES + (i * 4 + w) * 1024), 16, 0, 0);
    };
    const int fsw = (lq ^ ((4 - ((lr >> 2) & 3)) & 3)) << 4;
    const int aoff = (wm * MI * 16 + lr) * 64 + fsw, boff = ABYTES + (wn * NI * 16 + lr) * 64 + fsw;
    const int nk = K >> 5;
    __syncthreads();
    stage(0, 0);
    for (int kt = 0; kt < nk; ++kt) {
        asm volatile("s_waitcnt vmcnt(0)" ::: "memory");
        __syncthreads();
        if (kt + 1 < nk) stage((kt + 1) & 1, (kt + 1) * 32);
        const LAS unsigned char* bs = lds + (kt & 1) * STG;
        bf16x8 xa[MI], wb[NI];
#pragma unroll
        for (int i = 0; i < MI; ++i) xa[i] = *(const LAS bf16x8*)(bs + aoff + i * 1024);
#pragma unroll
        for (int i = 0; i < NI; ++i) wb[i] = *(const LAS bf16x8*)(bs + boff + i * 1024);
#pragma unroll
        for (int mi = 0; mi < MI; ++mi)
#pragma unroll
            for (int ni = 0; ni < NI; ++ni) acc[mi][ni] = __builtin_amdgcn_mfma_f32_16x16x32_bf16(wb[ni], xa[mi], acc[mi][ni], 0, 0, 0);
    }
    epi(acc, wm, wn, lr, lq);
}

struct RowLin { const bf16_t* base; long ld; __device__ __forceinline__ const bf16_t* operator()(int r) const { return base + (long)r * ld; } };

__device__ __forceinline__ void b_inproj(const P& p, int l, int vb, bf16_t* smem) {
    const int mt = vb / (PCW / 128), nt = vb % (PCW / 128);
    RowLin ra{p.H + (long)mt * 128 * D, D}, rb{p.WT_IN + ((long)l * PCW + nt * 128) * D, D};
    unit_wait_nf(sync_ctr(p, l, SY_N1, mt), 8u);
    if (nt == 20) {
        auto epi_dt = [&](const f32x4 (&acc)[4][1], int wm, int wn, int lr, int lq) {
            if (wn == 0) {
#pragma unroll
                for (int mi = 0; mi < 4; ++mi) *(f32x4*)(p.DT + (long)(mt * 128 + wm * 64 + mi * 16 + lr) * 16 + lq * 4) = acc[mi][0];
            }
        };
        gemm_tile<4, 1>(ra, rb, D, smem, epi_dt);
        return;
    }
    const bool latent = mt < NLAT / 128;
    const int kind = (nt == 20) ? 3 : (nt == 3 || nt == 18 || nt == 19) ? 2 : (latent && nt <= 2) ? 0 : (latent && nt >= 14 && nt <= 17) ? 1 : 4;
    constexpr int OS = 136;
    auto epi = [&](f32x4 (&acc)[4][4], int wm, int wn, int lr, int lq) {
        if (kind == 3) {
            if (wn == 0) {
#pragma unroll
                for (int mi = 0; mi < 4; ++mi) *(f32x4*)(p.DT + (long)(mt * 128 + wm * 64 + mi * 16 + lr) * 16 + lq * 4) = acc[mi][0];
            }
            return;
        }
        if (nt == 2 || nt == 16 || nt == 17) {
            const int b = latent ? mt / (L / 128) : (mt - NLAT / 128) / (LC / 128);
#pragma unroll
            for (int half = 0; half < 2; ++half) {
                float mxv = 0.f;
#pragma unroll
                for (int mi = 0; mi < 4; ++mi) {
                    float ssq = 0.f;
#pragma unroll
                    for (int n2 = 0; n2 < 2; ++n2)
#pragma unroll
                        for (int e = 0; e < 4; ++e) { const float v = acc[mi][2 * half + n2][e]; ssq += v * v; }
                    ssq += __shfl_xor(ssq, 16); ssq += __shfl_xor(ssq, 32);
                    mxv = fmaxf(mxv, ssq);
                }
                if (nt == 2) {
                    const float other = mxv;
                    (void)other;
                }
                if (nt != 2) {
#pragma unroll
                    for (int o = 1; o < 16; o <<= 1) mxv = fmaxf(mxv, __shfl_xor(mxv, o));
                    if ((otid() & 63) == 0) atomicMax(&p.KMAX[(l * NB + b) * 10 + (nt - 16) * 4 + wn * 2 + half], __float_as_uint(mxv));
                }
            }
            if (nt == 2) {
                float mxv = 0.f;
#pragma unroll
                for (int mi = 0; mi < 4; ++mi) {
                    float ssq = 0.f;
#pragma unroll
                    for (int ni = 0; ni < 4; ++ni)
#pragma unroll
                        for (int e = 0; e < 4; ++e) { const float v = acc[mi][ni][e]; ssq += v * v; }
                    ssq += __shfl_xor(ssq, 16); ssq += __shfl_xor(ssq, 32);
                    mxv = fmaxf(mxv, ssq);
                }
#pragma unroll
                for (int o = 1; o < 16; o <<= 1) mxv = fmaxf(mxv, __shfl_xor(mxv, o));
                if ((otid() & 63) == 0) atomicMax(&p.KMAX[(l * NB + b) * 10 + 8 + wn], __float_as_uint(mxv));
            }
        }
        if (kind == 0) {
#pragma unroll
            for (int mi = 0; mi < 4; ++mi) {
                const int i = (mt * 128 + wm * 64 + mi * 16 + lr) & (L - 1);
#pragma unroll
                for (int hf = 0; hf < 2; ++hf) {
                    const int pos = hf ? (i & 63) : (i >> 6);
                    const float* tb = p.ROPE + (pos * 24 + lq * 4) * 2;
                    const f32x4 t0 = *(const f32x4*)tb, t1 = *(const f32x4*)(tb + 4);
                    const float cs[4] = {t0[0], t0[2], t1[0], t1[2]}, sn[4] = {t0[1], t0[3], t1[1], t1[3]};
#pragma unroll
                    for (int e = 0; e < 4; ++e) {
                        const float u1 = acc[mi][2 * hf][e], u2 = acc[mi][2 * hf + 1][e];
                        acc[mi][2 * hf][e] = u1 * cs[e] - u2 * sn[e]; acc[mi][2 * hf + 1][e] = u1 * sn[e] + u2 * cs[e];
                    }
                }
            }
        } else if (kind == 1) {
#pragma unroll
            for (int mi = 0; mi < 4; ++mi) {
                const int i = (mt * 128 + wm * 64 + mi * 16 + lr) & (L - 1);
#pragma unroll
                for (int hf = 0; hf < 2; ++hf) {
                    const int pos = hf ? (i & 63) : (i >> 6);
                    const float* tb = p.ROPE + (pos * 24 + 16 + (lq & 1) * 4) * 2;
                    const f32x4 t0 = *(const f32x4*)tb, t1 = *(const f32x4*)(tb + 4);
                    const float cs[4] = {t0[0], t0[2], t1[0], t1[2]}, sn[4] = {t0[1], t0[3], t1[1], t1[3]};
#pragma unroll
                    for (int n2 = 0; n2 < 2; ++n2) {
                        const int ni = 2 * n2 + hf;
#pragma unroll
                        for (int e = 0; e < 4; ++e) {
                            const float v = acc[mi][ni][e], pv = __shfl_xor(v, 32);
                            acc[mi][ni][e] = lq < 2 ? v * cs[e] - pv * sn[e] : pv * sn[e] + v * cs[e];
                        }
                    }
                }
            }
        }
        __syncthreads();
        if (kind == 2) {
#pragma unroll
            for (int mi = 0; mi < 4; ++mi) {
                const int m = wm * 64 + mi * 16 + lr, mp = (m & ~12) | ((m & 4) << 1) | ((m & 8) >> 1);
#pragma unroll
                for (int ni = 0; ni < 4; ++ni)
#pragma unroll
                    for (int e = 0; e < 4; ++e) smem[(wn * 64 + ni * 16 + lq * 4 + e) * OS + mp] = f2bf(acc[mi][ni][e]);
            }
        } else {
#pragma unroll
            for (int mi = 0; mi < 4; ++mi)
#pragma unroll
                for (int ni = 0; ni < 4; ++ni) {
                    const f32x4 a = acc[mi][ni];
                    uint2 o; o.x = pack_bf16(a[0], a[1]); o.y = pack_bf16(a[2], a[3]);
                    *(uint2*)(smem + (wm * 64 + mi * 16 + lr) * OS + wn * 64 + ni * 16 + lq * 4) = o;
                }
        }
        __syncthreads();
        const int tid = otid();
        if (kind == 2) {
            const int nh = nt == 3 ? 2 : 4, hbase = nt == 3 ? 0 : (nt - 18) * 2;
            bf16_t* vtb = nt == 3 ? p.VTA : p.VT;
            const int b = latent ? mt / (L / 128) : (mt - NLAT / 128) / (LC / 128);
            const int key0 = latent ? (mt % (L / 128)) * 128 : L + ((mt - NLAT / 128) % (LC / 128)) * 128;
#pragma unroll
            for (int i2 = 0; i2 < 8; ++i2) {
                const int idx = tid + i2 * 256, n = idx >> 4, mc = (idx & 15) * 8;
                const u32x4 v = *(const u32x4*)(smem + n * OS + mc);
                *(u32x4*)(vtb + ((long)(b * nh + hbase + (n >> 6)) * 64 + (n & 63)) * NKEY + key0 + mc) = v;
            }
        } else {
            bf16_t* out = p.PROJ + (long)mt * 128 * PC + nt * 128;
#pragma unroll
            for (int i2 = 0; i2 < 8; ++i2) {
                const int idx = tid + i2 * 256, m = idx >> 4, nc = (idx & 15) * 8;
                *(u32x4*)(out + (long)m * PC + nc) = *(const u32x4*)(smem + m * OS + nc);
            }
        }
    };
    gemm_tile(ra, rb, D, smem, epi);
}

template <int MI, int NI>
__device__ __forceinline__ void b_outproj(const P& p, int l, int row0, int col0, bf16_t* smem) {
    RowLin ra{p.MIXO + (long)row0 * D, D}, rb{p.WT_OUT + ((long)l * D + col0) * D, D};
    auto epi = [&](const f32x4 (&acc)[MI][NI], int wm, int wn, int lr, int lq) {
#pragma unroll
        for (int mi = 0; mi < MI; ++mi) {
            const int tok = row0 + wm * MI * 16 + mi * 16 + lr;
            const float* g1 = p.MOD + ((long)l * 5 + tok_modrow(tok)) * 6 * D + 2 * D;
#pragma unroll
            for (int ni = 0; ni < NI; ++ni) {
                const int n = col0 + wn * NI * 16 + ni * 16 + lq * 4;
                const float4 g = *(const float4*)(g1 + n);
                float4* xp = (float4*)(p.X + (long)tok * D + n);
                float4 xv = *xp; const f32x4 a = acc[mi][ni];
                xv.x += g.x * a[0]; xv.y += g.y * a[1]; xv.z += g.z * a[2]; xv.w += g.w * a[3];
                *xp = xv;
            }
        }
    };
    float rs0[MI], rs1[MI];
    {
        const int lane = otid() & 63, w = otid() >> 6, wm0 = w >> 1, lr0 = lane & 15;
#pragma unroll
        for (int mi = 0; mi < MI; ++mi) {
            const float* sq = p.SSQ + (long)(row0 + wm0 * MI * 16 + mi * 16 + lr0) * 8;
            const f32x4 s0 = *(const f32x4*)sq, s1 = *(const f32x4*)(sq + 4);
            rs0[mi] = rsqrtf(((s0[0] + s0[1]) + (s0[2] + s0[3])) * (1.f / 256.f) + EPS); rs1[mi] = rsqrtf(((s1[0] + s1[1]) + (s1[2] + s1[3])) * (1.f / 256.f) + EPS);
        }
    }
    auto hook = [&](int kt, f32x4 (&acc)[MI][NI]) {
        if (kt == 4 || kt == 8 || kt == 12) {
#pragma unroll
            for (int mi = 0; mi < MI; ++mi) {
                const float f = kt == 4 ? 1.f / rs0[mi] : kt == 8 ? rs0[mi] / rs1[mi] : rs1[mi];
#pragma unroll
                for (int ni = 0; ni < NI; ++ni) acc[mi][ni] *= f;
            }
        }
    };
    gemm_tile<MI, NI>(ra, rb, D, smem, epi, hook);
}


__device__ __forceinline__ void b_attnC(const P& p, int l, int unit, bf16_t* smem) {
    const int tid = otid(), lane = tid & 63, w = tid >> 6, c = lane & 31, h = lane >> 5;
    const bool ctxq = unit >= NB * 4 * (L / 128);
    int b, hh, qb;
    if (!ctxq) { qb = unit & 31; hh = (unit >> 5) & 3; b = unit >> 7; }
    else { const int u = unit - NB * 4 * (L / 128); qb = u & 1; hh = (u >> 1) & 3; b = u >> 3; }
    const int tokq = (ctxq ? NLAT + b * LC : b * L) + qb * 128 + w * 32 + c;
    const int t0 = ctxq ? 64 : 0, nt = ctxq ? 4 : NKT;
    const float lambda_init = 0.8f - 0.6f * expf(-0.3f * (float)l);
    const float* cl = p.c_lambda + l * 128;
    const float d1 = wave_sum(h == 0 ? cl[c] * cl[32 + c] : 0.f), d2 = wave_sum(h == 0 ? cl[64 + c] * cl[96 + c] : 0.f);
    const float lam = expf(d1) - expf(d2) + lambda_init;
    bf16x8 qf[2][2];
    {
        const float qs = 0.17677669529663687f * 1.4426950408889634f;
        const bf16_t* qp = p.PROJ + (long)tokq * PC + P_CQ + hh * 64;
#pragma unroll
        for (int m = 0; m < 2; ++m)
#pragma unroll
            for (int s2 = 0; s2 < 2; ++s2) {
                const u32x4 raw = *(const u32x4*)(qp + m * 32 + s2 * 16 + h * 8);
                u32x4 sc;
#pragma unroll
                for (int e = 0; e < 4; ++e) sc[e] = pack_bf16(bf2f((bf16_t)(raw[e] & 0xffff)) * qs, bf2f((bf16_t)(raw[e] >> 16)) * qs);
                qf[m][s2] = __builtin_bit_cast(bf16x8, sc);
            }
    }
    LAS unsigned char* lds = (LAS unsigned char*)smem;
    const bf16_t* vtb = p.VT + (long)(b * 4 + hh) * 64 * NKEY;
    const int wu = __builtin_amdgcn_readfirstlane(w);
    int srow[2], schk[2];
#pragma unroll
    for (int i = 0; i < 2; ++i) { srow[i] = (wu * 2 + i) * 8 + (lane >> 3); schk[i] = ((lane & 7) ^ ((srow[i] >> 1) & 7)) * 8; }
    auto dma = [&](int buf, int t) {
        const int tok0 = t < 64 ? b * L + t * 64 : NLAT + b * LC + (t - 64) * 64;
#pragma unroll
        for (int i = 0; i < 2; ++i) {
            __builtin_amdgcn_global_load_lds((const unsigned*)(p.PROJ + (long)(tok0 + srow[i]) * PC + P_CK + hh * 64 + schk[i]), (LAS unsigned*)(lds + buf * 16384 + (wu * 2 + i) * 1024), 16, 0, 0);
            __builtin_amdgcn_global_load_lds((const unsigned*)(vtb + (long)srow[i] * NKEY + t * 64 + schk[i]), (LAS unsigned*)(lds + buf * 16384 + 8192 + (wu * 2 + i) * 1024), 16, 0, 0);
        }
    };
    f32x16 o[2][2];
#pragma unroll
    for (int m = 0; m < 2; ++m)
#pragma unroll
        for (int dt = 0; dt < 2; ++dt)
#pragma unroll
            for (int e = 0; e < 16; ++e) o[m][dt][e] = 0.f;
    float negm[2];
    float lsum[2] = {0.f, 0.f};
#pragma unroll
    for (int m = 0; m < 2; ++m) {
        float qn = 0.f;
#pragma unroll
        for (int s2 = 0; s2 < 2; ++s2) { const u32x4 qq = __builtin_bit_cast(u32x4, qf[m][s2]);
#pragma unroll
            for (int e = 0; e < 4; ++e) { const float a = bf2f((bf16_t)(qq[e] & 0xffff)), bq = bf2f((bf16_t)(qq[e] >> 16)); qn += a * a + bq * bq; } }
        qn += __shfl_xor(qn, 32);
        const float km = __uint_as_float(p.KMAX[(l * NB + b) * 10 + hh * 2 + m]);
        negm[m] = -sqrtf(qn * km);
    }
    f32x16 negv;
    { const float nm = fminf(negm[0], negm[1]);
#pragma unroll
      for (int e = 0; e < 16; ++e) negv[e] = nm; }
    const int swz = (c >> 1) & 7;
    const int krow = c * 128, fo0 = ((0 + h) ^ swz) << 4, fo1 = ((2 + h) ^ swz) << 4, fo2 = ((4 + h) ^ swz) << 4, fo3 = ((6 + h) ^ swz) << 4;
    __syncthreads();
    dma(0, t0);
    for (int it = 0; it < nt; ++it) {
        asm volatile("s_waitcnt vmcnt(0)" ::: "memory");
        __syncthreads();
        if (it + 1 < nt) dma((it + 1) & 1, t0 + it + 1);
        const LAS unsigned char* Ks = lds + (it & 1) * 16384; const LAS unsigned char* Vs = Ks + 8192;
        auto qk = [&](int sub, int m) -> f32x16 {
            const LAS unsigned char* kr = Ks + sub * 4096 + krow;
            const bf16x8 k0 = *(const LAS bf16x8*)(kr + (m ? fo2 : fo0)), k1 = *(const LAS bf16x8*)(kr + (m ? fo3 : fo1));
            const f32x16 sa = __builtin_amdgcn_mfma_f32_32x32x16_bf16(k0, qf[m][0], negv, 0, 0, 0);
            return __builtin_amdgcn_mfma_f32_32x32x16_bf16(k1, qf[m][1], sa, 0, 0, 0);
        };
        f32x16 sa = qk(0, 0);
        bf16x8 vf[2][2];
#pragma unroll
        for (int j = 0; j < 4; ++j) {
            const int sub = j >> 1, m = j & 1;
            if (m == 0) {
#pragma unroll
                for (int dt = 0; dt < 2; ++dt) {
                    const LAS unsigned char* vr = Vs + dt * 4096 + krow;
                    vf[dt][0] = *(const LAS bf16x8*)(vr + (sub ? fo2 : fo0)); vf[dt][1] = *(const LAS bf16x8*)(vr + (sub ? fo3 : fo1));
                }
            }
            f32x16 san;
            if (j < 3) san = qk((j + 1) >> 1, (j + 1) & 1);
            float ps = 0.f;
            u32x4 a0, a1;
#pragma unroll
            for (int e = 0; e < 4; ++e) {
                const float p0 = __builtin_amdgcn_exp2f(sa[2 * e]), p1 = __builtin_amdgcn_exp2f(sa[2 * e + 1]);
                const float p2 = __builtin_amdgcn_exp2f(sa[8 + 2 * e]), p3 = __builtin_amdgcn_exp2f(sa[8 + 2 * e + 1]);
                ps = (((ps + p0) + p1) + p2) + p3;
                a0[e] = pack_bf16(p0, p1); a1[e] = pack_bf16(p2, p3);
            }
            lsum[m] += ps; asm volatile("" : "+v"(lsum[m]));
            const bf16x8 pk0 = __builtin_bit_cast(bf16x8, a0), pk1 = __builtin_bit_cast(bf16x8, a1);
#pragma unroll
            for (int dt = 0; dt < 2; ++dt) {
                o[m][dt] = __builtin_amdgcn_mfma_f32_32x32x16_bf16(vf[dt][0], pk0, o[m][dt], 0, 0, 0);
                o[m][dt] = __builtin_amdgcn_mfma_f32_32x32x16_bf16(vf[dt][1], pk1, o[m][dt], 0, 0, 0);
            }
            if (j < 3) sa = san;
            __builtin_amdgcn_sched_barrier(0);
        }
    }
    __syncthreads();
    const float l0 = lsum[0] + __shfl_xor(lsum[0], 32), l1 = lsum[1] + __shfl_xor(lsum[1], 32);
    const float c0 = 1.f / l0, c1 = -lam / l1;
    float ss = 0.f;
#pragma unroll
    for (int dt = 0; dt < 2; ++dt)
#pragma unroll
        for (int e = 0; e < 16; ++e) { const float v = o[0][dt][e] * c0 + o[1][dt][e] * c1; o[0][dt][e] = v; ss += v * v; }
    ss += __shfl_xor(ss, 32);
    const float r = rsqrtf(ss * (1.f / 64.f) + EPS) * (1.f - lambda_init);
    bf16_t* op = p.MIXO + (long)tokq * D + 768 + hh * 64;
    int lw = l * 64; asm volatile("" : "+v"(lw));
#pragma unroll
    for (int dt = 0; dt < 2; ++dt)
#pragma unroll
        for (int g = 0; g < 4; ++g) {
            const int dv = dt * 32 + 8 * g + 4 * h;
            const float4 wv = *(const float4*)(p.c_subln_w + lw + dv);
            uint2 ov; ov.x = pack_bf16(o[0][dt][4 * g + 0] * r * wv.x, o[0][dt][4 * g + 1] * r * wv.y);
            ov.y = pack_bf16(o[0][dt][4 * g + 2] * r * wv.z, o[0][dt][4 * g + 3] * r * wv.w);
            *(uint2*)(op + dv) = ov;
        }
}


__device__ __forceinline__ void b_attnA(const P& p, int l, int unit, bf16_t* smem) {
    const int tid = otid(), lane = tid & 63, w = tid >> 6, c = lane & 31, h = lane >> 5;
    const bool ctxq = unit >= NB * 4 * (L / 128);
    int b, hd, qb;
    if (!ctxq) { qb = unit & 31; hd = (unit >> 5) & 3; b = unit >> 7; }
    else { const int u = unit - NB * 4 * (L / 128); qb = u & 1; hd = (u >> 1) & 3; b = u >> 3; }
    const int kvh = hd >> 1;
    const int q0 = qb * 128 + w * 32, iq = q0 + c;
    const int tokq = (ctxq ? NLAT + b * LC : b * L) + iq;
    const int tl0 = ctxq ? 0 : max(0, 2 * qb - 2), tl1 = ctxq ? -1 : min(63, 2 * qb + 3), nloc = tl1 - tl0 + 1, nt = nloc + 4;
    bf16x8 qf[4];
    {
        const float qs = 0.125f * 1.4426950408889634f;
        const bf16_t* qp = p.PROJ + (long)tokq * PC + P_AQ + hd * 64;
#pragma unroll
        for (int s2 = 0; s2 < 4; ++s2) {
            const u32x4 raw = *(const u32x4*)(qp + s2 * 16 + h * 8);
            u32x4 sc;
#pragma unroll
            for (int e = 0; e < 4; ++e) sc[e] = pack_bf16(bf2f((bf16_t)(raw[e] & 0xffff)) * qs, bf2f((bf16_t)(raw[e] >> 16)) * qs);
            qf[s2] = __builtin_bit_cast(bf16x8, sc);
        }
    }
    const bf16_t* vtb = p.VTA + (long)(b * 2 + kvh) * 64 * NKEY;
    const int srow0 = tid >> 3, sch = (tid & 7) * 8;
    u32x4 rk[2], rv[2];
    auto tile_of = [&](int it) { return it < nloc ? tl0 + it : 64 + (it - nloc); };
    auto gload = [&](int t) {
        const int tok0 = t < 64 ? b * L + t * 64 : NLAT + b * LC + (t - 64) * 64;
#pragma unroll
        for (int i = 0; i < 2; ++i) {
            rk[i] = *(const u32x4*)(p.PROJ + (long)(tok0 + srow0 + i * 32) * PC + P_AK + kvh * 64 + sch);
            rv[i] = *(const u32x4*)(vtb + (long)(srow0 + i * 32) * NKEY + t * 64 + sch);
        }
    };
    auto lstore = [&](int buf) {
        bf16_t* Ks = smem + buf * (2 * 64 * 72); bf16_t* Vs = Ks + 64 * 72;
#pragma unroll
        for (int i = 0; i < 2; ++i) { *(u32x4*)(Ks + (srow0 + i * 32) * 72 + sch) = rk[i]; *(u32x4*)(Vs + (srow0 + i * 32) * 72 + sch) = rv[i]; }
    };
    f32x16 o[2];
#pragma unroll
    for (int dt = 0; dt < 2; ++dt)
#pragma unroll
        for (int e = 0; e < 16; ++e) o[dt][e] = 0.f;
    f32x16 negm; float lsum;
    {
        float qn = 0.f;
#pragma unroll
        for (int s2 = 0; s2 < 4; ++s2) { const u32x4 qq = __builtin_bit_cast(u32x4, qf[s2]);
#pragma unroll
            for (int e = 0; e < 4; ++e) { const float a = bf2f((bf16_t)(qq[e] & 0xffff)), bq = bf2f((bf16_t)(qq[e] >> 16)); qn += a * a + bq * bq; } }
        qn += __shfl_xor(qn, 32);
        const float km = __uint_as_float(p.KMAX[(l * NB + b) * 10 + 8 + kvh]);
        const float sk = p.a_sink[l * 4 + hd] * 1.4426950408889634f;
        const float mb = fmaxf(sqrtf(qn * km), sk);
#pragma unroll
        for (int e = 0; e < 16; ++e) negm[e] = -mb;
        lsum = h == 0 ? __builtin_amdgcn_exp2f(sk - mb) : 0.f;
    }
    __syncthreads();
    gload(tile_of(0)); lstore(0);
    __syncthreads();
    for (int it = 0; it < nt; ++it) {
        if (it + 1 < nt) gload(tile_of(it + 1));
        const int t = tile_of(it);
        const bool local = t < 64;
        const bf16_t* Ks = smem + (it & 1) * (2 * 64 * 72); const bf16_t* Vs = Ks + 64 * 72;
#pragma unroll
        for (int sub = 0; sub < 2; ++sub) {
            const int j0 = t * 64 + sub * 32;
            if (local && (j0 + 31 < q0 - 128 || j0 > q0 + 31 + 128)) continue;
            f32x16 sa = negm;
#pragma unroll
            for (int s2 = 0; s2 < 4; ++s2) {
                const bf16x8 kf = *(const bf16x8*)(Ks + (sub * 32 + c) * 72 + s2 * 16 + h * 8);
                sa = __builtin_amdgcn_mfma_f32_32x32x16_bf16(kf, qf[s2], sa, 0, 0, 0);
            }
            if (local) {
#pragma unroll
                for (int e = 0; e < 16; ++e) { const int j = j0 + 8 * (e >> 2) + 4 * h + (e & 3); const int dj = j - iq; if (dj > 128 || dj < -128) sa[e] = -INFINITY; }
            }
            float ps = 0.f;
            u32x4 a0, a1;
#pragma unroll
            for (int e = 0; e < 4; ++e) {
                const float p0 = __builtin_amdgcn_exp2f(sa[2 * e]), p1 = __builtin_amdgcn_exp2f(sa[2 * e + 1]);
                const float p2 = __builtin_amdgcn_exp2f(sa[8 + 2 * e]), p3 = __builtin_amdgcn_exp2f(sa[8 + 2 * e + 1]);
                ps += (p0 + p1) + (p2 + p3);
                a0[e] = pack_bf16(p0, p1); a1[e] = pack_bf16(p2, p3);
            }
            lsum += ps;
            const bf16x8 pk0 = __builtin_bit_cast(bf16x8, a0), pk1 = __builtin_bit_cast(bf16x8, a1);
#pragma unroll
            for (int dt = 0; dt < 2; ++dt) {
                const bf16x8 v0 = *(const bf16x8*)(Vs + (dt * 32 + c) * 72 + sub * 32 + h * 8);
                const bf16x8 v1 = *(const bf16x8*)(Vs + (dt * 32 + c) * 72 + sub * 32 + 16 + h * 8);
                o[dt] = __builtin_amdgcn_mfma_f32_32x32x16_bf16(v0, pk0, o[dt], 0, 0, 0);
                o[dt] = __builtin_amdgcn_mfma_f32_32x32x16_bf16(v1, pk1, o[dt], 0, 0, 0);
            }
        }
        if (it + 1 < nt) lstore((it + 1) & 1);
        __syncthreads();
    }
    const float inv = 1.f / (lsum + __shfl_xor(lsum, 32));
    bf16_t* op = p.MIXO + (long)tokq * D + hd * 64;
#pragma unroll
    for (int dt = 0; dt < 2; ++dt)
#pragma unroll
        for (int g = 0; g < 4; ++g) {
            uint2 ov; ov.x = pack_bf16(o[dt][4 * g + 0] * inv, o[dt][4 * g + 1] * inv); ov.y = pack_bf16(o[dt][4 * g + 2] * inv, o[dt][4 * g + 3] * inv);
            *(uint2*)(op + dt * 32 + 8 * g + 4 * h) = ov;
        }
}

constexpr int NCH = 34;
constexpr int XT_STRIDE = 136;
__device__ __forceinline__ int chunk_tok0(int b, int cc) { return cc < 2 ? NLAT + b * LC + cc * 128 : b * L + (cc - 2) * 128; }
__device__ __forceinline__ float softplusf(float v) { return fmaxf(v, 0.f) + log1pf(expf(-fabsf(v))); }

__device__ __forceinline__ void ssd_dt_cum(const P& p, int l, int tok0, int head, float* cumv, float* dtv) {
    const int lane = otid() & 63, w = otid() >> 6;
    if (w < 2) {
        const int dir = w;
        const float a = -expf(p.a_log[(l * 2 + dir) * 8 + head]), dtb = p.dt_bias[(l * 2 + dir) * 8 + head];
        const int k0 = 2 * lane, k1 = 2 * lane + 1, i0 = dir ? 127 - k0 : k0, i1 = dir ? 127 - k1 : k1;
        const float dt0 = softplusf(p.DT[(long)(tok0 + i0) * 16 + dir * 8 + head] + dtb), dt1 = softplusf(p.DT[(long)(tok0 + i1) * 16 + dir * 8 + head] + dtb);
        const float la0 = dt0 * a, la1 = dt1 * a;
        float sc = la0 + la1;
#pragma unroll
        for (int off = 1; off < 64; off <<= 1) { const float t = __shfl_up(sc, off); if (lane >= off) sc += t; }
        const float excl = sc - (la0 + la1);
        cumv[dir * 128 + i0] = excl + la0; cumv[dir * 128 + i1] = excl + la0 + la1;
        dtv[dir * 128 + i0] = dt0; dtv[dir * 128 + i1] = dt1;
    }
}
__device__ __forceinline__ void ssd_conv_load(const P& p, int tok0, int cpos, int len, int col0, u32x4 (&raw)[8]) {
    const int tid = otid(), ch8 = (tid & 7) * 8, t0 = (tid >> 3) * 4;
#pragma unroll
    for (int r = 0; r < 8; ++r) {
        const int tt = t0 - 2 + r, pos = cpos + tt;
        u32x4 v = (u32x4){0u, 0u, 0u, 0u};
        if (pos >= 0 && pos < len) v = *(const u32x4*)(p.PROJ + (long)(tok0 + tt) * PC + P_BX + col0 + ch8);
        raw[r] = v;
    }
}
template <bool TR>
__device__ __forceinline__ void ssd_conv_apply(const P& p, int l, int col0, const u32x4 (&raw)[8], bf16_t* dst) {
    const int tid = otid(), ch8 = (tid & 7) * 8, t0 = (tid >> 3) * 4;
    float xr[8][8];
#pragma unroll
    for (int r = 0; r < 8; ++r)
#pragma unroll
        for (int e = 0; e < 4; ++e) { xr[r][2 * e] = bf2f((bf16_t)(raw[r][e] & 0xffff)); xr[r][2 * e + 1] = bf2f((bf16_t)(raw[r][e] >> 16)); }
    float acc[4][8];
    { const float4 b0 = *(const float4*)(p.conv_b + l * 768 + col0 + ch8), b1 = *(const float4*)(p.conv_b + l * 768 + col0 + ch8 + 4);
#pragma unroll
      for (int i = 0; i < 4; ++i) { acc[i][0] = b0.x; acc[i][1] = b0.y; acc[i][2] = b0.z; acc[i][3] = b0.w; acc[i][4] = b1.x; acc[i][5] = b1.y; acc[i][6] = b1.z; acc[i][7] = b1.w; } }
#pragma unroll
    for (int tap = 0; tap < 5; ++tap) {
        const float4 w0 = *(const float4*)(p.conv_w + (l * 5 + tap) * 768 + col0 + ch8), w1 = *(const float4*)(p.conv_w + (l * 5 + tap) * 768 + col0 + ch8 + 4);
        const float wv[8] = {w0.x, w0.y, w0.z, w0.w, w1.x, w1.y, w1.z, w1.w};
#pragma unroll
        for (int i = 0; i < 4; ++i)
#pragma unroll
            for (int e = 0; e < 8; ++e) acc[i][e] += wv[e] * xr[i + tap][e];
    }
#pragma unroll
    for (int i = 0; i < 4; ++i) {
        if (TR) {
#pragma unroll
            for (int e = 0; e < 8; ++e) dst[(ch8 + e) * XT_STRIDE + t0 + i] = f2bf(siluf(acc[i][e]));
        } else {
            u32x4 o;
#pragma unroll
            for (int e = 0; e < 4; ++e) o[e] = pack_bf16(siluf(acc[i][2 * e]), siluf(acc[i][2 * e + 1]));
            *(u32x4*)(dst + (t0 + i) * 72 + ch8) = o;
        }
    }
}

__device__ __forceinline__ void b_ssd_states(const P& p, int l, int unit, bf16_t* smem) {
    const int head = unit & 7, cc = (unit >> 3) % NCH, b = unit / (8 * NCH), g = head >> 2;
    const int tok0 = chunk_tok0(b, cc);
    const int tid = otid(), lane = tid & 63, w = tid >> 6, c = lane & 31, h = lane >> 5;
    bf16_t* xT = smem; bf16_t* BT = smem + 64 * XT_STRIDE;
    float* cumv = (float*)(smem + 2 * 64 * XT_STRIDE); float* dtv = cumv + 256; float* wdt = dtv + 256;
    __syncthreads();
    const int cpos = cc < 2 ? cc * 128 : (cc - 2) * 128, slen = cc < 2 ? LC : L;
    {
        u32x4 rx[8], rb[8];
        ssd_conv_load(p, tok0, cpos, slen, head * 64, rx);
        ssd_conv_load(p, tok0, cpos, slen, 512 + g * 64, rb);
        ssd_dt_cum(p, l, tok0, head, cumv, dtv);
        ssd_conv_apply<true>(p, l, head * 64, rx, xT);
        ssd_conv_apply<true>(p, l, 512 + g * 64, rb, BT);
    }
    __syncthreads();
    { const int dir = tid >> 7, t = tid & 127; const float ce = cumv[dir * 128 + (dir ? 0 : 127)];
      wdt[tid] = __expf(ce - cumv[tid]) * dtv[tid];
      if (t == 0) wt_store(&p.DEC[((long)(b * NCH + cc) * 8 + head) * 2 + dir], __expf(ce)); }
    __syncthreads();
    const int dir = w >> 1, pt = w & 1;
    f32x16 acc[2];
#pragma unroll
    for (int nt = 0; nt < 2; ++nt)
#pragma unroll
        for (int e = 0; e < 16; ++e) acc[nt][e] = 0.f;
#pragma unroll
    for (int ks = 0; ks < 8; ++ks) {
        const u32x4 xr = *(const u32x4*)(xT + (pt * 32 + c) * XT_STRIDE + ks * 16 + h * 8);
        const f32x4 w0 = *(const f32x4*)(wdt + dir * 128 + ks * 16 + h * 8), w1 = *(const f32x4*)(wdt + dir * 128 + ks * 16 + h * 8 + 4);
        u32x4 xs;
        xs[0] = pack_bf16(bf2f((bf16_t)(xr[0] & 0xffff)) * w0[0], bf2f((bf16_t)(xr[0] >> 16)) * w0[1]);
        xs[1] = pack_bf16(bf2f((bf16_t)(xr[1] & 0xffff)) * w0[2], bf2f((bf16_t)(xr[1] >> 16)) * w0[3]);
        xs[2] = pack_bf16(bf2f((bf16_t)(xr[2] & 0xffff)) * w1[0], bf2f((bf16_t)(xr[2] >> 16)) * w1[1]);
        xs[3] = pack_bf16(bf2f((bf16_t)(xr[3] & 0xffff)) * w1[2], bf2f((bf16_t)(xr[3] >> 16)) * w1[3]);
        const bf16x8 xa = __builtin_bit_cast(bf16x8, xs);
#pragma unroll
        for (int nt = 0; nt < 2; ++nt) {
            const bf16x8 bb = *(const bf16x8*)(BT + (nt * 32 + c) * XT_STRIDE + ks * 16 + h * 8);
            acc[nt] = __builtin_amdgcn_mfma_f32_32x32x16_bf16(xa, bb, acc[nt], 0, 0, 0);
        }
    }
    float* st = p.ST + (((long)(b * NCH + cc) * 8 + head) * 2 + dir) * 4096;
#pragma unroll
    for (int nt = 0; nt < 2; ++nt)
#pragma unroll
        for (int e = 0; e < 16; ++e) { const int pr = pt * 32 + 8 * (e >> 2) + 4 * h + (e & 3); wt_store(&st[pr * 64 + nt * 32 + c], acc[nt][e]); }
    unit_publish(p.SYNC + l * 2 + 0);
}

__device__ __forceinline__ void b_ssd_scan(const P& p, int l, int vb) {
    unit_wait(p.SYNC + l * 2 + 0, (unsigned)(NB * NCH * 8));
    const int idx = vb * 256 + otid();
    const int e = idx & 4095, dir = (idx >> 12) & 1, head = (idx >> 13) & 7, b = idx >> 16;
    float stv[NCH], dcv[NCH];
#pragma unroll
    for (int k = 0; k < NCH; ++k) {
        const int cc = dir ? (k < 2 ? 1 - k : 35 - k) : k;
        const long base = ((long)(b * NCH + cc) * 8 + head) * 2 + dir;
        stv[k] = p.ST[base * 4096 + e]; dcv[k] = p.DEC[base];
    }
    float hst = 0.f;
#pragma unroll
    for (int k = 0; k < NCH; ++k) {
        const int cc = dir ? (k < 2 ? 1 - k : 35 - k) : k;
        const long base = ((long)(b * NCH + cc) * 8 + head) * 2 + dir;
        { const float oth = __shfl_xor(hst, 1); if ((e & 1) == 0) wt_store((unsigned*)(p.HS + base * 4096 + e), pack_bf16(hst, oth)); }
        hst = dcv[k] * hst + stv[k];
    }
    unit_publish(p.SYNC + l * 2 + 1);
}

__device__ __forceinline__ void b_ssd_out(const P& p, int l, int unit, bf16_t* smem) {
    const int head = unit & 7, cc = (unit >> 3) % NCH, b = unit / (8 * NCH), g = head >> 2;
    const int tok0 = chunk_tok0(b, cc);
    const int tid = otid(), lane = tid & 63, w = tid >> 6, c = lane & 31, h = lane >> 5;
    bf16_t* Cs = smem; bf16_t* Bs = smem + 128 * 72; bf16_t* xT = smem + 2 * 128 * 72;
    float* cumv = (float*)(smem + 2 * 128 * 72 + 64 * XT_STRIDE); float* dtv = cumv + 256;
    __syncthreads();
    const int cpos = cc < 2 ? cc * 128 : (cc - 2) * 128, slen = cc < 2 ? LC : L;
    const int t = 32 * w + c;
    const bf16_t* zp = p.PROJ + (long)(tok0 + t) * PC + P_BZ + head * 64;
    {
        u32x4 rc[8], rb[8], rx[8];
        ssd_conv_load(p, tok0, cpos, slen, 640 + g * 64, rc);
        ssd_conv_load(p, tok0, cpos, slen, 512 + g * 64, rb);
        ssd_dt_cum(p, l, tok0, head, cumv, dtv);
        ssd_conv_apply<false>(p, l, 640 + g * 64, rc, Cs);
        ssd_conv_load(p, tok0, cpos, slen, head * 64, rx);
        ssd_conv_apply<false>(p, l, 512 + g * 64, rb, Bs);
        ssd_conv_apply<true>(p, l, head * 64, rx, xT);
    }
    unit_wait(p.SYNC + l * 2 + 1, (unsigned)(NB * 8 * 2 * 4096 / 256));
    bf16x8 cf[4];
#pragma unroll
    for (int ks = 0; ks < 4; ++ks) cf[ks] = *(const bf16x8*)(Cs + t * 72 + ks * 16 + h * 8);
    f32x16 gT[4];
#pragma unroll
    for (int st = 0; st < 4; ++st) {
#pragma unroll
        for (int e = 0; e < 16; ++e) gT[st][e] = 0.f;
#pragma unroll
        for (int ks = 0; ks < 4; ++ks) {
            const bf16x8 bfr = *(const bf16x8*)(Bs + (st * 32 + c) * 72 + ks * 16 + h * 8);
            gT[st] = __builtin_amdgcn_mfma_f32_32x32x16_bf16(bfr, cf[ks], gT[st], 0, 0, 0);
        }
    }
    f32x16 tot[2];
#pragma unroll
    for (int pt = 0; pt < 2; ++pt)
#pragma unroll
        for (int e = 0; e < 16; ++e) tot[pt][e] = 0.f;
#pragma unroll
    for (int dir = 0; dir < 2; ++dir) {
        const float ct = cumv[dir * 128 + t];
        bf16x8 hsf[4][2];
        {
            const bf16_t* hs = p.HS + (((long)(b * NCH + cc) * 8 + head) * 2 + dir) * 4096;
#pragma unroll
            for (int ks = 0; ks < 4; ++ks)
#pragma unroll
                for (int pt = 0; pt < 2; ++pt) hsf[ks][pt] = *(const bf16x8*)(hs + (pt * 32 + c) * 64 + ks * 16 + h * 8);
        }
#pragma unroll
        for (int st = 0; st < 4; ++st) {
            const bool need = dir ? (st >= w) : (st <= w);
            if (need) {
#pragma unroll
                for (int k2 = 0; k2 < 2; ++k2) {
                    float mv[8];
#pragma unroll
                    for (int j = 0; j < 8; ++j) {
                        const int sidx = st * 32 + 16 * k2 + 8 * (j >> 2) + 4 * h + (j & 3);
                        const float cs = cumv[dir * 128 + sidx], ds = dtv[dir * 128 + sidx];
                        const bool ok = (st != w) || (dir ? (sidx >= t) : (sidx <= t));
                        const float arg = ok ? ct - cs : -__builtin_inff();
                        mv[j] = gT[st][8 * k2 + j] * __expf(arg) * ds;
                    }
                    u32x4 pm; pm[0] = pack_bf16(mv[0], mv[1]); pm[1] = pack_bf16(mv[2], mv[3]); pm[2] = pack_bf16(mv[4], mv[5]); pm[3] = pack_bf16(mv[6], mv[7]);
                    const bf16x8 pmb = __builtin_bit_cast(bf16x8, pm);
#pragma unroll
                    for (int pt = 0; pt < 2; ++pt) {
                        const bf16_t* xr = xT + (pt * 32 + c) * XT_STRIDE + st * 32 + 16 * k2 + 4 * h;
                        const uint2 lo = *(const uint2*)xr, hi = *(const uint2*)(xr + 8);
                        const u32x4 xa = (u32x4){lo.x, lo.y, hi.x, hi.y};
                        tot[pt] = __builtin_amdgcn_mfma_f32_32x32x16_bf16(__builtin_bit_cast(bf16x8, xa), pmb, tot[pt], 0, 0, 0);
                    }
                }
            }
        }
        const float et = __expf(ct);
#pragma unroll
        for (int ks = 0; ks < 4; ++ks) {
            const u32x4 cr = __builtin_bit_cast(u32x4, cf[ks]);
            u32x4 cs4;
#pragma unroll
            for (int e = 0; e < 4; ++e) cs4[e] = pack_bf16(bf2f((bf16_t)(cr[e] & 0xffff)) * et, bf2f((bf16_t)(cr[e] >> 16)) * et);
            const bf16x8 cfs = __builtin_bit_cast(bf16x8, cs4);
#pragma unroll
            for (int pt = 0; pt < 2; ++pt) {
                tot[pt] = __builtin_amdgcn_mfma_f32_32x32x16_bf16(hsf[ks][pt], cfs, tot[pt], 0, 0, 0);
            }
        }
    }
    const float dsk = p.d_skip[(l * 2 + 0) * 8 + head] + p.d_skip[(l * 2 + 1) * 8 + head];
    bf16_t* gp = p.MIXO + (long)(tok0 + t) * D + 256 + head * 64;
    uint2 zr[2][4];
#pragma unroll
    for (int pt = 0; pt < 2; ++pt)
#pragma unroll
        for (int gq = 0; gq < 4; ++gq) zr[pt][gq] = *(const uint2*)(zp + pt * 32 + 8 * gq + 4 * h);
    float ss = 0.f;
#pragma unroll
    for (int pt = 0; pt < 2; ++pt)
#pragma unroll
        for (int gq = 0; gq < 4; ++gq) {
            const int p0 = pt * 32 + 8 * gq + 4 * h;
            const uint2 zq = zr[pt][gq];
            const float zv[4] = {bf2f((bf16_t)(zq.x & 0xffff)), bf2f((bf16_t)(zq.x >> 16)), bf2f((bf16_t)(zq.y & 0xffff)), bf2f((bf16_t)(zq.y >> 16))};
            float gv[4];
#pragma unroll
            for (int e = 0; e < 4; ++e) { const float y = tot[pt][4 * gq + e] + bf2f(xT[(p0 + e) * XT_STRIDE + t]) * dsk; gv[e] = y * siluf(zv[e]); ss += gv[e] * gv[e]; }
            uint2 ov; ov.x = pack_bf16(gv[0], gv[1]); ov.y = pack_bf16(gv[2], gv[3]);
            *(uint2*)(gp + p0) = ov;
        }
    ss += __shfl_xor(ss, 32);
    if (h == 0) p.SSQ[(long)(tok0 + t) * 8 + head] = ss;
}

__device__ __forceinline__ void b_norm2r(const P& p, int l, int vb, bf16_t* smem) {
    const int tid = otid(), wave = tid >> 6, lane = tid & 63;
    constexpr int HST = D + 16;
    bf16_t* Hs = smem;
    float* red = (float*)(smem + 16 * HST);
    float* lgs = red + 4 * 16 * 48;
    __syncthreads();
#pragma unroll 1
    for (int i4 = 0; i4 < 4; ++i4) {
        const int tl = wave * 4 + i4, tok = vb * 16 + tl;
        float v[16];
        const float* src = p.X + (long)tok * D;
#pragma unroll
        for (int i = 0; i < 4; ++i) { const float4 t = *(const float4*)(src + i * 256 + lane * 4); v[i * 4 + 0] = t.x; v[i * 4 + 1] = t.y; v[i * 4 + 2] = t.z; v[i * 4 + 3] = t.w; }
        float ss = 0.f;
#pragma unroll
        for (int i = 0; i < 16; ++i) ss += v[i] * v[i];
        ss = wave_sum(ss);
        const float r = rsqrtf(ss * (1.f / D) + EPS);
        const float* m = p.MOD + ((long)l * 5 + tok_modrow(tok)) * 6 * D;
        const float* nw = p.norm2_w + l * D;
        bf16_t* ho = p.H + (long)tok * D;
#pragma unroll
        for (int i = 0; i < 4; ++i) {
            const int k = i * 256 + lane * 4;
            const float4 w4 = *(const float4*)(nw + k), sc = *(const float4*)(m + 4 * D + k), sh = *(const float4*)(m + 3 * D + k);
            uint2 o;
            o.x = pack_bf16(v[i * 4 + 0] * r * w4.x * (1.f + sc.x) + sh.x, v[i * 4 + 1] * r * w4.y * (1.f + sc.y) + sh.y);
            o.y = pack_bf16(v[i * 4 + 2] * r * w4.z * (1.f + sc.z) + sh.z, v[i * 4 + 3] * r * w4.w * (1.f + sc.w) + sh.w);
            *(uint2*)(ho + k) = o;
            *(uint2*)(Hs + tl * HST + k) = o;
        }
    }
    __syncthreads();
    {
        const int lr = lane & 15, lq = lane >> 4;
        const bf16_t* wr = p.WT_R + ((long)l * 128 + lr) * D + wave * 256 + lq * 8;
        const bf16_t* hr = Hs + lr * HST + wave * 256 + lq * 8;
        f32x4 acc[3];
#pragma unroll
        for (int ni = 0; ni < 3; ++ni) acc[ni] = (f32x4){0.f, 0.f, 0.f, 0.f};
#pragma unroll
        for (int half = 0; half < 2; ++half) {
            bf16x8 wb[4][3];
#pragma unroll
            for (int ks = 0; ks < 4; ++ks)
#pragma unroll
                for (int ni = 0; ni < 3; ++ni) wb[ks][ni] = *(const bf16x8*)(wr + (long)ni * 16 * D + (half * 4 + ks) * 32);
#pragma unroll
            for (int ks = 0; ks < 4; ++ks) {
                const bf16x8 xa = *(const bf16x8*)(hr + (half * 4 + ks) * 32);
#pragma unroll
                for (int ni = 0; ni < 3; ++ni) acc[ni] = __builtin_amdgcn_mfma_f32_16x16x32_bf16(wb[ks][ni], xa, acc[ni], 0, 0, 0);
            }
        }
#pragma unroll
        for (int ni = 0; ni < 3; ++ni) *(f32x4*)(red + (wave * 16 + lr) * 48 + ni * 16 + lq * 4) = acc[ni];
    }
    __syncthreads();
#pragma unroll
    for (int i = 0; i < 3; ++i) {
        const int idx = tid + i * 256, t = idx / 48, j = idx % 48;
        lgs[t * 49 + j] = (red[(0 * 16 + t) * 48 + j] + red[(1 * 16 + t) * 48 + j]) + (red[(2 * 16 + t) * 48 + j] + red[(3 * 16 + t) * 48 + j]);
    }
    __syncthreads();
    if (tid < 16) {
        const int tok = vb * 16 + tid;
        const float* lg = lgs + tid * 49;
        int gs = 0; float gm = lg[0];
#pragma unroll
        for (int j = 1; j < 4; ++j) { const float v = lg[j]; if (v > gm) { gm = v; gs = j; } }
        float den = 0.f;
#pragma unroll
        for (int j = 0; j < 4; ++j) den += expf(lg[j] - gm);
        const float gp = 1.f / den;
        float e0 = -3.4e38f, e1 = -3.4e38f; int i0 = 0, i1 = 0;
#pragma unroll
        for (int j = 0; j < 8; ++j) {
            const float val = lg[4 + gs * 8 + j];
            if (val > e0) { e1 = e0; i1 = i0; e0 = val; i0 = j; }
            else if (val > e1) { e1 = val; i1 = j; }
        }
        const float x1 = expf(e1 - e0), w0 = gp / (1.f + x1), w1 = gp * x1 / (1.f + x1);
        const int ex0 = gs * 8 + i0, ex1 = gs * 8 + i1;
        int* cnt = p.cnt + l * NEXP;
        const int rk0 = atomicAdd(&cnt[ex0], 1); p.list[(long)ex0 * NTOK + rk0] = tok * 2 + 0; p.gatew[tok * 2 + 0] = w0;
        const int rk1 = atomicAdd(&cnt[ex1], 1); p.list[(long)ex1 * NTOK + rk1] = tok * 2 + 1; p.gatew[tok * 2 + 1] = w1;
    }
}

struct MoeTile { int e, mt, cnt, off; };
__device__ __forceinline__ int moe_row_tiles(const int* cnt) { int t = 0; for (int e = 0; e < NEXP; ++e) t += (cnt[e] + 127) >> 7; return t; }
__device__ __forceinline__ MoeTile moe_find_tile(const int* cnt, int tile) {
    MoeTile t; t.e = -1; t.mt = 0; t.cnt = 0; t.off = 0;
    int acc_t = 0, off = 0;
    for (int e = 0; e < NEXP; ++e) {
        const int c = cnt[e], nt = (c + 127) >> 7;
        if (t.e < 0 && tile < acc_t + nt) { t.e = e; t.mt = tile - acc_t; t.cnt = c; t.off = off; }
        acc_t += nt; off += c;
    }
    return t;
}
struct RowGather { const bf16_t* base; const int* lst; int n; __device__ __forceinline__ const bf16_t* operator()(int r) const { return base + (long)(lst[r < n ? r : n - 1] >> 1) * D; } };
struct RowLimit { const bf16_t* base; long ld; int n; __device__ __forceinline__ const bf16_t* operator()(int r) const { return base + (long)(r < n ? r : n - 1) * ld; } };
template <int NI> struct RowGateUp { const bf16_t* wg; const bf16_t* wu; __device__ __forceinline__ const bf16_t* operator()(int n) const {
    const int wn = n / (NI * 16), f = (n >> 4) % NI, j = n & 15, col = wn * (NI * 8) + (f % (NI / 2)) * 16 + j; return wg + (long)(f / (NI / 2)) * (wu - wg) + (long)col * D; } };

template <int NI>
__device__ __forceinline__ void b_moe_up(const P& p, int l, int rt, int h0, bf16_t* smem) {
    const MoeTile t = moe_find_tile(p.cnt + l * NEXP, rt);
    if (t.e < 0) return;
    const int nrow = min(128, t.cnt - t.mt * 128);
    RowGather ra{p.H, p.list + (long)t.e * NTOK + t.mt * 128, nrow};
    const long wofs = (((long)l * NEXP + t.e) * DEXP + h0) * D;
    RowGateUp<NI> rb{p.WT_G + wofs, p.WT_U + wofs};
    bf16_t* out = p.HID + (long)(t.off + t.mt * 128) * DEXP + h0;
    auto epi = [&](const f32x4 (&acc)[4][NI], int wm, int wn, int lr, int lq) {
#pragma unroll
        for (int mi = 0; mi < 4; ++mi) {
            const int r = wm * 64 + mi * 16 + lr;
            if (r < nrow) {
#pragma unroll
                for (int f = 0; f < NI / 2; ++f) {
                    const f32x4 gt = acc[mi][f], up = acc[mi][NI / 2 + f];
                    float hv[4];
#pragma unroll
                    for (int e = 0; e < 4; ++e) hv[e] = siluf(gt[e]) * up[e];
                    uint2 o; o.x = pack_bf16(hv[0], hv[1]); o.y = pack_bf16(hv[2], hv[3]);
                    *(uint2*)(out + (long)r * DEXP + wn * (NI * 8) + f * 16 + lq * 4) = o;
                }
            }
        }
    };
    if constexpr (NI == 8) gemm_tile32<4, 8>(ra, rb, D, smem, epi); else gemm_tile<4, NI>(ra, rb, D, smem, epi);
}

template <int NI>
__device__ __forceinline__ void b_moe_down(const P& p, int l, int rt, int n0, bf16_t* smem) {
    const MoeTile t = moe_find_tile(p.cnt + l * NEXP, rt);
    if (t.e < 0) return;
    const int nrow = min(128, t.cnt - t.mt * 128);
    const int slot0 = t.off + t.mt * 128;
    RowLimit ra{p.HID + (long)slot0 * DEXP, DEXP, nrow};
    RowLin rb{p.WT_D + (((long)l * NEXP + t.e) * D + n0) * DEXP, DEXP};
    const int* lst = p.list + (long)t.e * NTOK + t.mt * 128;
    int asg[4]; float gwv[4];
    {
        const int lane = otid() & 63, w = otid() >> 6;
#pragma unroll
        for (int mi = 0; mi < 4; ++mi) { const int r = (w >> 1) * 64 + mi * 16 + (lane & 15); asg[mi] = lst[r < nrow ? r : nrow - 1]; gwv[mi] = p.gatew[asg[mi]]; }
    }
    auto epi = [&](const f32x4 (&acc)[4][NI], int wm, int wn, int lr, int lq) {
#pragma unroll
        for (int mi = 0; mi < 4; ++mi) {
            const int r = wm * 64 + mi * 16 + lr;
            if (r < nrow) {
                const float gw = gwv[mi];
                if (n0 == 0 && wn == 0 && lq == 0) p.pos[asg[mi]] = slot0 + r;
#pragma unroll
                for (int ni = 0; ni < NI; ++ni) {
                    const int n = n0 + wn * (NI * 16) + ni * 16 + lq * 4;
                    const f32x4 a = acc[mi][ni];
                    uint2 o; o.x = pack_bf16(a[0] * gw, a[1] * gw); o.y = pack_bf16(a[2] * gw, a[3] * gw);
                    *(uint2*)(p.YS + (long)(slot0 + r) * D + n) = o;
                }
            }
        }
    };
    if constexpr (NI == 8) gemm_tile32<4, 8>(ra, rb, DEXP, smem, epi); else gemm_tile<4, NI>(ra, rb, DEXP, smem, epi);
}

__device__ __forceinline__ void b_final(const P& p, int vb) {
    const int wave = otid() >> 6, lane = otid() & 63;
    const int tok = vb * 4 + wave;
    if (tok >= NLAT) return;
    float v[16];
    const float* src = p.X + (long)tok * D;
#pragma unroll
    for (int i = 0; i < 4; ++i) { const float4 t = *(const float4*)(src + i * 256 + lane * 4); v[i * 4 + 0] = t.x; v[i * 4 + 1] = t.y; v[i * 4 + 2] = t.z; v[i * 4 + 3] = t.w; }
    {
        const bf16_t* ys0 = p.YS + (long)p.pos[tok * 2 + 0] * D; const bf16_t* ys1 = p.YS + (long)p.pos[tok * 2 + 1] * D;
        const float* g2 = p.MOD + ((long)(DEPTH - 1) * 5 + tok_modrow(tok)) * 6 * D + 5 * D;
#pragma unroll
        for (int i = 0; i < 4; ++i) {
            const uint2 t = *(const uint2*)(ys0 + i * 256 + lane * 4), u = *(const uint2*)(ys1 + i * 256 + lane * 4);
            const float4 g = *(const float4*)(g2 + i * 256 + lane * 4);
            v[i * 4 + 0] += (bf2f((bf16_t)(t.x & 0xffff)) + bf2f((bf16_t)(u.x & 0xffff))) * g.x; v[i * 4 + 1] += (bf2f((bf16_t)(t.x >> 16)) + bf2f((bf16_t)(u.x >> 16))) * g.y;
            v[i * 4 + 2] += (bf2f((bf16_t)(t.y & 0xffff)) + bf2f((bf16_t)(u.y & 0xffff))) * g.z; v[i * 4 + 3] += (bf2f((bf16_t)(t.y >> 16)) + bf2f((bf16_t)(u.y >> 16))) * g.w;
        }
    }
    float ss = 0.f;
#pragma unroll
    for (int i = 0; i < 16; ++i) ss += v[i] * v[i];
    ss = wave_sum(ss);
    const float r = rsqrtf(ss * (1.f / D) + EPS);
    float* o = p.out + (long)tok * D;
#pragma unroll
    for (int i = 0; i < 4; ++i) { const float4 w = *(const float4*)(p.final_w + i * 256 + lane * 4);
        *(float4*)(o + i * 256 + lane * 4) = make_float4(v[i * 4 + 0] * r * w.x, v[i * 4 + 1] * r * w.y, v[i * 4 + 2] * r * w.z, v[i * 4 + 3] * r * w.w); }
}


#define XB_TMO      128
#define XB_XCNT(j)  (256  + 64 * (j))
#define XB_XSUB(j)  (1280 + 64 * (j))
#define XB_XGEN(j)  (2304 + 64 * (j))
#define XB_TOP      3328
#define XB_TOPGEN   3392
#define XCD_BAR_WORDS 3456
#define XB_SPIN_CAP (1u << 22)
__device__ __forceinline__ unsigned xb_ld(unsigned* p)              { return __hip_atomic_load(p, __ATOMIC_RELAXED, __HIP_MEMORY_SCOPE_AGENT); }
__device__ __forceinline__ unsigned xb_add(unsigned* p, unsigned v) { return __hip_atomic_fetch_add(p, v, __ATOMIC_RELAXED, __HIP_MEMORY_SCOPE_AGENT); }
__device__ __forceinline__ unsigned xb_xcc_id() { return (unsigned)__builtin_amdgcn_s_getreg((3 << 11) | 20) & 0xFu; }
#define XB_SPIN(cond, bar) do { unsigned _sp = 0; while (cond) { __builtin_amdgcn_s_sleep(1); \
    if ((++_sp & 255u) == 0u) { if (xb_ld(&(bar)[XB_TMO])) break; if (_sp > XB_SPIN_CAP) { atomicAdd(&(bar)[XB_TMO], 1u); break; } } } } while (0)
struct XcdBarrier { unsigned* bar; unsigned x; volatile LAS unsigned* st; };
__device__ __forceinline__ XcdBarrier xcd_barrier_post(unsigned* bar, volatile LAS unsigned* st) {
    XcdBarrier b; b.bar = bar; b.x = xb_xcc_id(); b.st = st;
    if (threadIdx.x == 0) (void)xb_add(&bar[XB_XCNT(b.x)], 1u);
    return b;
}
__device__ __forceinline__ void xcd_barrier_complete(unsigned* bar, unsigned x, unsigned& nloc, unsigned& nx) {
    const unsigned G = gridDim.x * gridDim.y * gridDim.z;
    unsigned sum, cnt, mine, sp = 0u;
    for (;;) {
        sum = 0u; cnt = 0u; mine = 0u;
#pragma unroll
        for (unsigned j = 0; j < 16; ++j) { const unsigned c = xb_ld(&bar[XB_XCNT(j)]); sum += c; cnt += (c > 0u) ? 1u : 0u; mine = (j == x) ? c : mine; }
        if (sum == G) break;
        __builtin_amdgcn_s_sleep(1);
        if ((++sp & 255u) == 0u) { if (xb_ld(&bar[XB_TMO])) break; if (sp > XB_SPIN_CAP) { atomicAdd(&bar[XB_TMO], 1u); break; } }
    }
    nloc = mine > 0u ? mine : 1u; nx = cnt > 0u ? cnt : 1u;
}
__device__ __forceinline__ void xcd_barrier(const XcdBarrier& b) {
    asm volatile("s_waitcnt vmcnt(0)" ::: "memory");
    __syncthreads();
    if (threadIdx.x == 0) {
        unsigned* bar = b.bar;
        __builtin_amdgcn_s_waitcnt(0);
        unsigned bx = __builtin_amdgcn_readfirstlane(b.x); asm volatile("" : "+s"(bx));
        unsigned nloc = b.st[0], nx = b.st[1];
        if (nloc == 0u) { xcd_barrier_complete(bar, bx, nloc, nx); b.st[0] = nloc; b.st[1] = nx; }
        const unsigned old = xb_add(&bar[XB_XSUB(bx)], 1u);
        const unsigned gen = old / nloc;
        if (old + 1u == (gen + 1u) * nloc) {
            __builtin_amdgcn_fence(__ATOMIC_RELEASE, "agent");
            asm volatile("s_waitcnt vmcnt(0)" ::: "memory");
            const unsigned og = xb_add(&bar[XB_TOP], 1u);
            const unsigned tg = og / nx;
            if (og + 1u == (tg + 1u) * nx) xb_add(&bar[XB_TOPGEN], 1u);
            else XB_SPIN(xb_ld(&bar[XB_TOPGEN]) == tg, bar);
            __builtin_amdgcn_fence(__ATOMIC_ACQUIRE, "agent");
            xb_add(&bar[XB_XGEN(bx)], 1u);
            asm volatile("s_waitcnt vmcnt(0)" ::: "memory");
        } else {
            XB_SPIN(xb_ld(&bar[XB_XGEN(bx)]) == gen, bar);
            __builtin_amdgcn_fence(__ATOMIC_ACQUIRE, "agent");
            asm volatile("s_waitcnt vmcnt(0)" ::: "memory");
        }
    }
    __syncthreads();
}

#define FOR_VB(n) for (int vb = blockIdx.x; vb < (n); vb += gridDim.x)
#define FOR_VB_XCD(n) for (int _ch = ((n) + 7) >> 3, _j = (int)blockIdx.x >> 3, vb = ((int)blockIdx.x & 7) * _ch + _j; _j < _ch; _j += (int)gridDim.x >> 3, vb += (int)gridDim.x >> 3) if (vb < (n))
#define FOR_VB_OFF(n, off) for (int vb = (int)((blockIdx.x + gridDim.x - ((off) % gridDim.x)) % gridDim.x); vb < (n); vb += gridDim.x)
__global__ void __launch_bounds__(256, 2) k_mega(P p) {
    extern __shared__ __attribute__((aligned(16))) unsigned char dynlds[];
    bf16_t* smem = (bf16_t*)dynlds;
    uint4* xbw = (uint4*)(dynlds + SMEM_BYTES);
    float (*tt)[65] = (float (*)[65])smem;
    if (threadIdx.x == 0) *xbw = make_uint4(0u, 0u, 0u, 0u);
    __syncthreads();
    const XcdBarrier xb = xcd_barrier_post(p.bar, (volatile LAS unsigned*)xbw);
    if (threadIdx.x == 0) {
        const unsigned key = (xb.x << 8) | ((unsigned)__builtin_amdgcn_s_getreg((7 << 11) | (8 << 6) | 4) & 0xFFu);
        ((volatile LAS unsigned*)xbw)[4] = xb_add(&p.cuslot[key], 1u) & 1u;
    }
    __syncthreads();
    const int slot = __builtin_amdgcn_readfirstlane((int)((volatile LAS unsigned*)xbw)[4]);
    if (blockIdx.x == 0 && otid() < DEPTH * NEXP) p.cnt[otid()] = 0;
    if (blockIdx.x == 1 && otid() < DEPTH * NB * 10) p.KMAX[otid()] = 0u;
    if (blockIdx.x == 2) for (int i = otid(); i < SY_LAYER + DEPTH * SY_STRIDE; i += 256) p.SYNC[i] = 0u;
    FOR_VB(6) b_rope_table(p, vb);
    FOR_VB(DEPTH * 6 * D / 64) b_mod(p, vb, (float*)smem);
    __syncthreads();
    constexpr int CI1 = 28 * 16 / 4, CI2 = 12 * 16 / 4, CVO = (D / 64) * (D / 64) / 4;
    auto prep_in = [&](int bz, int off) {
        FOR_VB_OFF(CI1, off) b_convT_stream(bz * CI1 + vb, p.w_in, p.WT_IN, D, 1792, nullptr, IN_COLS, 0, 0, (long)D * IN_COLS, (long)PCW * D);
        FOR_VB_OFF(CI2, off + CI1) b_convT_stream(bz * CI2 + vb, p.w_in, p.WT_IN, D, 768, nullptr, IN_COLS, 1808, 1792, (long)D * IN_COLS, (long)PCW * D);
        FOR_VB_OFF(16, off + CI1 + CI2) b_convT(tt, 0, vb, bz, p.w_in, p.WT_IN, D, IN_COLS, OLD_BDT, 16, PC, (long)D * IN_COLS, (long)PCW * D);
    };
    prep_in(0, 0);
    FOR_VB(1 * 16 * DEPTH) b_convT(tt, 0, vb % 16, vb / 16, p.w_grouter, p.WT_R, D, 4, 0, 4, 0, (long)D * 4, (long)128 * D);
    FOR_VB(1 * 16 * DEPTH) b_convT(tt, 0, vb % 16, vb / 16, p.w_router, p.WT_R, D, 32, 0, 32, 4, (long)D * 32, (long)128 * D);
    xcd_barrier(xb);
    for (int l = 0; l < DEPTH; ++l) {
        const bool last = (l == DEPTH - 1);
        const int ntok = last ? NLAT : NTOK;
        FOR_VB(NTOK / 16) b_norm1(p, l, vb);
        {
            constexpr int NT = PCW / 128, MPX = (NTOK / 128) / 8, CH = MPX * NT, M0 = (MPX + 1) / 2, M1 = MPX - M0;
            for (int j = (int)blockIdx.x >> 3; j < CH; j += (int)gridDim.x >> 3) {
                const int jj = j < M0 * NT ? j : j - M0 * NT, mh = j < M0 * NT ? M0 : M1, m = (j < M0 * NT ? 0 : M0) + jj % mh, n = jj / mh;
                b_inproj(p, l, (((int)blockIdx.x & 7) * MPX + m) * NT + n, smem);
            }
        }
        xcd_barrier(xb);
        {
            const int nst = NB * NCH * 8, nsc = NB * 8 * 2 * 4096 / 256;
            const int ncu = NB * 4 * (L / 128) + (last ? 0 : NB * 4 * 2);
            FOR_VB_OFF(nst, 0) b_ssd_states(p, l, vb, smem);
            constexpr int CVL = NEXP * (D / 64) * (DEXP / 64) / 4;
#pragma unroll 1
            for (int step = 0; step < 2; ++step) {
                if ((step ^ slot) == 0) {
                    __builtin_amdgcn_s_setprio(2);
                    FOR_VB_OFF(ncu, nst) b_attnC(p, l, vb, smem);
                    __builtin_amdgcn_s_setprio(0);
                } else {
                    for (int vb = l * CVL + (int)blockIdx.x; vb < (l + 1) * CVL; vb += (int)gridDim.x) b_convT_stream(vb, p.w_gate, p.WT_G, D, DEXP);
                    for (int vb = l * CVL + (int)blockIdx.x; vb < (l + 1) * CVL; vb += (int)gridDim.x) b_convT_stream(vb, p.w_up, p.WT_U, D, DEXP);
                    for (int vb = l * CVL + (int)blockIdx.x; vb < (l + 1) * CVL; vb += (int)gridDim.x) b_convT_stream(vb, p.w_down, p.WT_D, DEXP, D);
                    FOR_VB_OFF(CVO, 192) b_convT_stream(l * CVO + vb, p.w_out, p.WT_OUT, D, D, p.b_norm_w);
                    if (l + 1 < DEPTH) prep_in(l + 1, 192 + CVO);
                }
                if (step == 0) { FOR_VB_OFF(nsc, nst + ncu) b_ssd_scan(p, l, vb); }
            }
            FOR_VB_OFF(ncu, nst + nsc + ncu) b_attnA(p, l, vb, smem);
            FOR_VB_OFF(nst, nst + nsc + 2 * ncu) { if (last && ((vb >> 3) % NCH) < 2) continue; b_ssd_out(p, l, vb, smem); }
        }
        xcd_barrier(xb);
        {
            const int ch = (ntok / 128) * (D / 128) / 8, bpx = (int)gridDim.x >> 3, j = (int)blockIdx.x >> 3, xc = (int)blockIdx.x & 7;
            const int rem = ch % bpx, nfull = (rem * 8 <= bpx) ? ch - rem : ch;
            for (int t = j; t < nfull; t += bpx) { const int vb = xc * ch + t; b_outproj<4, 4>(p, l, (vb >> 3) * 128, (vb & 7) * 128, smem); }
            for (int q = j; q < (ch - nfull) * 8; q += bpx) { const int vb = xc * ch + nfull + (q >> 3), sub = q & 7; b_outproj<2, 1>(p, l, (vb >> 3) * 128 + (sub >> 2) * 64, (vb & 7) * 128 + (sub & 3) * 32, smem); }
        }
        xcd_barrier(xb);
        FOR_VB(ntok / 16) b_norm2r(p, l, vb, smem);
        xcd_barrier(xb);
        const int nbig = moe_row_tiles(p.cnt + l * NEXP) * 4, mch = (nbig + 7) >> 3, bpx = (int)gridDim.x >> 3, mj = (int)blockIdx.x >> 3;
        const int mlo = ((int)blockIdx.x & 7) * mch, mcnt = max(min(mlo + mch, nbig) - mlo, 0), mrem = mcnt % bpx;
        const int msplit = (mrem == 0) ? 1 : (mrem * 4 <= bpx) ? 4 : (mrem * 2 <= bpx) ? 2 : 1, mfull = msplit > 1 ? mcnt - mrem : mcnt;
        for (int t = mj; t < mfull; t += bpx) { const int bt = mlo + t; b_moe_up<8>(p, l, bt >> 2, (bt & 3) * 128, smem); }
        if (msplit == 4) { for (int q = mj; q < mrem * 4; q += bpx) { const int bt = mlo + mfull + (q >> 2); b_moe_up<2>(p, l, bt >> 2, (bt & 3) * 128 + (q & 3) * 32, smem); } }
        else if (msplit == 2) { for (int q = mj; q < mrem * 2; q += bpx) { const int bt = mlo + mfull + (q >> 1); b_moe_up<4>(p, l, bt >> 2, (bt & 3) * 128 + (q & 1) * 64, smem); } }
        xcd_barrier(xb);
        for (int t = mj; t < mfull; t += bpx) { const int bt = mlo + t; b_moe_down<8>(p, l, bt >> 2, (bt & 3) * 256, smem); }
        if (msplit == 4) { for (int q = mj; q < mrem * 4; q += bpx) { const int bt = mlo + mfull + (q >> 2); b_moe_down<2>(p, l, bt >> 2, (bt & 3) * 256 + (q & 3) * 64, smem); } }
        else if (msplit == 2) { for (int q = mj; q < mrem * 2; q += bpx) { const int bt = mlo + mfull + (q >> 1); b_moe_down<4>(p, l, bt >> 2, (bt & 3) * 256 + (q & 1) * 128, smem); } }
        xcd_barrier(xb);
    }
    FOR_VB(NLAT / 4) b_final(p, vb);
}

extern "C" void kernel_launch(void* const* d_in, const int* in_sizes, int n_in, void* d_out, int out_size, void* d_ws, size_t ws_size, hipStream_t stream) {
    P p{};
    const float** f = (const float**)&p;
    for (int i = 0; i < 25; ++i) f[i] = (const float*)d_in[i];
    p.out = (float*)d_out;
    char* w = (char*)d_ws; size_t off = 0;
    auto take = [&](size_t bytes) { char* r = w + off; off += (bytes + 255) & ~(size_t)255; return r; };
    p.X = (float*)take((size_t)NTOK * D * 4);
    p.MOD = (float*)take((size_t)DEPTH * 5 * 6 * D * 4);
    p.DT = (float*)take((size_t)NTOK * 16 * 4);
    p.SSQ = (float*)take((size_t)NTOK * 8 * 4);
    p.SYNC = (unsigned*)take((size_t)(SY_LAYER + DEPTH * SY_STRIDE) * 4);
    p.ST = (float*)take((size_t)NB * NCH * 16 * 4096 * 4);
    p.DEC = (float*)take((size_t)NB * NCH * 16 * 4);
    p.HS = (bf16_t*)take((size_t)NB * NCH * 16 * 4096 * 2);
    p.gatew = (float*)take((size_t)NTOK * 2 * 4);
    p.H = (bf16_t*)take((size_t)NTOK * D * 2);
    p.PROJ = (bf16_t*)take((size_t)NTOK * PC * 2);
    p.WT_IN = (bf16_t*)take((size_t)DEPTH * PCW * D * 2);
    p.WT_R = (bf16_t*)take((size_t)DEPTH * 128 * D * 2);
    p.WT_OUT = (bf16_t*)take((size_t)DEPTH * D * D * 2);
    p.WT_G = (bf16_t*)take((size_t)DEPTH * NEXP * DEXP * D * 2);
    p.WT_U = (bf16_t*)take((size_t)DEPTH * NEXP * DEXP * D * 2);
    p.WT_D = (bf16_t*)take((size_t)DEPTH * NEXP * DEXP * D * 2);
    p.MIXO = (bf16_t*)take((size_t)NTOK * D * 2);
    p.HID = (bf16_t*)take((size_t)(NTOK * 2 + 128) * DEXP * 2);
    p.YS = (bf16_t*)take((size_t)(NTOK * 2 + 128) * D * 2);
    p.cnt = (int*)take((size_t)DEPTH * NEXP * 4);
    p.list = (int*)take((size_t)NEXP * NTOK * 4);
    p.pos = (int*)take((size_t)NTOK * 2 * 4);
    p.VT = (bf16_t*)take((size_t)NB * 4 * 64 * NKEY * 2);
    p.VTA = (bf16_t*)take((size_t)NB * 2 * 64 * NKEY * 2);
    p.bar = (unsigned*)take((size_t)(XCD_BAR_WORDS + 4096) * 4); p.cuslot = p.bar + XCD_BAR_WORDS;
    p.ROPE = (float*)take((size_t)64 * 24 * 2 * 4);
    p.KMAX = (unsigned*)take((size_t)DEPTH * NB * 10 * 4);
    if (off > ws_size) { fprintf(stderr, "workspace too small: need %zu have %zu\n", off, ws_size); return; }

    (void)hipMemsetAsync(p.bar, 0, (XCD_BAR_WORDS + 4096) * 4, stream);
    static int grid_blocks = 0;
    if (!grid_blocks) {
        int dev = 0, cus = 0, per_cu = 0;
        (void)hipGetDevice(&dev);
        (void)hipDeviceGetAttribute(&cus, hipDeviceAttributeMultiprocessorCount, dev);
        if (hipFuncSetAttribute((const void*)k_mega, hipFuncAttributeMaxDynamicSharedMemorySize, LDS_BYTES) != hipSuccess) fprintf(stderr, "hipFuncSetAttribute(LDS %d) failed\n", LDS_BYTES);
        (void)hipOccupancyMaxActiveBlocksPerMultiprocessor(&per_cu, k_mega, 256, LDS_BYTES);
        if (per_cu > 2) per_cu = 2;
        grid_blocks = cus * per_cu;
    }
    void* args[] = {&p};
    hipError_t e = hipLaunchCooperativeKernel((void*)k_mega, dim3(grid_blocks), dim3(256), args, LDS_BYTES, stream);
    if (e != hipSuccess) fprintf(stderr, "cooperative launch failed: %s (grid %d)\n", hipGetErrorString(e), grid_blocks);
}
```

```cpp
#include <hip/hip_runtime.h>
#include <cstdio>
#include <cstdint>

typedef unsigned short bf16_t;
typedef short bf16x8 __attribute__((ext_vector_type(8)));
typedef float f32x4 __attribute__((ext_vector_type(4)));
typedef unsigned u32x4 __attribute__((ext_vector_type(4)));
typedef float f32x16 __attribute__((ext_vector_type(16)));

constexpr int D = 1024, NB = 4, L = 4096, LC = 256, NLAT = NB * L, NCTX = NB * LC, NTOK = NLAT + NCTX, DEPTH = 4;
constexpr int IN_COLS = 2576, OLD_BDT = 1792;
constexpr int PC = 2560;
constexpr int PCW = 2688;
constexpr int P_AQ = 0, P_AK = 256, P_AV = 384, P_BZ = 512, P_BX = 1024, P_CQ = 1792, P_CK = 2048, P_CV = 2304;
constexpr int NEXP = 32, DEXP = 512;
constexpr int NKEY = L + LC;
constexpr int NKT = NKEY / 64;
constexpr float EPS = 1e-6f;

__device__ __forceinline__ int otid() { int t = threadIdx.x; asm volatile("" : "+v"(t)); return t; }
typedef __bf16 bf16n2 __attribute__((ext_vector_type(2)));
__device__ __forceinline__ bf16_t f2bf(float f) { return __builtin_bit_cast(bf16_t, (__bf16)f); }
__device__ __forceinline__ unsigned pack_bf16(float a, float b) { const bf16n2 v = {(__bf16)a, (__bf16)b}; return __builtin_bit_cast(unsigned, v); }
__device__ __forceinline__ float bf2f(bf16_t h) { return __uint_as_float(((unsigned)h) << 16); }
__device__ __forceinline__ float wave_sum(float v) {
#pragma unroll
    for (int o = 32; o > 0; o >>= 1) v += __shfl_xor(v, o);
    return v;
}
__device__ __forceinline__ float siluf(float v) { return v * __builtin_amdgcn_rcpf(1.f + __expf(-v)); }
__device__ __forceinline__ int tok_modrow(int tok) { return tok < NLAT ? tok / L : NB; }

struct P {
    const float *x, *c, *ctx, *c_ctx, *w_mod, *b_mod, *norm1_w, *norm2_w, *w_in, *w_out, *a_sink, *conv_w, *conv_b, *dt_bias, *a_log, *d_skip,
        *b_norm_w, *c_lambda, *c_subln_w, *w_grouter, *w_router, *w_gate, *w_up, *w_down, *final_w;
    float* out;
    float* X; float* MOD; float* DT; float* SSQ; float* gatew; float* ST; float* DEC; float* ROPE;
    bf16_t *H, *PROJ, *WT_IN, *WT_OUT, *WT_G, *WT_U, *WT_D, *MIXO, *HID, *YS, *VT, *VTA, *HS, *WT_R;
    int *cnt, *list, *pos;
    unsigned* bar; unsigned* cuslot;
    unsigned* SYNC;
    unsigned* KMAX;
};

__device__ __forceinline__ void b_convT(float (*t)[65], int bx, int by, int bz, const float* __restrict__ src, bf16_t* __restrict__ dst, int K, int ld_src, int c0, int ncols, int n_dst0,
                                        long src_bstride, long dst_bstride) {
    src += (long)bz * src_bstride; dst += (long)bz * dst_bstride;
    const int kb = by * 64, nb = bx * 64, tid = otid();
    const int c4 = (tid & 15) * 4, kr0 = tid >> 4;
#pragma unroll
    for (int i = 0; i < 4; ++i) {
        const int kr = kr0 + i * 16;
        float4 v = make_float4(0.f, 0.f, 0.f, 0.f);
        if (nb + c4 < ncols) v = *(const float4*)(src + (long)(kb + kr) * ld_src + c0 + nb + c4);
        t[kr][c4] = v.x; t[kr][c4 + 1] = v.y; t[kr][c4 + 2] = v.z; t[kr][c4 + 3] = v.w;
    }
    __syncthreads();
    const int n = tid >> 2, kq = (tid & 3) * 16;
    if (nb + n < ncols) {
        unsigned o[8];
#pragma unroll
        for (int j = 0; j < 8; ++j) o[j] = (unsigned)f2bf(t[kq + 2 * j][n]) | ((unsigned)f2bf(t[kq + 2 * j + 1][n]) << 16);
        bf16_t* d = dst + (long)(n_dst0 + nb + n) * K + kb + kq;
        *(u32x4*)d = (u32x4){o[0], o[1], o[2], o[3]};
        *(u32x4*)(d + 8) = (u32x4){o[4], o[5], o[6], o[7]};
    }
    __syncthreads();
}

__device__ __forceinline__ void b_convT_stream(int vb, const float* __restrict__ src, bf16_t* __restrict__ dst, int K, int N, const float* rowscale = nullptr,
                                               int ld_src = 0, int c0 = 0, int n_dst0 = 0, long src_ms = 0, long dst_ms = 0) {
    const int tid = otid(), lane = tid & 63;
    const int gw = vb * 4 + (tid >> 6);
    const int nbs = N >> 6, kbs = K >> 6;
    const int mat = gw / (nbs * kbs), r = gw % (nbs * kbs), kb = r / nbs, nb = r % nbs;
    const int kq = lane & 3, n4l = lane >> 2;
    if (ld_src == 0) { ld_src = N; src_ms = (long)K * N; dst_ms = (long)K * N; }
    const float* sp = src + mat * src_ms + (long)(kb * 64 + kq * 8) * ld_src + c0 + nb * 64 + n4l * 4;
    float4 v[16];
#pragma unroll
    for (int j = 0; j < 16; ++j) v[j] = *(const float4*)(sp + (long)((j & 7) + (j >> 3) * 32) * ld_src);
    if (rowscale) {
        const int k0 = kb * 64 + kq * 8;
        if (k0 >= 256 && k0 < 768) {
#pragma unroll
            for (int j = 0; j < 16; ++j) { const float sc = rowscale[mat * 512 + k0 - 256 + (j & 7) + (j >> 3) * 32]; v[j].x *= sc; v[j].y *= sc; v[j].z *= sc; v[j].w *= sc; }
        }
    }
    bf16_t* dp = dst + mat * dst_ms + (long)(n_dst0 + nb * 64 + n4l * 4) * K + kb * 64 + kq * 8;
    u32x4 o0, o1;
#pragma unroll
    for (int j = 0; j < 4; ++j) { o0[j] = pack_bf16(v[2 * j].x, v[2 * j + 1].x); o1[j] = pack_bf16(v[8 + 2 * j].x, v[8 + 2 * j + 1].x); }
    *(u32x4*)dp = o0; *(u32x4*)(dp + 32) = o1;
#pragma unroll
    for (int j = 0; j < 4; ++j) { o0[j] = pack_bf16(v[2 * j].y, v[2 * j + 1].y); o1[j] = pack_bf16(v[8 + 2 * j].y, v[8 + 2 * j + 1].y); }
    *(u32x4*)(dp + K) = o0; *(u32x4*)(dp + K + 32) = o1;
#pragma unroll
    for (int j = 0; j < 4; ++j) { o0[j] = pack_bf16(v[2 * j].z, v[2 * j + 1].z); o1[j] = pack_bf16(v[8 + 2 * j].z, v[8 + 2 * j + 1].z); }
    *(u32x4*)(dp + 2 * K) = o0; *(u32x4*)(dp + 2 * K + 32) = o1;
#pragma unroll
    for (int j = 0; j < 4; ++j) { o0[j] = pack_bf16(v[2 * j].w, v[2 * j + 1].w); o1[j] = pack_bf16(v[8 + 2 * j].w, v[8 + 2 * j + 1].w); }
    *(u32x4*)(dp + 3 * K) = o0; *(u32x4*)(dp + 3 * K + 32) = o1;
}

__device__ __forceinline__ void b_rope_table(const P& p, int vb) {
    const int idx = vb * 256 + otid();
    if (idx >= 64 * 24) return;
    const int pos = idx / 24, f = idx % 24;
    const float fr = f < 16 ? __expf(-(float)f * (1.f / 16.f) * 9.210340371976184f) : __expf(-(float)(f - 16) * (1.f / 8.f) * 9.210340371976184f);
    float sn, cs; sincosf((float)pos * fr, &sn, &cs);
    p.ROPE[idx * 2] = cs; p.ROPE[idx * 2 + 1] = sn;
}

__device__ __forceinline__ void b_mod(const P& p, int vb, float* red) {
    const int tid = otid(), lane = tid & 63, kq = tid >> 6, ks = lane >> 4, c4 = (lane & 15) * 4;
    const int idx = vb * 64 + c4;
    const int l = idx / (6 * D), n = idx % (6 * D);
    float acc[5][4];
#pragma unroll
    for (int r = 0; r < 5; ++r)
#pragma unroll
        for (int e = 0; e < 4; ++e) acc[r][e] = 0.f;
    const float* w = p.w_mod + (long)l * D * 6 * D + n;
#pragma unroll 8
    for (int k = kq * 256 + ks; k < kq * 256 + 256; k += 4) {
        const float4 wv = *(const float4*)(w + (long)k * 6 * D);
#pragma unroll
        for (int r = 0; r < 5; ++r) {
            const float cv = siluf((r < 4) ? p.c[r * D + k] : p.c_ctx[k]);
            acc[r][0] += cv * wv.x; acc[r][1] += cv * wv.y; acc[r][2] += cv * wv.z; acc[r][3] += cv * wv.w;
        }
    }
#pragma unroll
    for (int r = 0; r < 5; ++r)
#pragma unroll
        for (int e = 0; e < 4; ++e) { float v = acc[r][e]; v += __shfl_xor(v, 16); v += __shfl_xor(v, 32); acc[r][e] = v; }
    __syncthreads();
    if (ks == 0) {
#pragma unroll
        for (int r = 0; r < 5; ++r) *(float4*)(red + (kq * 5 + r) * 64 + c4) = make_float4(acc[r][0], acc[r][1], acc[r][2], acc[r][3]);
    }
    __syncthreads();
    if (tid < 64) {
        const int col = tid, i2 = vb * 64 + col, n2 = i2 % (6 * D);
        const float bv = p.b_mod[l * 6 * D + n2];
#pragma unroll
        for (int r = 0; r < 5; ++r) p.MOD[((long)l * 5 + r) * 6 * D + n2] = ((red[(0 * 5 + r) * 64 + col] + red[(1 * 5 + r) * 64 + col]) + (red[(2 * 5 + r) * 64 + col] + red[(3 * 5 + r) * 64 + col])) + bv;
    }
}

__device__ __forceinline__ void wt_store(float* ptr, float v) { __hip_atomic_store(ptr, v, __ATOMIC_RELAXED, __HIP_MEMORY_SCOPE_AGENT); }
__device__ __forceinline__ void wt_store(unsigned* ptr, unsigned v) { __hip_atomic_store(ptr, v, __ATOMIC_RELAXED, __HIP_MEMORY_SCOPE_AGENT); }
__device__ __forceinline__ void wt_store8(void* ptr, unsigned lo, unsigned hi) { __hip_atomic_store((unsigned long long*)ptr, ((unsigned long long)hi << 32) | lo, __ATOMIC_RELAXED, __HIP_MEMORY_SCOPE_AGENT); }
__device__ __forceinline__ void unit_publish(unsigned* cnt) {
    asm volatile("s_waitcnt vmcnt(0)" ::: "memory");
    __syncthreads();
    if (threadIdx.x == 0) (void)__hip_atomic_fetch_add(cnt, 1u, __ATOMIC_RELAXED, __HIP_MEMORY_SCOPE_AGENT);
}
__device__ __forceinline__ void unit_wait(unsigned* cnt, unsigned target) {
    if (threadIdx.x == 0) {
        unsigned sp = 0;
        while (__hip_atomic_load(cnt, __ATOMIC_RELAXED, __HIP_MEMORY_SCOPE_AGENT) < target) { __builtin_amdgcn_s_sleep(2); if (++sp > (1u << 24)) break; }
        __builtin_amdgcn_fence(__ATOMIC_ACQUIRE, "agent");
        asm volatile("s_waitcnt vmcnt(0)" ::: "memory");
    }
    __syncthreads();
}

__device__ __forceinline__ void unit_wait_nf(unsigned* cnt, unsigned target) {
    if (threadIdx.x == 0) {
        unsigned sp = 0;
        while (__hip_atomic_load(cnt, __ATOMIC_RELAXED, __HIP_MEMORY_SCOPE_AGENT) < target) { __builtin_amdgcn_s_sleep(2); if (++sp > (1u << 24)) break; }
    }
    __syncthreads();
    asm volatile("" ::: "memory");
}
constexpr int SY_LAYER = 64, SY_STRIDE = 1024, SY_N1 = 0, SY_OP = 136, SY_N2 = 272, SY_UP = 408;
__device__ __forceinline__ unsigned* sync_ctr(const P& p, int l, int which, int idx) { return p.SYNC + SY_LAYER + l * SY_STRIDE + which + idx; }

__device__ __forceinline__ void b_norm1(const P& p, int l, int vb) {
    const int wave = otid() >> 6, lane = otid() & 63;
#pragma unroll 1
    for (int i4 = 0; i4 < 4; ++i4) {
        const int tok = vb * 16 + wave * 4 + i4;
        float v[16];
        const float* src = (l == 0) ? (tok < NLAT ? p.x + (long)tok * D : p.ctx + (long)(tok - NLAT) * D) : p.X + (long)tok * D;
#pragma unroll
        for (int i = 0; i < 4; ++i) { const float4 t = *(const float4*)(src + i * 256 + lane * 4); v[i * 4 + 0] = t.x; v[i * 4 + 1] = t.y; v[i * 4 + 2] = t.z; v[i * 4 + 3] = t.w; }
        if (l > 0) {
            const bf16_t* ys0 = p.YS + (long)p.pos[tok * 2 + 0] * D; const bf16_t* ys1 = p.YS + (long)p.pos[tok * 2 + 1] * D;
            const float* g2 = p.MOD + ((long)(l - 1) * 5 + tok_modrow(tok)) * 6 * D + 5 * D;
#pragma unroll
            for (int i = 0; i < 4; ++i) {
                const uint2 t = *(const uint2*)(ys0 + i * 256 + lane * 4), u = *(const uint2*)(ys1 + i * 256 + lane * 4);
                const float4 g = *(const float4*)(g2 + i * 256 + lane * 4);
                v[i * 4 + 0] += (bf2f((bf16_t)(t.x & 0xffff)) + bf2f((bf16_t)(u.x & 0xffff))) * g.x; v[i * 4 + 1] += (bf2f((bf16_t)(t.x >> 16)) + bf2f((bf16_t)(u.x >> 16))) * g.y;
                v[i * 4 + 2] += (bf2f((bf16_t)(t.y & 0xffff)) + bf2f((bf16_t)(u.y & 0xffff))) * g.z; v[i * 4 + 3] += (bf2f((bf16_t)(t.y >> 16)) + bf2f((bf16_t)(u.y >> 16))) * g.w;
            }
        }
        float* xo = p.X + (long)tok * D;
#pragma unroll
        for (int i = 0; i < 4; ++i) *(float4*)(xo + i * 256 + lane * 4) = make_float4(v[i * 4 + 0], v[i * 4 + 1], v[i * 4 + 2], v[i * 4 + 3]);
        float ss = 0.f;
#pragma unroll
        for (int i = 0; i < 16; ++i) ss += v[i] * v[i];
        ss = wave_sum(ss);
        const float r = rsqrtf(ss * (1.f / D) + EPS);
        const float* m = p.MOD + ((long)l * 5 + tok_modrow(tok)) * 6 * D;
        const float* nw = p.norm1_w + l * D;
        bf16_t* ho = p.H + (long)tok * D;
#pragma unroll
        for (int i = 0; i < 4; ++i) {
            const int k = i * 256 + lane * 4;
            const float4 w4 = *(const float4*)(nw + k), sc = *(const float4*)(m + D + k), sh = *(const float4*)(m + k);
            wt_store8(ho + k, pack_bf16(v[i * 4 + 0] * r * w4.x * (1.f + sc.x) + sh.x, v[i * 4 + 1] * r * w4.y * (1.f + sc.y) + sh.y),
                              pack_bf16(v[i * 4 + 2] * r * w4.z * (1.f + sc.z) + sh.z, v[i * 4 + 3] * r * w4.w * (1.f + sc.w) + sh.w));
        }
    }
    unit_publish(sync_ctr(p, l, SY_N1, vb >> 3));
}

#define LAS __attribute__((address_space(3)))
constexpr int LDS_STRIDE = 72;
constexpr int SMEM_BYTES = 65536;
constexpr int LDS_BYTES = SMEM_BYTES + 256;
struct NoHook { template <class A> __device__ __forceinline__ void operator()(int, A&) const {} };
template <int MI = 4, int NI = 4, class RowA, class RowB, class Epi, class Hook = NoHook>
__device__ __forceinline__ void gemm_tile(const RowA& ra, const RowB& rb, int K, bf16_t* smem, const Epi& epi, const Hook& hook = Hook()) {
    LAS unsigned char* lds = (LAS unsigned char*)smem;
    const int tid = otid(), lane = tid & 63, w = __builtin_amdgcn_readfirstlane(tid >> 6), wm = w >> 1, wn = w & 1, lr = lane & 15, lq = lane >> 4;
    f32x4 acc[MI][NI];
#pragma unroll
    for (int i = 0; i < MI; ++i)
#pragma unroll
        for (int j = 0; j < NI; ++j) acc[i][j] = (f32x4){0.f, 0.f, 0.f, 0.f};
    const bf16_t* pa[MI]; const bf16_t* pb[NI];
    const int kcs = ((lane & 7) ^ ((lane >> 3) & 7)) * 8;
#pragma unroll
    for (int i = 0; i < MI; ++i) pa[i] = ra((i * 4 + w) * 8 + (lane >> 3)) + kcs;
#pragma unroll
    for (int i = 0; i < NI; ++i) pb[i] = rb((i * 4 + w) * 8 + (lane >> 3)) + kcs;
    auto stage = [&](int buf, int k0) {
#pragma unroll
        for (int i = 0; i < MI; ++i) __builtin_amdgcn_global_load_lds((const unsigned*)(pa[i] + k0), (LAS unsigned*)(lds + buf * 32768 + (i * 4 + w) * 1024), 16, 0, 0);
#pragma unroll
        for (int i = 0; i < NI; ++i) __builtin_amdgcn_global_load_lds((const unsigned*)(pb[i] + k0), (LAS unsigned*)(lds + buf * 32768 + 16384 + (i * 4 + w) * 1024), 16, 0, 0);
    };
    const int aoff = (wm * MI * 16 + lr) * 128 + ((lq ^ (lr & 7)) << 4), boff = 16384 + (wn * NI * 16 + lr) * 128 + ((lq ^ (lr & 7)) << 4);
    const int nk = K >> 6;
    __syncthreads();
    stage(0, 0);
    for (int kt = 0; kt < nk; ++kt) {
        asm volatile("s_waitcnt vmcnt(0)" ::: "memory");
        __syncthreads();
        if (kt + 1 < nk) stage((kt + 1) & 1, (kt + 1) * 64);
        hook(kt, acc);
        const LAS unsigned char* bs = lds + (kt & 1) * 32768;
#pragma unroll
        for (int ks = 0; ks < 2; ++ks) {
            bf16x8 xa[MI], wb[NI];
#pragma unroll
            for (int i = 0; i < MI; ++i) xa[i] = *(const LAS bf16x8*)(bs + (aoff ^ (ks << 6)) + i * 2048);
#pragma unroll
            for (int i = 0; i < NI; ++i) wb[i] = *(const LAS bf16x8*)(bs + (boff ^ (ks << 6)) + i * 2048);
#pragma unroll
            for (int mi = 0; mi < MI; ++mi)
#pragma unroll
                for (int ni = 0; ni < NI; ++ni) acc[mi][ni] = __builtin_amdgcn_mfma_f32_16x16x32_bf16(wb[ni], xa[mi], acc[mi][ni], 0, 0, 0);
        }
    }
    epi(acc, wm, wn, lr, lq);
}

template <int MI, int NI, class RowA, class RowB, class Epi>
__device__ __forceinline__ void gemm_tile32(const RowA& ra, const RowB& rb, int K, bf16_t* smem, const Epi& epi) {
    LAS unsigned char* lds = (LAS unsigned char*)smem;
    const int tid = otid(), lane = tid & 63, w = __builtin_amdgcn_readfirstlane(tid >> 6), wm = w >> 1, wn = w & 1, lr = lane & 15, lq = lane >> 4;
    constexpr int ABYTES = MI * 32 * 64, STG = (MI + NI) * 32 * 64, PA = MI / 2, PB = NI / 2;
    f32x4 acc[MI][NI];
#pragma unroll
    for (int i = 0; i < MI; ++i)
#pragma unroll
        for (int j = 0; j < NI; ++j) acc[i][j] = (f32x4){0.f, 0.f, 0.f, 0.f};
    const bf16_t* pa[PA]; const bf16_t* pb[PB];
    const int kcs = ((lane & 3) ^ ((4 - ((lane >> 4) & 3)) & 3)) * 8;
#pragma unroll
    for (int i = 0; i < PA; ++i) pa[i] = ra((i * 4 + w) * 16 + (lane >> 2)) + kcs;
#pragma unroll
    for (int i = 0; i < PB; ++i) pb[i] = rb((i * 4 + w) * 16 + (lane >> 2)) + kcs;
    auto stage = [&](int buf, int k0) {
#pragma unroll
        for (int i = 0; i < PA; ++i) __builtin_amdgcn_global_load_lds((const unsigned*)(pa[i] + k0), (LAS unsigned*)(lds + buf * STG + (i * 4 + w) * 1024), 16, 0, 0);
#pragma unroll
        for (int i = 0; i < PB; ++i) __builtin_amdgcn_global_load_lds((const unsigned*)(pb[i] + k0), (LAS unsigned*)(lds + buf * STG + ABYTES + (i * 4 + w) * 1024), 16, 0, 0);
    };
    const int fsw = (lq ^ ((4 - ((lr >> 2) & 3)) & 3)) << 4;
    const int aoff = (wm * MI * 16 + lr) * 64 + fsw, boff = ABYTES + (wn * NI * 16 + lr) * 64 + fsw;
    const int nk = K >> 5;
    __syncthreads();
    stage(0, 0);
    for (int kt = 0; kt < nk; ++kt) {
        asm volatile("s_waitcnt vmcnt(0)" ::: "memory");
        __syncthreads();
        if (kt + 1 < nk) stage((kt + 1) & 1, (kt + 1) * 32);
        const LAS unsigned char* bs = lds + (kt & 1) * STG;
        bf16x8 xa[MI], wb[NI];
#pragma unroll
        for (int i = 0; i < MI; ++i) xa[i] = *(const LAS bf16x8*)(bs + aoff + i * 1024);
#pragma unroll
        for (int i = 0; i < NI; ++i) wb[i] = *(const LAS bf16x8*)(bs + boff + i * 1024);
#pragma unroll
        for (int mi = 0; mi < MI; ++mi)
#pragma unroll
            for (int ni = 0; ni < NI; ++ni) acc[mi][ni] = __builtin_amdgcn_mfma_f32_16x16x32_bf16(wb[ni], xa[mi], acc[mi][ni], 0, 0, 0);
    }
    epi(acc, wm, wn, lr, lq);
}

struct RowLin { const bf16_t* base; long ld; __device__ __forceinline__ const bf16_t* operator()(int r) const { return base + (long)r * ld; } };

__device__ __forceinline__ void b_inproj(const P& p, int l, int vb, bf16_t* smem) {
    const int mt = vb / (PCW / 128), nt = vb % (PCW / 128);
    RowLin ra{p.H + (long)mt * 128 * D, D}, rb{p.WT_IN + ((long)l * PCW + nt * 128) * D, D};
    unit_wait_nf(sync_ctr(p, l, SY_N1, mt), 8u);
    if (nt == 20) {
        auto epi_dt = [&](const f32x4 (&acc)[4][1], int wm, int wn, int lr, int lq) {
            if (wn == 0) {
#pragma unroll
                for (int mi = 0; mi < 4; ++mi) *(f32x4*)(p.DT + (long)(mt * 128 + wm * 64 + mi * 16 + lr) * 16 + lq * 4) = acc[mi][0];
            }
        };
        gemm_tile<4, 1>(ra, rb, D, smem, epi_dt);
        return;
    }
    const bool latent = mt < NLAT / 128;
    const int kind = (nt == 20) ? 3 : (nt == 3 || nt == 18 || nt == 19) ? 2 : (latent && nt <= 2) ? 0 : (latent && nt >= 14 && nt <= 17) ? 1 : 4;
    constexpr int OS = 136;
    auto epi = [&](f32x4 (&acc)[4][4], int wm, int wn, int lr, int lq) {
        if (kind == 3) {
            if (wn == 0) {
#pragma unroll
                for (int mi = 0; mi < 4; ++mi) *(f32x4*)(p.DT + (long)(mt * 128 + wm * 64 + mi * 16 + lr) * 16 + lq * 4) = acc[mi][0];
            }
            return;
        }
        if (nt == 2 || nt == 16 || nt == 17) {
            const int b = latent ? mt / (L / 128) : (mt - NLAT / 128) / (LC / 128);
#pragma unroll
            for (int half = 0; half < 2; ++half) {
                float mxv = 0.f;
#pragma unroll
                for (int mi = 0; mi < 4; ++mi) {
                    float ssq = 0.f;
#pragma unroll
                    for (int n2 = 0; n2 < 2; ++n2)
#pragma unroll
                        for (int e = 0; e < 4; ++e) { const float v = acc[mi][2 * half + n2][e]; ssq += v * v; }
                    ssq += __shfl_xor(ssq, 16); ssq += __shfl_xor(ssq, 32);
                    mxv = fmaxf(mxv, ssq);
                }
                if (nt == 2) {
                    const float other = mxv;
                    (void)other;
                }
                if (nt != 2) {
#pragma unroll
                    for (int o = 1; o < 16; o <<= 1) mxv = fmaxf(mxv, __shfl_xor(mxv, o));
                    if ((otid() & 63) == 0) atomicMax(&p.KMAX[(l * NB + b) * 10 + (nt - 16) * 4 + wn * 2 + half], __float_as_uint(mxv));
                }
            }
            if (nt == 2) {
                float mxv = 0.f;
#pragma unroll
                for (int mi = 0; mi < 4; ++mi) {
                    float ssq = 0.f;
#pragma unroll
                    for (int ni = 0; ni < 4; ++ni)
#pragma unroll
                        for (int e = 0; e < 4; ++e) { const float v = acc[mi][ni][e]; ssq += v * v; }
                    ssq += __shfl_xor(ssq, 16); ssq += __shfl_xor(ssq, 32);
                    mxv = fmaxf(mxv, ssq);
                }
#pragma unroll
                for (int o = 1; o < 16; o <<= 1) mxv = fmaxf(mxv, __shfl_xor(mxv, o));
                if ((otid() & 63) == 0) atomicMax(&p.KMAX[(l * NB + b) * 10 + 8 + wn], __float_as_uint(mxv));
            }
        }
        if (kind == 0) {
#pragma unroll
            for (int mi = 0; mi < 4; ++mi) {
                const int i = (mt * 128 + wm * 64 + mi * 16 + lr) & (L - 1);
#pragma unroll
                for (int hf = 0; hf < 2; ++hf) {
                    const int pos = hf ? (i & 63) : (i >> 6);
                    const float* tb = p.ROPE + (pos * 24 + lq * 4) * 2;
                    const f32x4 t0 = *(const f32x4*)tb, t1 = *(const f32x4*)(tb + 4);
                    const float cs[4] = {t0[0], t0[2], t1[0], t1[2]}, sn[4] = {t0[1], t0[3], t1[1], t1[3]};
#pragma unroll
                    for (int e = 0; e < 4; ++e) {
                        const float u1 = acc[mi][2 * hf][e], u2 = acc[mi][2 * hf + 1][e];
                        acc[mi][2 * hf][e] = u1 * cs[e] - u2 * sn[e]; acc[mi][2 * hf + 1][e] = u1 * sn[e] + u2 * cs[e];
                    }
                }
            }
        } else if (kind == 1) {
#pragma unroll
            for (int mi = 0; mi < 4; ++mi) {
                const int i = (mt * 128 + wm * 64 + mi * 16 + lr) & (L - 1);
#pragma unroll
                for (int hf = 0; hf < 2; ++hf) {
                    const int pos = hf ? (i & 63) : (i >> 6);
                    const float* tb = p.ROPE + (pos * 24 + 16 + (lq & 1) * 4) * 2;
                    const f32x4 t0 = *(const f32x4*)tb, t1 = *(const f32x4*)(tb + 4);
                    const float cs[4] = {t0[0], t0[2], t1[0], t1[2]}, sn[4] = {t0[1], t0[3], t1[1], t1[3]};
#pragma unroll
                    for (int n2 = 0; n2 < 2; ++n2) {
                        const int ni = 2 * n2 + hf;
#pragma unroll
                        for (int e = 0; e < 4; ++e) {
                            const float v = acc[mi][ni][e], pv = __shfl_xor(v, 32);
                            acc[mi][ni][e] = lq < 2 ? v * cs[e] - pv * sn[e] : pv * sn[e] + v * cs[e];
                        }
                    }
                }
            }
        }
        __syncthreads();
        if (kind == 2) {
#pragma unroll
            for (int mi = 0; mi < 4; ++mi) {
                const int m = wm * 64 + mi * 16 + lr, mp = (m & ~12) | ((m & 4) << 1) | ((m & 8) >> 1);
#pragma unroll
                for (int ni = 0; ni < 4; ++ni)
#pragma unroll
                    for (int e = 0; e < 4; ++e) smem[(wn * 64 + ni * 16 + lq * 4 + e) * OS + mp] = f2bf(acc[mi][ni][e]);
            }
        } else {
#pragma unroll
            for (int mi = 0; mi < 4; ++mi)
#pragma unroll
                for (int ni = 0; ni < 4; ++ni) {
                    const f32x4 a = acc[mi][ni];
                    uint2 o; o.x = pack_bf16(a[0], a[1]); o.y = pack_bf16(a[2], a[3]);
                    *(uint2*)(smem + (wm * 64 + mi * 16 + lr) * OS + wn * 64 + ni * 16 + lq * 4) = o;
                }
        }
        __syncthreads();
        const int tid = otid();
        if (kind == 2) {
            const int nh = nt == 3 ? 2 : 4, hbase = nt == 3 ? 0 : (nt - 18) * 2;
            bf16_t* vtb = nt == 3 ? p.VTA : p.VT;
            const int b = latent ? mt / (L / 128) : (mt - NLAT / 128) / (LC / 128);
            const int key0 = latent ? (mt % (L / 128)) * 128 : L + ((mt - NLAT / 128) % (LC / 128)) * 128;
#pragma unroll
            for (int i2 = 0; i2 < 8; ++i2) {
                const int idx = tid + i2 * 256, n = idx >> 4, mc = (idx & 15) * 8;
                const u32x4 v = *(const u32x4*)(smem + n * OS + mc);
                *(u32x4*)(vtb + ((long)(b * nh + hbase + (n >> 6)) * 64 + (n & 63)) * NKEY + key0 + mc) = v;
            }
        } else {
            bf16_t* out = p.PROJ + (long)mt * 128 * PC + nt * 128;
#pragma unroll
            for (int i2 = 0; i2 < 8; ++i2) {
                const int idx = tid + i2 * 256, m = idx >> 4, nc = (idx & 15) * 8;
                *(u32x4*)(out + (long)m * PC + nc) = *(const u32x4*)(smem + m * OS + nc);
            }
        }
    };
    gemm_tile(ra, rb, D, smem, epi);
}

template <int MI, int NI>
__device__ __forceinline__ void b_outproj(const P& p, int l, int row0, int col0, bf16_t* smem) {
    RowLin ra{p.MIXO + (long)row0 * D, D}, rb{p.WT_OUT + ((long)l * D + col0) * D, D};
    auto epi = [&](const f32x4 (&acc)[MI][NI], int wm, int wn, int lr, int lq) {
#pragma unroll
        for (int mi = 0; mi < MI; ++mi) {
            const int tok = row0 + wm * MI * 16 + mi * 16 + lr;
            const float* g1 = p.MOD + ((long)l * 5 + tok_modrow(tok)) * 6 * D + 2 * D;
#pragma unroll
            for (int ni = 0; ni < NI; ++ni) {
                const int n = col0 + wn * NI * 16 + ni * 16 + lq * 4;
                const float4 g = *(const float4*)(g1 + n);
                float4* xp = (float4*)(p.X + (long)tok * D + n);
                float4 xv = *xp; const f32x4 a = acc[mi][ni];
                xv.x += g.x * a[0]; xv.y += g.y * a[1]; xv.z += g.z * a[2]; xv.w += g.w * a[3];
                *xp = xv;
            }
        }
    };
    float rs0[MI], rs1[MI];
    {
        const int lane = otid() & 63, w = otid() >> 6, wm0 = w >> 1, lr0 = lane & 15;
#pragma unroll
        for (int mi = 0; mi < MI; ++mi) {
            const float* sq = p.SSQ + (long)(row0 + wm0 * MI * 16 + mi * 16 + lr0) * 8;
            const f32x4 s0 = *(const f32x4*)sq, s1 = *(const f32x4*)(sq + 4);
            rs0[mi] = rsqrtf(((s0[0] + s0[1]) + (s0[2] + s0[3])) * (1.f / 256.f) + EPS); rs1[mi] = rsqrtf(((s1[0] + s1[1]) + (s1[2] + s1[3])) * (1.f / 256.f) + EPS);
        }
    }
    auto hook = [&](int kt, f32x4 (&acc)[MI][NI]) {
        if (kt == 4 || kt == 8 || kt == 12) {
#pragma unroll
            for (int mi = 0; mi < MI; ++mi) {
                const float f = kt == 4 ? 1.f / rs0[mi] : kt == 8 ? rs0[mi] / rs1[mi] : rs1[mi];
#pragma unroll
                for (int ni = 0; ni < NI; ++ni) acc[mi][ni] *= f;
            }
        }
    };
    gemm_tile<MI, NI>(ra, rb, D, smem, epi, hook);
}


__device__ __forceinline__ void b_attnC(const P& p, int l, int unit, bf16_t* smem) {
    const int tid = otid(), lane = tid & 63, w = tid >> 6, c = lane & 31, h = lane >> 5;
    const bool ctxq = unit >= NB * 4 * (L / 128);
    int b, hh, qb;
    if (!ctxq) { qb = unit & 31; hh = (unit >> 5) & 3; b = unit >> 7; }
    else { const int u = unit - NB * 4 * (L / 128); qb = u & 1; hh = (u >> 1) & 3; b = u >> 3; }
    const int tokq = (ctxq ? NLAT + b * LC : b * L) + qb * 128 + w * 32 + c;
    const int t0 = ctxq ? 64 : 0, nt = ctxq ? 4 : NKT;
    const float lambda_init = 0.8f - 0.6f * expf(-0.3f * (float)l);
    const float* cl = p.c_lambda + l * 128;
    const float d1 = wave_sum(h == 0 ? cl[c] * cl[32 + c] : 0.f), d2 = wave_sum(h == 0 ? cl[64 + c] * cl[96 + c] : 0.f);
    const float lam = expf(d1) - expf(d2) + lambda_init;
    bf16x8 qf[2][2];
    {
        const float qs = 0.17677669529663687f * 1.4426950408889634f;
        const bf16_t* qp = p.PROJ + (long)tokq * PC + P_CQ + hh * 64;
#pragma unroll
        for (int m = 0; m < 2; ++m)
#pragma unroll
            for (int s2 = 0; s2 < 2; ++s2) {
                const u32x4 raw = *(const u32x4*)(qp + m * 32 + s2 * 16 + h * 8);
                u32x4 sc;
#pragma unroll
                for (int e = 0; e < 4; ++e) sc[e] = pack_bf16(bf2f((bf16_t)(raw[e] & 0xffff)) * qs, bf2f((bf16_t)(raw[e] >> 16)) * qs);
                qf[m][s2] = __builtin_bit_cast(bf16x8, sc);
            }
    }
    LAS unsigned char* lds = (LAS unsigned char*)smem;
    const bf16_t* vtb = p.VT + (long)(b * 4 + hh) * 64 * NKEY;
    const int wu = __builtin_amdgcn_readfirstlane(w);
    int srow[2], schk[2];
#pragma unroll
    for (int i = 0; i < 2; ++i) { srow[i] = (wu * 2 + i) * 8 + (lane >> 3); schk[i] = ((lane & 7) ^ ((srow[i] >> 1) & 7)) * 8; }
    auto dma = [&](int buf, int t) {
        const int tok0 = t < 64 ? b * L + t * 64 : NLAT + b * LC + (t - 64) * 64;
#pragma unroll
        for (int i = 0; i < 2; ++i) {
            __builtin_amdgcn_global_load_lds((const unsigned*)(p.PROJ + (long)(tok0 + srow[i]) * PC + P_CK + hh * 64 + schk[i]), (LAS unsigned*)(lds + buf * 16384 + (wu * 2 + i) * 1024), 16, 0, 0);
            __builtin_amdgcn_global_load_lds((const unsigned*)(vtb + (long)srow[i] * NKEY + t * 64 + schk[i]), (LAS unsigned*)(lds + buf * 16384 + 8192 + (wu * 2 + i) * 1024), 16, 0, 0);
        }
    };
    f32x16 o[2][2];
#pragma unroll
    for (int m = 0; m < 2; ++m)
#pragma unroll
        for (int dt = 0; dt < 2; ++dt)
#pragma unroll
            for (int e = 0; e < 16; ++e) o[m][dt][e] = 0.f;
    float negm[2];
    float lsum[2] = {0.f, 0.f};
#pragma unroll
    for (int m = 0; m < 2; ++m) {
        float qn = 0.f;
#pragma unroll
        for (int s2 = 0; s2 < 2; ++s2) { const u32x4 qq = __builtin_bit_cast(u32x4, qf[m][s2]);
#pragma unroll
            for (int e = 0; e < 4; ++e) { const float a = bf2f((bf16_t)(qq[e] & 0xffff)), bq = bf2f((bf16_t)(qq[e] >> 16)); qn += a * a + bq * bq; } }
        qn += __shfl_xor(qn, 32);
        const float km = __uint_as_float(p.KMAX[(l * NB + b) * 10 + hh * 2 + m]);
        negm[m] = -sqrtf(qn * km);
    }
    f32x16 negv;
    { const float nm = fminf(negm[0], negm[1]);
#pragma unroll
      for (int e = 0; e < 16; ++e) negv[e] = nm; }
    const int swz = (c >> 1) & 7;
    const int krow = c * 128, fo0 = ((0 + h) ^ swz) << 4, fo1 = ((2 + h) ^ swz) << 4, fo2 = ((4 + h) ^ swz) << 4, fo3 = ((6 + h) ^ swz) << 4;
    __syncthreads();
    dma(0, t0);
    for (int it = 0; it < nt; ++it) {
        asm volatile("s_waitcnt vmcnt(0)" ::: "memory");
        __syncthreads();
        if (it + 1 < nt) dma((it + 1) & 1, t0 + it + 1);
        const LAS unsigned char* Ks = lds + (it & 1) * 16384; const LAS unsigned char* Vs = Ks + 8192;
        auto qk = [&](int sub, int m) -> f32x16 {
            const LAS unsigned char* kr = Ks + sub * 4096 + krow;
            const bf16x8 k0 = *(const LAS bf16x8*)(kr + (m ? fo2 : fo0)), k1 = *(const LAS bf16x8*)(kr + (m ? fo3 : fo1));
            const f32x16 sa = __builtin_amdgcn_mfma_f32_32x32x16_bf16(k0, qf[m][0], negv, 0, 0, 0);
            return __builtin_amdgcn_mfma_f32_32x32x16_bf16(k1, qf[m][1], sa, 0, 0, 0);
        };
        f32x16 sa = qk(0, 0);
        bf16x8 vf[2][2];
#pragma unroll
        for (int j = 0; j < 4; ++j) {
            const int sub = j >> 1, m = j & 1;
            if (m == 0) {
#pragma unroll
                for (int dt = 0; dt < 2; ++dt) {
                    const LAS unsigned char* vr = Vs + dt * 4096 + krow;
                    vf[dt][0] = *(const LAS bf16x8*)(vr + (sub ? fo2 : fo0)); vf[dt][1] = *(const LAS bf16x8*)(vr + (sub ? fo3 : fo1));
                }
            }
            f32x16 san;
            if (j < 3) san = qk((j + 1) >> 1, (j + 1) & 1);
            float ps = 0.f;
            u32x4 a0, a1;
#pragma unroll
            for (int e = 0; e < 4; ++e) {
                const float p0 = __builtin_amdgcn_exp2f(sa[2 * e]), p1 = __builtin_amdgcn_exp2f(sa[2 * e + 1]);
                const float p2 = __builtin_amdgcn_exp2f(sa[8 + 2 * e]), p3 = __builtin_amdgcn_exp2f(sa[8 + 2 * e + 1]);
                ps = (((ps + p0) + p1) + p2) + p3;
                a0[e] = pack_bf16(p0, p1); a1[e] = pack_bf16(p2, p3);
            }
            lsum[m] += ps; asm volatile("" : "+v"(lsum[m]));
            const bf16x8 pk0 = __builtin_bit_cast(bf16x8, a0), pk1 = __builtin_bit_cast(bf16x8, a1);
#pragma unroll
            for (int dt = 0; dt < 2; ++dt) {
                o[m][dt] = __builtin_amdgcn_mfma_f32_32x32x16_bf16(vf[dt][0], pk0, o[m][dt], 0, 0, 0);
                o[m][dt] = __builtin_amdgcn_mfma_f32_32x32x16_bf16(vf[dt][1], pk1, o[m][dt], 0, 0, 0);
            }
            if (j < 3) sa = san;
            __builtin_amdgcn_sched_barrier(0);
        }
    }
    __syncthreads();
    const float l0 = lsum[0] + __shfl_xor(lsum[0], 32), l1 = lsum[1] + __shfl_xor(lsum[1], 32);
    const float c0 = 1.f / l0, c1 = -lam / l1;
    float ss = 0.f;
#pragma unroll
    for (int dt = 0; dt < 2; ++dt)
#pragma unroll
        for (int e = 0; e < 16; ++e) { const float v = o[0][dt][e] * c0 + o[1][dt][e] * c1; o[0][dt][e] = v; ss += v * v; }
    ss += __shfl_xor(ss, 32);
    const float r = rsqrtf(ss * (1.f / 64.f) + EPS) * (1.f - lambda_init);
    bf16_t* op = p.MIXO + (long)tokq * D + 768 + hh * 64;
    int lw = l * 64; asm volatile("" : "+v"(lw));
#pragma unroll
    for (int dt = 0; dt < 2; ++dt)
#pragma unroll
        for (int g = 0; g < 4; ++g) {
            const int dv = dt * 32 + 8 * g + 4 * h;
            const float4 wv = *(const float4*)(p.c_subln_w + lw + dv);
            uint2 ov; ov.x = pack_bf16(o[0][dt][4 * g + 0] * r * wv.x, o[0][dt][4 * g + 1] * r * wv.y);
            ov.y = pack_bf16(o[0][dt][4 * g + 2] * r * wv.z, o[0][dt][4 * g + 3] * r * wv.w);
            *(uint2*)(op + dv) = ov;
        }
}


__device__ __forceinline__ void b_attnA(const P& p, int l, int unit, bf16_t* smem) {
    const int tid = otid(), lane = tid & 63, w = tid >> 6, c = lane & 31, h = lane >> 5;
    const bool ctxq = unit >= NB * 4 * (L / 128);
    int b, hd, qb;
    if (!ctxq) { qb = unit & 31; hd = (unit >> 5) & 3; b = unit >> 7; }
    else { const int u = unit - NB * 4 * (L / 128); qb = u & 1; hd = (u >> 1) & 3; b = u >> 3; }
    const int kvh = hd >> 1;
    const int q0 = qb * 128 + w * 32, iq = q0 + c;
    const int tokq = (ctxq ? NLAT + b * LC : b * L) + iq;
    const int tl0 = ctxq ? 0 : max(0, 2 * qb - 2), tl1 = ctxq ? -1 : min(63, 2 * qb + 3), nloc = tl1 - tl0 + 1, nt = nloc + 4;
    bf16x8 qf[4];
    {
        const float qs = 0.125f * 1.4426950408889634f;
        const bf16_t* qp = p.PROJ + (long)tokq * PC + P_AQ + hd * 64;
#pragma unroll
        for (int s2 = 0; s2 < 4; ++s2) {
            const u32x4 raw = *(const u32x4*)(qp + s2 * 16 + h * 8);
            u32x4 sc;
#pragma unroll
            for (int e = 0; e < 4; ++e) sc[e] = pack_bf16(bf2f((bf16_t)(raw[e] & 0xffff)) * qs, bf2f((bf16_t)(raw[e] >> 16)) * qs);
            qf[s2] = __builtin_bit_cast(bf16x8, sc);
        }
    }
    const bf16_t* vtb = p.VTA + (long)(b * 2 + kvh) * 64 * NKEY;
    const int srow0 = tid >> 3, sch = (tid & 7) * 8;
    u32x4 rk[2], rv[2];
    auto tile_of = [&](int it) { return it < nloc ? tl0 + it : 64 + (it - nloc); };
    auto gload = [&](int t) {
        const int tok0 = t < 64 ? b * L + t * 64 : NLAT + b * LC + (t - 64) * 64;
#pragma unroll
        for (int i = 0; i < 2; ++i) {
            rk[i] = *(const u32x4*)(p.PROJ + (long)(tok0 + srow0 + i * 32) * PC + P_AK + kvh * 64 + sch);
            rv[i] = *(const u32x4*)(vtb + (long)(srow0 + i * 32) * NKEY + t * 64 + sch);
        }
    };
    auto lstore = [&](int buf) {
        bf16_t* Ks = smem + buf * (2 * 64 * 72); bf16_t* Vs = Ks + 64 * 72;
#pragma unroll
        for (int i = 0; i < 2; ++i) { *(u32x4*)(Ks + (srow0 + i * 32) * 72 + sch) = rk[i]; *(u32x4*)(Vs + (srow0 + i * 32) * 72 + sch) = rv[i]; }
    };
    f32x16 o[2];
#pragma unroll
    for (int dt = 0; dt < 2; ++dt)
#pragma unroll
        for (int e = 0; e < 16; ++e) o[dt][e] = 0.f;
    f32x16 negm; float lsum;
    {
        float qn = 0.f;
#pragma unroll
        for (int s2 = 0; s2 < 4; ++s2) { const u32x4 qq = __builtin_bit_cast(u32x4, qf[s2]);
#pragma unroll
            for (int e = 0; e < 4; ++e) { const float a = bf2f((bf16_t)(qq[e] & 0xffff)), bq = bf2f((bf16_t)(qq[e] >> 16)); qn += a * a + bq * bq; } }
        qn += __shfl_xor(qn, 32);
        const float km = __uint_as_float(p.KMAX[(l * NB + b) * 10 + 8 + kvh]);
        const float sk = p.a_sink[l * 4 + hd] * 1.4426950408889634f;
        const float mb = fmaxf(sqrtf(qn * km), sk);
#pragma unroll
        for (int e = 0; e < 16; ++e) negm[e] = -mb;
        lsum = h == 0 ? __builtin_amdgcn_exp2f(sk - mb) : 0.f;
    }
    __syncthreads();
    gload(tile_of(0)); lstore(0);
    __syncthreads();
    for (int it = 0; it < nt; ++it) {
        if (it + 1 < nt) gload(tile_of(it + 1));
        const int t = tile_of(it);
        const bool local = t < 64;
        const bf16_t* Ks = smem + (it & 1) * (2 * 64 * 72); const bf16_t* Vs = Ks + 64 * 72;
#pragma unroll
        for (int sub = 0; sub < 2; ++sub) {
            const int j0 = t * 64 + sub * 32;
            if (local && (j0 + 31 < q0 - 128 || j0 > q0 + 31 + 128)) continue;
            f32x16 sa = negm;
#pragma unroll
            for (int s2 = 0; s2 < 4; ++s2) {
                const bf16x8 kf = *(const bf16x8*)(Ks + (sub * 32 + c) * 72 + s2 * 16 + h * 8);
                sa = __builtin_amdgcn_mfma_f32_32x32x16_bf16(kf, qf[s2], sa, 0, 0, 0);
            }
            if (local) {
#pragma unroll
                for (int e = 0; e < 16; ++e) { const int j = j0 + 8 * (e >> 2) + 4 * h + (e & 3); const int dj = j - iq; if (dj > 128 || dj < -128) sa[e] = -INFINITY; }
            }
            float ps = 0.f;
            u32x4 a0, a1;
#pragma unroll
            for (int e = 0; e < 4; ++e) {
                const float p0 = __builtin_amdgcn_exp2f(sa[2 * e]), p1 = __builtin_amdgcn_exp2f(sa[2 * e + 1]);
                const float p2 = __builtin_amdgcn_exp2f(sa[8 + 2 * e]), p3 = __builtin_amdgcn_exp2f(sa[8 + 2 * e + 1]);
                ps += (p0 + p1) + (p2 + p3);
                a0[e] = pack_bf16(p0, p1); a1[e] = pack_bf16(p2, p3);
            }
            lsum += ps;
            const bf16x8 pk0 = __builtin_bit_cast(bf16x8, a0), pk1 = __builtin_bit_cast(bf16x8, a1);
#pragma unroll
            for (int dt = 0; dt < 2; ++dt) {
                const bf16x8 v0 = *(const bf16x8*)(Vs + (dt * 32 + c) * 72 + sub * 32 + h * 8);
                const bf16x8 v1 = *(const bf16x8*)(Vs + (dt * 32 + c) * 72 + sub * 32 + 16 + h * 8);
                o[dt] = __builtin_amdgcn_mfma_f32_32x32x16_bf16(v0, pk0, o[dt], 0, 0, 0);
                o[dt] = __builtin_amdgcn_mfma_f32_32x32x16_bf16(v1, pk1, o[dt], 0, 0, 0);
            }
        }
        if (it + 1 < nt) lstore((it + 1) & 1);
        __syncthreads();
    }
    const float inv = 1.f / (lsum + __shfl_xor(lsum, 32));
    bf16_t* op = p.MIXO + (long)tokq * D + hd * 64;
#pragma unroll
    for (int dt = 0; dt < 2; ++dt)
#pragma unroll
        for (int g = 0; g < 4; ++g) {
            uint2 ov; ov.x = pack_bf16(o[dt][4 * g + 0] * inv, o[dt][4 * g + 1] * inv); ov.y = pack_bf16(o[dt][4 * g + 2] * inv, o[dt][4 * g + 3] * inv);
            *(uint2*)(op + dt * 32 + 8 * g + 4 * h) = ov;
        }
}

constexpr int NCH = 34;
constexpr int XT_STRIDE = 136;
__device__ __forceinline__ int chunk_tok0(int b, int cc) { return cc < 2 ? NLAT + b * LC + cc * 128 : b * L + (cc - 2) * 128; }
__device__ __forceinline__ float softplusf(float v) { return fmaxf(v, 0.f) + log1pf(expf(-fabsf(v))); }

__device__ __forceinline__ void ssd_dt_cum(const P& p, int l, int tok0, int head, float* cumv, float* dtv) {
    const int lane = otid() & 63, w = otid() >> 6;
    if (w < 2) {
        const int dir = w;
        const float a = -expf(p.a_log[(l * 2 + dir) * 8 + head]), dtb = p.dt_bias[(l * 2 + dir) * 8 + head];
        const int k0 = 2 * lane, k1 = 2 * lane + 1, i0 = dir ? 127 - k0 : k0, i1 = dir ? 127 - k1 : k1;
        const float dt0 = softplusf(p.DT[(long)(tok0 + i0) * 16 + dir * 8 + head] + dtb), dt1 = softplusf(p.DT[(long)(tok0 + i1) * 16 + dir * 8 + head] + dtb);
        const float la0 = dt0 * a, la1 = dt1 * a;
        float sc = la0 + la1;
#pragma unroll
        for (int off = 1; off < 64; off <<= 1) { const float t = __shfl_up(sc, off); if (lane >= off) sc += t; }
        const float excl = sc - (la0 + la1);
        cumv[dir * 128 + i0] = excl + la0; cumv[dir * 128 + i1] = excl + la0 + la1;
        dtv[dir * 128 + i0] = dt0; dtv[dir * 128 + i1] = dt1;
    }
}
__device__ __forceinline__ void ssd_conv_load(const P& p, int tok0, int cpos, int len, int col0, u32x4 (&raw)[8]) {
    const int tid = otid(), ch8 = (tid & 7) * 8, t0 = (tid >> 3) * 4;
#pragma unroll
    for (int r = 0; r < 8; ++r) {
        const int tt = t0 - 2 + r, pos = cpos + tt;
        u32x4 v = (u32x4){0u, 0u, 0u, 0u};
        if (pos >= 0 && pos < len) v = *(const u32x4*)(p.PROJ + (long)(tok0 + tt) * PC + P_BX + col0 + ch8);
        raw[r] = v;
    }
}
template <bool TR>
__device__ __forceinline__ void ssd_conv_apply(const P& p, int l, int col0, const u32x4 (&raw)[8], bf16_t* dst) {
    const int tid = otid(), ch8 = (tid & 7) * 8, t0 = (tid >> 3) * 4;
    float xr[8][8];
#pragma unroll
    for (int r = 0; r < 8; ++r)
#pragma unroll
        for (int e = 0; e < 4; ++e) { xr[r][2 * e] = bf2f((bf16_t)(raw[r][e] & 0xffff)); xr[r][2 * e + 1] = bf2f((bf16_t)(raw[r][e] >> 16)); }
    float acc[4][8];
    { const float4 b0 = *(const float4*)(p.conv_b + l * 768 + col0 + ch8), b1 = *(const float4*)(p.conv_b + l * 768 + col0 + ch8 + 4);
#pragma unroll
      for (int i = 0; i < 4; ++i) { acc[i][0] = b0.x; acc[i][1] = b0.y; acc[i][2] = b0.z; acc[i][3] = b0.w; acc[i][4] = b1.x; acc[i][5] = b1.y; acc[i][6] = b1.z; acc[i][7] = b1.w; } }
#pragma unroll
    for (int tap = 0; tap < 5; ++tap) {
        const float4 w0 = *(const float4*)(p.conv_w + (l * 5 + tap) * 768 + col0 + ch8), w1 = *(const float4*)(p.conv_w + (l * 5 + tap) * 768 + col0 + ch8 + 4);
        const float wv[8] = {w0.x, w0.y, w0.z, w0.w, w1.x, w1.y, w1.z, w1.w};
#pragma unroll
        for (int i = 0; i < 4; ++i)
#pragma unroll
            for (int e = 0; e < 8; ++e) acc[i][e] += wv[e] * xr[i + tap][e];
    }
#pragma unroll
    for (int i = 0; i < 4; ++i) {
        if (TR) {
#pragma unroll
            for (int e = 0; e < 8; ++e) dst[(ch8 + e) * XT_STRIDE + t0 + i] = f2bf(siluf(acc[i][e]));
        } else {
            u32x4 o;
#pragma unroll
            for (int e = 0; e < 4; ++e) o[e] = pack_bf16(siluf(acc[i][2 * e]), siluf(acc[i][2 * e + 1]));
            *(u32x4*)(dst + (t0 + i) * 72 + ch8) = o;
        }
    }
}

__device__ __forceinline__ void b_ssd_states(const P& p, int l, int unit, bf16_t* smem) {
    const int head = unit & 7, cc = (unit >> 3) % NCH, b = unit / (8 * NCH), g = head >> 2;
    const int tok0 = chunk_tok0(b, cc);
    const int tid = otid(), lane = tid & 63, w = tid >> 6, c = lane & 31, h = lane >> 5;
    bf16_t* xT = smem; bf16_t* BT = smem + 64 * XT_STRIDE;
    float* cumv = (float*)(smem + 2 * 64 * XT_STRIDE); float* dtv = cumv + 256; float* wdt = dtv + 256;
    __syncthreads();
    const int cpos = cc < 2 ? cc * 128 : (cc - 2) * 128, slen = cc < 2 ? LC : L;
    {
        u32x4 rx[8], rb[8];
        ssd_conv_load(p, tok0, cpos, slen, head * 64, rx);
        ssd_conv_load(p, tok0, cpos, slen, 512 + g * 64, rb);
        ssd_dt_cum(p, l, tok0, head, cumv, dtv);
        ssd_conv_apply<true>(p, l, head * 64, rx, xT);
        ssd_conv_apply<true>(p, l, 512 + g * 64, rb, BT);
    }
    __syncthreads();
    { const int dir = tid >> 7, t = tid & 127; const float ce = cumv[dir * 128 + (dir ? 0 : 127)];
      wdt[tid] = __expf(ce - cumv[tid]) * dtv[tid];
      if (t == 0) wt_store(&p.DEC[((long)(b * NCH + cc) * 8 + head) * 2 + dir], __expf(ce)); }
    __syncthreads();
    const int dir = w >> 1, pt = w & 1;
    f32x16 acc[2];
#pragma unroll
    for (int nt = 0; nt < 2; ++nt)
#pragma unroll
        for (int e = 0; e < 16; ++e) acc[nt][e] = 0.f;
#pragma unroll
    for (int ks = 0; ks < 8; ++ks) {
        const u32x4 xr = *(const u32x4*)(xT + (pt * 32 + c) * XT_STRIDE + ks * 16 + h * 8);
        const f32x4 w0 = *(const f32x4*)(wdt + dir * 128 + ks * 16 + h * 8), w1 = *(const f32x4*)(wdt + dir * 128 + ks * 16 + h * 8 + 4);
        u32x4 xs;
        xs[0] = pack_bf16(bf2f((bf16_t)(xr[0] & 0xffff)) * w0[0], bf2f((bf16_t)(xr[0] >> 16)) * w0[1]);
        xs[1] = pack_bf16(bf2f((bf16_t)(xr[1] & 0xffff)) * w0[2], bf2f((bf16_t)(xr[1] >> 16)) * w0[3]);
        xs[2] = pack_bf16(bf2f((bf16_t)(xr[2] & 0xffff)) * w1[0], bf2f((bf16_t)(xr[2] >> 16)) * w1[1]);
        xs[3] = pack_bf16(bf2f((bf16_t)(xr[3] & 0xffff)) * w1[2], bf2f((bf16_t)(xr[3] >> 16)) * w1[3]);
        const bf16x8 xa = __builtin_bit_cast(bf16x8, xs);
#pragma unroll
        for (int nt = 0; nt < 2; ++nt) {
            const bf16x8 bb = *(const bf16x8*)(BT + (nt * 32 + c) * XT_STRIDE + ks * 16 + h * 8);
            acc[nt] = __builtin_amdgcn_mfma_f32_32x32x16_bf16(xa, bb, acc[nt], 0, 0, 0);
        }
    }
    float* st = p.ST + (((long)(b * NCH + cc) * 8 + head) * 2 + dir) * 4096;
#pragma unroll
    for (int nt = 0; nt < 2; ++nt)
#pragma unroll
        for (int e = 0; e < 16; ++e) { const int pr = pt * 32 + 8 * (e >> 2) + 4 * h + (e & 3); wt_store(&st[pr * 64 + nt * 32 + c], acc[nt][e]); }
    unit_publish(p.SYNC + l * 2 + 0);
}

__device__ __forceinline__ void b_ssd_scan(const P& p, int l, int vb) {
    unit_wait(p.SYNC + l * 2 + 0, (unsigned)(NB * NCH * 8));
    const int idx = vb * 256 + otid();
    const int e = idx & 4095, dir = (idx >> 12) & 1, head = (idx >> 13) & 7, b = idx >> 16;
    float stv[NCH], dcv[NCH];
#pragma unroll
    for (int k = 0; k < NCH; ++k) {
        const int cc = dir ? (k < 2 ? 1 - k : 35 - k) : k;
        const long base = ((long)(b * NCH + cc) * 8 + head) * 2 + dir;
        stv[k] = p.ST[base * 4096 + e]; dcv[k] = p.DEC[base];
    }
    float hst = 0.f;
#pragma unroll
    for (int k = 0; k < NCH; ++k) {
        const int cc = dir ? (k < 2 ? 1 - k : 35 - k) : k;
        const long base = ((long)(b * NCH + cc) * 8 + head) * 2 + dir;
        { const float oth = __shfl_xor(hst, 1); if ((e & 1) == 0) wt_store((unsigned*)(p.HS + base * 4096 + e), pack_bf16(hst, oth)); }
        hst = dcv[k] * hst + stv[k];
    }
    unit_publish(p.SYNC + l * 2 + 1);
}

__device__ __forceinline__ void b_ssd_out(const P& p, int l, int unit, bf16_t* smem) {
    const int head = unit & 7, cc = (unit >> 3) % NCH, b = unit / (8 * NCH), g = head >> 2;
    const int tok0 = chunk_tok0(b, cc);
    const int tid = otid(), lane = tid & 63, w = tid >> 6, c = lane & 31, h = lane >> 5;
    bf16_t* Cs = smem; bf16_t* Bs = smem + 128 * 72; bf16_t* xT = smem + 2 * 128 * 72;
    float* cumv = (float*)(smem + 2 * 128 * 72 + 64 * XT_STRIDE); float* dtv = cumv + 256;
    __syncthreads();
    const int cpos = cc < 2 ? cc * 128 : (cc - 2) * 128, slen = cc < 2 ? LC : L;
    const int t = 32 * w + c;
    const bf16_t* zp = p.PROJ + (long)(tok0 + t) * PC + P_BZ + head * 64;
    {
        u32x4 rc[8], rb[8], rx[8];
        ssd_conv_load(p, tok0, cpos, slen, 640 + g * 64, rc);
        ssd_conv_load(p, tok0, cpos, slen, 512 + g * 64, rb);
        ssd_dt_cum(p, l, tok0, head, cumv, dtv);
        ssd_conv_apply<false>(p, l, 640 + g * 64, rc, Cs);
        ssd_conv_load(p, tok0, cpos, slen, head * 64, rx);
        ssd_conv_apply<false>(p, l, 512 + g * 64, rb, Bs);
        ssd_conv_apply<true>(p, l, head * 64, rx, xT);
    }
    unit_wait(p.SYNC + l * 2 + 1, (unsigned)(NB * 8 * 2 * 4096 / 256));
    bf16x8 cf[4];
#pragma unroll
    for (int ks = 0; ks < 4; ++ks) cf[ks] = *(const bf16x8*)(Cs + t * 72 + ks * 16 + h * 8);
    f32x16 gT[4];
#pragma unroll
    for (int st = 0; st < 4; ++st) {
#pragma unroll
        for (int e = 0; e < 16; ++e) gT[st][e] = 0.f;
#pragma unroll
        for (int ks = 0; ks < 4; ++ks) {
            const bf16x8 bfr = *(const bf16x8*)(Bs + (st * 32 + c) * 72 + ks * 16 + h * 8);
            gT[st] = __builtin_amdgcn_mfma_f32_32x32x16_bf16(bfr, cf[ks], gT[st], 0, 0, 0);
        }
    }
    f32x16 tot[2];
#pragma unroll
    for (int pt = 0; pt < 2; ++pt)
#pragma unroll
        for (int e = 0; e < 16; ++e) tot[pt][e] = 0.f;
#pragma unroll
    for (int dir = 0; dir < 2; ++dir) {
        const float ct = cumv[dir * 128 + t];
        bf16x8 hsf[4][2];
        {
            const bf16_t* hs = p.HS + (((long)(b * NCH + cc) * 8 + head) * 2 + dir) * 4096;
#pragma unroll
            for (int ks = 0; ks < 4; ++ks)
#pragma unroll
                for (int pt = 0; pt < 2; ++pt) hsf[ks][pt] = *(const bf16x8*)(hs + (pt * 32 + c) * 64 + ks * 16 + h * 8);
        }
#pragma unroll
        for (int st = 0; st < 4; ++st) {
            const bool need = dir ? (st >= w) : (st <= w);
            if (need) {
#pragma unroll
                for (int k2 = 0; k2 < 2; ++k2) {
                    float mv[8];
#pragma unroll
                    for (int j = 0; j < 8; ++j) {
                        const int sidx = st * 32 + 16 * k2 + 8 * (j >> 2) + 4 * h + (j & 3);
                        const float cs = cumv[dir * 128 + sidx], ds = dtv[dir * 128 + sidx];
                        const bool ok = (st != w) || (dir ? (sidx >= t) : (sidx <= t));
                        const float arg = ok ? ct - cs : -__builtin_inff();
                        mv[j] = gT[st][8 * k2 + j] * __expf(arg) * ds;
                    }
                    u32x4 pm; pm[0] = pack_bf16(mv[0], mv[1]); pm[1] = pack_bf16(mv[2], mv[3]); pm[2] = pack_bf16(mv[4], mv[5]); pm[3] = pack_bf16(mv[6], mv[7]);
                    const bf16x8 pmb = __builtin_bit_cast(bf16x8, pm);
#pragma unroll
                    for (int pt = 0; pt < 2; ++pt) {
                        const bf16_t* xr = xT + (pt * 32 + c) * XT_STRIDE + st * 32 + 16 * k2 + 4 * h;
                        const uint2 lo = *(const uint2*)xr, hi = *(const uint2*)(xr + 8);
                        const u32x4 xa = (u32x4){lo.x, lo.y, hi.x, hi.y};
                        tot[pt] = __builtin_amdgcn_mfma_f32_32x32x16_bf16(__builtin_bit_cast(bf16x8, xa), pmb, tot[pt], 0, 0, 0);
                    }
                }
            }
        }
        const float et = __expf(ct);
#pragma unroll
        for (int ks = 0; ks < 4; ++ks) {
            const u32x4 cr = __builtin_bit_cast(u32x4, cf[ks]);
            u32x4 cs4;
#pragma unroll
            for (int e = 0; e < 4; ++e) cs4[e] = pack_bf16(bf2f((bf16_t)(cr[e] & 0xffff)) * et, bf2f((bf16_t)(cr[e] >> 16)) * et);
            const bf16x8 cfs = __builtin_bit_cast(bf16x8, cs4);
#pragma unroll
            for (int pt = 0; pt < 2; ++pt) {
                tot[pt] = __builtin_amdgcn_mfma_f32_32x32x16_bf16(hsf[ks][pt], cfs, tot[pt], 0, 0, 0);
            }
        }
    }
    const float dsk = p.d_skip[(l * 2 + 0) * 8 + head] + p.d_skip[(l * 2 + 1) * 8 + head];
    bf16_t* gp = p.MIXO + (long)(tok0 + t) * D + 256 + head * 64;
    uint2 zr[2][4];
#pragma unroll
    for (int pt = 0; pt < 2; ++pt)
#pragma unroll
        for (int gq = 0; gq < 4; ++gq) zr[pt][gq] = *(const uint2*)(zp + pt * 32 + 8 * gq + 4 * h);
    float ss = 0.f;
#pragma unroll
    for (int pt = 0; pt < 2; ++pt)
#pragma unroll
        for (int gq = 0; gq < 4; ++gq) {
            const int p0 = pt * 32 + 8 * gq + 4 * h;
            const uint2 zq = zr[pt][gq];
            const float zv[4] = {bf2f((bf16_t)(zq.x & 0xffff)), bf2f((bf16_t)(zq.x >> 16)), bf2f((bf16_t)(zq.y & 0xffff)), bf2f((bf16_t)(zq.y >> 16))};
            float gv[4];
#pragma unroll
            for (int e = 0; e < 4; ++e) { const float y = tot[pt][4 * gq + e] + bf2f(xT[(p0 + e) * XT_STRIDE + t]) * dsk; gv[e] = y * siluf(zv[e]); ss += gv[e] * gv[e]; }
            uint2 ov; ov.x = pack_bf16(gv[0], gv[1]); ov.y = pack_bf16(gv[2], gv[3]);
            *(uint2*)(gp + p0) = ov;
        }
    ss += __shfl_xor(ss, 32);
    if (h == 0) p.SSQ[(long)(tok0 + t) * 8 + head] = ss;
}

__device__ __forceinline__ void b_norm2r(const P& p, int l, int vb, bf16_t* smem) {
    const int tid = otid(), wave = tid >> 6, lane = tid & 63;
    constexpr int HST = D + 16;
    bf16_t* Hs = smem;
    float* red = (float*)(smem + 16 * HST);
    float* lgs = red + 4 * 16 * 48;
    __syncthreads();
#pragma unroll 1
    for (int i4 = 0; i4 < 4; ++i4) {
        const int tl = wave * 4 + i4, tok = vb * 16 + tl;
        float v[16];
        const float* src = p.X + (long)tok * D;
#pragma unroll
        for (int i = 0; i < 4; ++i) { const float4 t = *(const float4*)(src + i * 256 + lane * 4); v[i * 4 + 0] = t.x; v[i * 4 + 1] = t.y; v[i * 4 + 2] = t.z; v[i * 4 + 3] = t.w; }
        float ss = 0.f;
#pragma unroll
        for (int i = 0; i < 16; ++i) ss += v[i] * v[i];
        ss = wave_sum(ss);
        const float r = rsqrtf(ss * (1.f / D) + EPS);
        const float* m = p.MOD + ((long)l * 5 + tok_modrow(tok)) * 6 * D;
        const float* nw = p.norm2_w + l * D;
        bf16_t* ho = p.H + (long)tok * D;
#pragma unroll
        for (int i = 0; i < 4; ++i) {
            const int k = i * 256 + lane * 4;
            const float4 w4 = *(const float4*)(nw + k), sc = *(const float4*)(m + 4 * D + k), sh = *(const float4*)(m + 3 * D + k);
            uint2 o;
            o.x = pack_bf16(v[i * 4 + 0] * r * w4.x * (1.f + sc.x) + sh.x, v[i * 4 + 1] * r * w4.y * (1.f + sc.y) + sh.y);
            o.y = pack_bf16(v[i * 4 + 2] * r * w4.z * (1.f + sc.z) + sh.z, v[i * 4 + 3] * r * w4.w * (1.f + sc.w) + sh.w);
            *(uint2*)(ho + k) = o;
            *(uint2*)(Hs + tl * HST + k) = o;
        }
    }
    __syncthreads();
    {
        const int lr = lane & 15, lq = lane >> 4;
        const bf16_t* wr = p.WT_R + ((long)l * 128 + lr) * D + wave * 256 + lq * 8;
        const bf16_t* hr = Hs + lr * HST + wave * 256 + lq * 8;
        f32x4 acc[3];
#pragma unroll
        for (int ni = 0; ni < 3; ++ni) acc[ni] = (f32x4){0.f, 0.f, 0.f, 0.f};
#pragma unroll
        for (int half = 0; half < 2; ++half) {
            bf16x8 wb[4][3];
#pragma unroll
            for (int ks = 0; ks < 4; ++ks)
#pragma unroll
                for (int ni = 0; ni < 3; ++ni) wb[ks][ni] = *(const bf16x8*)(wr + (long)ni * 16 * D + (half * 4 + ks) * 32);
#pragma unroll
            for (int ks = 0; ks < 4; ++ks) {
                const bf16x8 xa = *(const bf16x8*)(hr + (half * 4 + ks) * 32);
#pragma unroll
                for (int ni = 0; ni < 3; ++ni) acc[ni] = __builtin_amdgcn_mfma_f32_16x16x32_bf16(wb[ks][ni], xa, acc[ni], 0, 0, 0);
            }
        }
#pragma unroll
        for (int ni = 0; ni < 3; ++ni) *(f32x4*)(red + (wave * 16 + lr) * 48 + ni * 16 + lq * 4) = acc[ni];
    }
    __syncthreads();
#pragma unroll
    for (int i = 0; i < 3; ++i) {
        const int idx = tid + i * 256, t = idx / 48, j = idx % 48;
        lgs[t * 49 + j] = (red[(0 * 16 + t) * 48 + j] + red[(1 * 16 + t) * 48 + j]) + (red[(2 * 16 + t) * 48 + j] + red[(3 * 16 + t) * 48 + j]);
    }
    __syncthreads();
    if (tid < 16) {
        const int tok = vb * 16 + tid;
        const float* lg = lgs + tid * 49;
        int gs = 0; float gm = lg[0];
#pragma unroll
        for (int j = 1; j < 4; ++j) { const float v = lg[j]; if (v > gm) { gm = v; gs = j; } }
        float den = 0.f;
#pragma unroll
        for (int j = 0; j < 4; ++j) den += expf(lg[j] - gm);
        const float gp = 1.f / den;
        float e0 = -3.4e38f, e1 = -3.4e38f; int i0 = 0, i1 = 0;
#pragma unroll
        for (int j = 0; j < 8; ++j) {
            const float val = lg[4 + gs * 8 + j];
            if (val > e0) { e1 = e0; i1 = i0; e0 = val; i0 = j; }
            else if (val > e1) { e1 = val; i1 = j; }
        }
        const float x1 = expf(e1 - e0), w0 = gp / (1.f + x1), w1 = gp * x1 / (1.f + x1);
        const int ex0 = gs * 8 + i0, ex1 = gs * 8 + i1;
        int* cnt = p.cnt + l * NEXP;
        const int rk0 = atomicAdd(&cnt[ex0], 1); p.list[(long)ex0 * NTOK + rk0] = tok * 2 + 0; p.gatew[tok * 2 + 0] = w0;
        const int rk1 = atomicAdd(&cnt[ex1], 1); p.list[(long)ex1 * NTOK + rk1] = tok * 2 + 1; p.gatew[tok * 2 + 1] = w1;
    }
}

struct MoeTile { int e, mt, cnt, off; };
__device__ __forceinline__ int moe_row_tiles(const int* cnt) { int t = 0; for (int e = 0; e < NEXP; ++e) t += (cnt[e] + 127) >> 7; return t; }
__device__ __forceinline__ MoeTile moe_find_tile(const int* cnt, int tile) {
    MoeTile t; t.e = -1; t.mt = 0; t.cnt = 0; t.off = 0;
    int acc_t = 0, off = 0;
    for (int e = 0; e < NEXP; ++e) {
        const int c = cnt[e], nt = (c + 127) >> 7;
        if (t.e < 0 && tile < acc_t + nt) { t.e = e; t.mt = tile - acc_t; t.cnt = c; t.off = off; }
        acc_t += nt; off += c;
    }
    return t;
}
struct RowGather { const bf16_t* base; const int* lst; int n; __device__ __forceinline__ const bf16_t* operator()(int r) const { return base + (long)(lst[r < n ? r : n - 1] >> 1) * D; } };
struct RowLimit { const bf16_t* base; long ld; int n; __device__ __forceinline__ const bf16_t* operator()(int r) const { return base + (long)(r < n ? r : n - 1) * ld; } };
template <int NI> struct RowGateUp { const bf16_t* wg; const bf16_t* wu; __device__ __forceinline__ const bf16_t* operator()(int n) const {
    const int wn = n / (NI * 16), f = (n >> 4) % NI, j = n & 15, col = wn * (NI * 8) + (f % (NI / 2)) * 16 + j; return wg + (long)(f / (NI / 2)) * (wu - wg) + (long)col * D; } };

template <int NI>
__device__ __forceinline__ void b_moe_up(const P& p, int l, int rt, int h0, bf16_t* smem) {
    const MoeTile t = moe_find_tile(p.cnt + l * NEXP, rt);
    if (t.e < 0) return;
    const int nrow = min(128, t.cnt - t.mt * 128);
    RowGather ra{p.H, p.list + (long)t.e * NTOK + t.mt * 128, nrow};
    const long wofs = (((long)l * NEXP + t.e) * DEXP + h0) * D;
    RowGateUp<NI> rb{p.WT_G + wofs, p.WT_U + wofs};
    bf16_t* out = p.HID + (long)(t.off + t.mt * 128) * DEXP + h0;
    auto epi = [&](const f32x4 (&acc)[4][NI], int wm, int wn, int lr, int lq) {
#pragma unroll
        for (int mi = 0; mi < 4; ++mi) {
            const int r = wm * 64 + mi * 16 + lr;
            if (r < nrow) {
#pragma unroll
                for (int f = 0; f < NI / 2; ++f) {
                    const f32x4 gt = acc[mi][f], up = acc[mi][NI / 2 + f];
                    float hv[4];
#pragma unroll
                    for (int e = 0; e < 4; ++e) hv[e] = siluf(gt[e]) * up[e];
                    uint2 o; o.x = pack_bf16(hv[0], hv[1]); o.y = pack_bf16(hv[2], hv[3]);
                    *(uint2*)(out + (long)r * DEXP + wn * (NI * 8) + f * 16 + lq * 4) = o;
                }
            }
        }
    };
    if constexpr (NI == 8) gemm_tile32<4, 8>(ra, rb, D, smem, epi); else gemm_tile<4, NI>(ra, rb, D, smem, epi);
}

template <int NI>
__device__ __forceinline__ void b_moe_down(const P& p, int l, int rt, int n0, bf16_t* smem) {
    const MoeTile t = moe_find_tile(p.cnt + l * NEXP, rt);
    if (t.e < 0) return;
    const int nrow = min(128, t.cnt - t.mt * 128);
    const int slot0 = t.off + t.mt * 128;
    RowLimit ra{p.HID + (long)slot0 * DEXP, DEXP, nrow};
    RowLin rb{p.WT_D + (((long)l * NEXP + t.e) * D + n0) * DEXP, DEXP};
    const int* lst = p.list + (long)t.e * NTOK + t.mt * 128;
    int asg[4]; float gwv[4];
    {
        const int lane = otid() & 63, w = otid() >> 6;
#pragma unroll
        for (int mi = 0; mi < 4; ++mi) { const int r = (w >> 1) * 64 + mi * 16 + (lane & 15); asg[mi] = lst[r < nrow ? r : nrow - 1]; gwv[mi] = p.gatew[asg[mi]]; }
    }
    auto epi = [&](const f32x4 (&acc)[4][NI], int wm, int wn, int lr, int lq) {
#pragma unroll
        for (int mi = 0; mi < 4; ++mi) {
            const int r = wm * 64 + mi * 16 + lr;
            if (r < nrow) {
                const float gw = gwv[mi];
                if (n0 == 0 && wn == 0 && lq == 0) p.pos[asg[mi]] = slot0 + r;
#pragma unroll
                for (int ni = 0; ni < NI; ++ni) {
                    const int n = n0 + wn * (NI * 16) + ni * 16 + lq * 4;
                    const f32x4 a = acc[mi][ni];
                    uint2 o; o.x = pack_bf16(a[0] * gw, a[1] * gw); o.y = pack_bf16(a[2] * gw, a[3] * gw);
                    *(uint2*)(p.YS + (long)(slot0 + r) * D + n) = o;
                }
            }
        }
    };
    if constexpr (NI == 8) gemm_tile32<4, 8>(ra, rb, DEXP, smem, epi); else gemm_tile<4, NI>(ra, rb, DEXP, smem, epi);
}

__device__ __forceinline__ void b_final(const P& p, int vb) {
    const int wave = otid() >> 6, lane = otid() & 63;
    const int tok = vb * 4 + wave;
    if (tok >= NLAT) return;
    float v[16];
    const float* src = p.X + (long)tok * D;
#pragma unroll
    for (int i = 0; i < 4; ++i) { const float4 t = *(const float4*)(src + i * 256 + lane * 4); v[i * 4 + 0] = t.x; v[i * 4 + 1] = t.y; v[i * 4 + 2] = t.z; v[i * 4 + 3] = t.w; }
    {
        const bf16_t* ys0 = p.YS + (long)p.pos[tok * 2 + 0] * D; const bf16_t* ys1 = p.YS + (long)p.pos[tok * 2 + 1] * D;
        const float* g2 = p.MOD + ((long)(DEPTH - 1) * 5 + tok_modrow(tok)) * 6 * D + 5 * D;
#pragma unroll
        for (int i = 0; i < 4; ++i) {
            const uint2 t = *(const uint2*)(ys0 + i * 256 + lane * 4), u = *(const uint2*)(ys1 + i * 256 + lane * 4);
            const float4 g = *(const float4*)(g2 + i * 256 + lane * 4);
            v[i * 4 + 0] += (bf2f((bf16_t)(t.x & 0xffff)) + bf2f((bf16_t)(u.x & 0xffff))) * g.x; v[i * 4 + 1] += (bf2f((bf16_t)(t.x >> 16)) + bf2f((bf16_t)(u.x >> 16))) * g.y;
            v[i * 4 + 2] += (bf2f((bf16_t)(t.y & 0xffff)) + bf2f((bf16_t)(u.y & 0xffff))) * g.z; v[i * 4 + 3] += (bf2f((bf16_t)(t.y >> 16)) + bf2f((bf16_t)(u.y >> 16))) * g.w;
        }
    }
    float ss = 0.f;
#pragma unroll
    for (int i = 0; i < 16; ++i) ss += v[i] * v[i];
    ss = wave_sum(ss);
    const float r = rsqrtf(ss * (1.f / D) + EPS);
    float* o = p.out + (long)tok * D;
#pragma unroll
    for (int i = 0; i < 4; ++i) { const float4 w = *(const float4*)(p.final_w + i * 256 + lane * 4);
        *(float4*)(o + i * 256 + lane * 4) = make_float4(v[i * 4 + 0] * r * w.x, v[i * 4 + 1] * r * w.y, v[i * 4 + 2] * r * w.z, v[i * 4 + 3] * r * w.w); }
}


#define XB_TMO      128
#define XB_XCNT(j)  (256  + 64 * (j))
#define XB_XSUB(j)  (1280 + 64 * (j))
#define XB_XGEN(j)  (2304 + 64 * (j))
#define XB_TOP      3328
#define XB_TOPGEN   3392
#define XCD_BAR_WORDS 3456
#define XB_SPIN_CAP (1u << 22)
__device__ __forceinline__ unsigned xb_ld(unsigned* p)              { return __hip_atomic_load(p, __ATOMIC_RELAXED, __HIP_MEMORY_SCOPE_AGENT); }
__device__ __forceinline__ unsigned xb_add(unsigned* p, unsigned v) { return __hip_atomic_fetch_add(p, v, __ATOMIC_RELAXED, __HIP_MEMORY_SCOPE_AGENT); }
__device__ __forceinline__ unsigned xb_xcc_id() { return (unsigned)__builtin_amdgcn_s_getreg((3 << 11) | 20) & 0xFu; }
#define XB_SPIN(cond, bar) do { unsigned _sp = 0; while (cond) { __builtin_amdgcn_s_sleep(1); \
    if ((++_sp & 255u) == 0u) { if (xb_ld(&(bar)[XB_TMO])) break; if (_sp > XB_SPIN_CAP) { atomicAdd(&(bar)[XB_TMO], 1u); break; } } } } while (0)
struct XcdBarrier { unsigned* bar; unsigned x; volatile LAS unsigned* st; };
__device__ __forceinline__ XcdBarrier xcd_barrier_post(unsigned* bar, volatile LAS unsigned* st) {
    XcdBarrier b; b.bar = bar; b.x = xb_xcc_id(); b.st = st;
    if (threadIdx.x == 0) (void)xb_add(&bar[XB_XCNT(b.x)], 1u);
    return b;
}
__device__ __forceinline__ void xcd_barrier_complete(unsigned* bar, unsigned x, unsigned& nloc, unsigned& nx) {
    const unsigned G = gridDim.x * gridDim.y * gridDim.z;
    unsigned sum, cnt, mine, sp = 0u;
    for (;;) {
        sum = 0u; cnt = 0u; mine = 0u;
#pragma unroll
        for (unsigned j = 0; j < 16; ++j) { const unsigned c = xb_ld(&bar[XB_XCNT(j)]); sum += c; cnt += (c > 0u) ? 1u : 0u; mine = (j == x) ? c : mine; }
        if (sum == G) break;
        __builtin_amdgcn_s_sleep(1);
        if ((++sp & 255u) == 0u) { if (xb_ld(&bar[XB_TMO])) break; if (sp > XB_SPIN_CAP) { atomicAdd(&bar[XB_TMO], 1u); break; } }
    }
    nloc = mine > 0u ? mine : 1u; nx = cnt > 0u ? cnt : 1u;
}
__device__ __forceinline__ void xcd_barrier(const XcdBarrier& b) {
    asm volatile("s_waitcnt vmcnt(0)" ::: "memory");
    __syncthreads();
    if (threadIdx.x == 0) {
        unsigned* bar = b.bar;
        __builtin_amdgcn_s_waitcnt(0);
        unsigned bx = __builtin_amdgcn_readfirstlane(b.x); asm volatile("" : "+s"(bx));
        unsigned nloc = b.st[0], nx = b.st[1];
        if (nloc == 0u) { xcd_barrier_complete(bar, bx, nloc, nx); b.st[0] = nloc; b.st[1] = nx; }
        const unsigned old = xb_add(&bar[XB_XSUB(bx)], 1u);
        const unsigned gen = old / nloc;
        if (old + 1u == (gen + 1u) * nloc) {
            __builtin_amdgcn_fence(__ATOMIC_RELEASE, "agent");
            asm volatile("s_waitcnt vmcnt(0)" ::: "memory");
            const unsigned og = xb_add(&bar[XB_TOP], 1u);
            const unsigned tg = og / nx;
            if (og + 1u == (tg + 1u) * nx) xb_add(&bar[XB_TOPGEN], 1u);
            else XB_SPIN(xb_ld(&bar[XB_TOPGEN]) == tg, bar);
            __builtin_amdgcn_fence(__ATOMIC_ACQUIRE, "agent");
            xb_add(&bar[XB_XGEN(bx)], 1u);
            asm volatile("s_waitcnt vmcnt(0)" ::: "memory");
        } else {
            XB_SPIN(xb_ld(&bar[XB_XGEN(bx)]) == gen, bar);
            __builtin_amdgcn_fence(__ATOMIC_ACQUIRE, "agent");
            asm volatile("s_waitcnt vmcnt(0)" ::: "memory");
        }
    }
    __syncthreads();
}

#define FOR_VB(n) for (int vb = blockIdx.x; vb < (n); vb += gridDim.x)
#define FOR_VB_XCD(n) for (int _ch = ((n) + 7) >> 3, _j = (int)blockIdx.x >> 3, vb = ((int)blockIdx.x & 7) * _ch + _j; _j < _ch; _j += (int)gridDim.x >> 3, vb += (int)gridDim.x >> 3) if (vb < (n))
#define FOR_VB_OFF(n, off) for (int vb = (int)((blockIdx.x + gridDim.x - ((off) % gridDim.x)) % gridDim.x); vb < (n); vb += gridDim.x)
__global__ void __launch_bounds__(256, 2) k_mega(P p) {
    extern __shared__ __attribute__((aligned(16))) unsigned char dynlds[];
    bf16_t* smem = (bf16_t*)dynlds;
    uint4* xbw = (uint4*)(dynlds + SMEM_BYTES);
    float (*tt)[65] = (float (*)[65])smem;
    if (threadIdx.x == 0) *xbw = make_uint4(0u, 0u, 0u, 0u);
    __syncthreads();
    const XcdBarrier xb = xcd_barrier_post(p.bar, (volatile LAS unsigned*)xbw);
    if (threadIdx.x == 0) {
        const unsigned key = (xb.x << 8) | ((unsigned)__builtin_amdgcn_s_getreg((7 << 11) | (8 << 6) | 4) & 0xFFu);
        ((volatile LAS unsigned*)xbw)[4] = xb_add(&p.cuslot[key], 1u) & 1u;
    }
    __syncthreads();
    const int slot = __builtin_amdgcn_readfirstlane((int)((volatile LAS unsigned*)xbw)[4]);
    if (blockIdx.x == 0 && otid() < DEPTH * NEXP) p.cnt[otid()] = 0;
    if (blockIdx.x == 1 && otid() < DEPTH * NB * 10) p.KMAX[otid()] = 0u;
    if (blockIdx.x == 2) for (int i = otid(); i < SY_LAYER + DEPTH * SY_STRIDE; i += 256) p.SYNC[i] = 0u;
    FOR_VB(6) b_rope_table(p, vb);
    FOR_VB(DEPTH * 6 * D / 64) b_mod(p, vb, (float*)smem);
    __syncthreads();
    constexpr int CI1 = 28 * 16 / 4, CI2 = 12 * 16 / 4, CVO = (D / 64) * (D / 64) / 4;
    auto prep_in = [&](int bz, int off) {
        FOR_VB_OFF(CI1, off) b_convT_stream(bz * CI1 + vb, p.w_in, p.WT_IN, D, 1792, nullptr, IN_COLS, 0, 0, (long)D * IN_COLS, (long)PCW * D);
        FOR_VB_OFF(CI2, off + CI1) b_convT_stream(bz * CI2 + vb, p.w_in, p.WT_IN, D, 768, nullptr, IN_COLS, 1808, 1792, (long)D * IN_COLS, (long)PCW * D);
        FOR_VB_OFF(16, off + CI1 + CI2) b_convT(tt, 0, vb, bz, p.w_in, p.WT_IN, D, IN_COLS, OLD_BDT, 16, PC, (long)D * IN_COLS, (long)PCW * D);
    };
    prep_in(0, 0);
    FOR_VB(1 * 16 * DEPTH) b_convT(tt, 0, vb % 16, vb / 16, p.w_grouter, p.WT_R, D, 4, 0, 4, 0, (long)D * 4, (long)128 * D);
    FOR_VB(1 * 16 * DEPTH) b_convT(tt, 0, vb % 16, vb / 16, p.w_router, p.WT_R, D, 32, 0, 32, 4, (long)D * 32, (long)128 * D);
    xcd_barrier(xb);
    for (int l = 0; l < DEPTH; ++l) {
        const bool last = (l == DEPTH - 1);
        const int ntok = last ? NLAT : NTOK;
        FOR_VB(NTOK / 16) b_norm1(p, l, vb);
        {
            constexpr int NT = PCW / 128, MPX = (NTOK / 128) / 8, CH = MPX * NT, M0 = (MPX + 1) / 2, M1 = MPX - M0;
            __builtin_amdgcn_s_setprio(2);
            for (int j = (int)blockIdx.x >> 3; j < CH; j += (int)gridDim.x >> 3) {
                const int jj = j < M0 * NT ? j : j - M0 * NT, mh = j < M0 * NT ? M0 : M1, m = (j < M0 * NT ? 0 : M0) + jj % mh, n = jj / mh;
                b_inproj(p, l, (((int)blockIdx.x & 7) * MPX + m) * NT + n, smem);
            }
            __builtin_amdgcn_s_setprio(0);
        }
        xcd_barrier(xb);
        {
            const int nst = NB * NCH * 8, nsc = NB * 8 * 2 * 4096 / 256;
            const int ncu = NB * 4 * (L / 128) + (last ? 0 : NB * 4 * 2);
            FOR_VB_OFF(nst, 0) b_ssd_states(p, l, vb, smem);
            constexpr int CVL = NEXP * (D / 64) * (DEXP / 64) / 4;
#pragma unroll 1
            for (int step = 0; step < 2; ++step) {
                if ((step ^ slot) == 0) {
                    __builtin_amdgcn_s_setprio(2);
                    FOR_VB_OFF(ncu, nst) b_attnC(p, l, vb, smem);
                    __builtin_amdgcn_s_setprio(0);
                } else {
                    for (int vb = l * CVL + (int)blockIdx.x; vb < (l + 1) * CVL; vb += (int)gridDim.x) b_convT_stream(vb, p.w_gate, p.WT_G, D, DEXP);
                    for (int vb = l * CVL + (int)blockIdx.x; vb < (l + 1) * CVL; vb += (int)gridDim.x) b_convT_stream(vb, p.w_up, p.WT_U, D, DEXP);
                    for (int vb = l * CVL + (int)blockIdx.x; vb < (l + 1) * CVL; vb += (int)gridDim.x) b_convT_stream(vb, p.w_down, p.WT_D, DEXP, D);
                    FOR_VB_OFF(CVO, 192) b_convT_stream(l * CVO + vb, p.w_out, p.WT_OUT, D, D, p.b_norm_w);
                    if (l + 1 < DEPTH) prep_in(l + 1, 192 + CVO);
                }
                if (step == 0) { FOR_VB_OFF(nsc, nst + ncu) b_ssd_scan(p, l, vb); }
            }
            FOR_VB_OFF(ncu, nst + nsc + ncu) b_attnA(p, l, vb, smem);
            FOR_VB_OFF(nst, nst + nsc + 2 * ncu) { if (last && ((vb >> 3) % NCH) < 2) continue; b_ssd_out(p, l, vb, smem); }
        }
        xcd_barrier(xb);
        {
            const int ch = (ntok / 128) * (D / 128) / 8, bpx = (int)gridDim.x >> 3, j = (int)blockIdx.x >> 3, xc = (int)blockIdx.x & 7;
            const int rem = ch % bpx, nfull = (rem * 8 <= bpx) ? ch - rem : ch;
            for (int t = j; t < nfull; t += bpx) { const int vb = xc * ch + t; b_outproj<4, 4>(p, l, (vb >> 3) * 128, (vb & 7) * 128, smem); }
            for (int q = j; q < (ch - nfull) * 8; q += bpx) { const int vb = xc * ch + nfull + (q >> 3), sub = q & 7; b_outproj<2, 1>(p, l, (vb >> 3) * 128 + (sub >> 2) * 64, (vb & 7) * 128 + (sub & 3) * 32, smem); }
        }
        xcd_barrier(xb);
        FOR_VB(ntok / 16) b_norm2r(p, l, vb, smem);
        xcd_barrier(xb);
        const int nbig = moe_row_tiles(p.cnt + l * NEXP) * 4, mch = (nbig + 7) >> 3, bpx = (int)gridDim.x >> 3, mj = (int)blockIdx.x >> 3;
        const int mlo = ((int)blockIdx.x & 7) * mch, mcnt = max(min(mlo + mch, nbig) - mlo, 0), mrem = mcnt % bpx;
        const int msplit = (mrem == 0) ? 1 : (mrem * 4 <= bpx) ? 4 : (mrem * 2 <= bpx) ? 2 : 1, mfull = msplit > 1 ? mcnt - mrem : mcnt;
        for (int t = mj; t < mfull; t += bpx) { const int bt = mlo + t; b_moe_up<8>(p, l, bt >> 2, (bt & 3) * 128, smem); }
        if (msplit == 4) { for (int q = mj; q < mrem * 4; q += bpx) { const int bt = mlo + mfull + (q >> 2); b_moe_up<2>(p, l, bt >> 2, (bt & 3) * 128 + (q & 3) * 32, smem); } }
        else if (msplit == 2) { for (int q = mj; q < mrem * 2; q += bpx) { const int bt = mlo + mfull + (q >> 1); b_moe_up<4>(p, l, bt >> 2, (bt & 3) * 128 + (q & 1) * 64, smem); } }
        xcd_barrier(xb);
        for (int t = mj; t < mfull; t += bpx) { const int bt = mlo + t; b_moe_down<8>(p, l, bt >> 2, (bt & 3) * 256, smem); }
        if (msplit == 4) { for (int q = mj; q < mrem * 4; q += bpx) { const int bt = mlo + mfull + (q >> 2); b_moe_down<2>(p, l, bt >> 2, (bt & 3) * 256 + (q & 3) * 64, smem); } }
        else if (msplit == 2) { for (int q = mj; q < mrem * 2; q += bpx) { const int bt = mlo + mfull + (q >> 1); b_moe_down<4>(p, l, bt >> 2, (bt & 3) * 256 + (q & 1) * 128, smem); } }
        xcd_barrier(xb);
    }
    FOR_VB(NLAT / 4) b_final(p, vb);
}

extern "C" void kernel_launch(void* const* d_in, const int* in_sizes, int n_in, void* d_out, int out_size, void* d_ws, size_t ws_size, hipStream_t stream) {
    P p{};
    const float** f = (const float**)&p;
    for (int i = 0; i < 25; ++i) f[i] = (const float*)d_in[i];
    p.out = (float*)d_out;
    char* w = (char*)d_ws; size_t off = 0;
    auto take = [&](size_t bytes) { char* r = w + off; off += (bytes + 255) & ~(size_t)255; return r; };
    p.X = (float*)take((size_t)NTOK * D * 4);
    p.MOD = (float*)take((size_t)DEPTH * 5 * 6 * D * 4);
    p.DT = (float*)take((size_t)NTOK * 16 * 4);
    p.SSQ = (float*)take((size_t)NTOK * 8 * 4);
    p.SYNC = (unsigned*)take((size_t)(SY_LAYER + DEPTH * SY_STRIDE) * 4);
    p.ST = (float*)take((size_t)NB * NCH * 16 * 4096 * 4);
    p.DEC = (float*)take((size_t)NB * NCH * 16 * 4);
    p.HS = (bf16_t*)take((size_t)NB * NCH * 16 * 4096 * 2);
    p.gatew = (float*)take((size_t)NTOK * 2 * 4);
    p.H = (bf16_t*)take((size_t)NTOK * D * 2);
    p.PROJ = (bf16_t*)take((size_t)NTOK * PC * 2);
    p.WT_IN = (bf16_t*)take((size_t)DEPTH * PCW * D * 2);
    p.WT_R = (bf16_t*)take((size_t)DEPTH * 128 * D * 2);
    p.WT_OUT = (bf16_t*)take((size_t)DEPTH * D * D * 2);
    p.WT_G = (bf16_t*)take((size_t)DEPTH * NEXP * DEXP * D * 2);
    p.WT_U = (bf16_t*)take((size_t)DEPTH * NEXP * DEXP * D * 2);
    p.WT_D = (bf16_t*)take((size_t)DEPTH * NEXP * DEXP * D * 2);
    p.MIXO = (bf16_t*)take((size_t)NTOK * D * 2);
    p.HID = (bf16_t*)take((size_t)(NTOK * 2 + 128) * DEXP * 2);
    p.YS = (bf16_t*)take((size_t)(NTOK * 2 + 128) * D * 2);
    p.cnt = (int*)take((size_t)DEPTH * NEXP * 4);
    p.list = (int*)take((size_t)NEXP * NTOK * 4);
    p.pos = (int*)take((size_t)NTOK * 2 * 4);
    p.VT = (bf16_t*)take((size_t)NB * 4 * 64 * NKEY * 2);
    p.VTA = (bf16_t*)take((size_t)NB * 2 * 64 * NKEY * 2);
    p.bar = (unsigned*)take((size_t)(XCD_BAR_WORDS + 4096) * 4); p.cuslot = p.bar + XCD_BAR_WORDS;
    p.ROPE = (float*)take((size_t)64 * 24 * 2 * 4);
    p.KMAX = (unsigned*)take((size_t)DEPTH * NB * 10 * 4);
    if (off > ws_size) { fprintf(stderr, "workspace too small: need %zu have %zu\n", off, ws_size); return; }

    (void)hipMemsetAsync(p.bar, 0, (XCD_BAR_WORDS + 4096) * 4, stream);
    static int grid_blocks = 0;
    if (!grid_blocks) {
        int dev = 0, cus = 0, per_cu = 0;
        (void)hipGetDevice(&dev);
        (void)hipDeviceGetAttribute(&cus, hipDeviceAttributeMultiprocessorCount, dev);
        if (hipFuncSetAttribute((const void*)k_mega, hipFuncAttributeMaxDynamicSharedMemorySize, LDS_BYTES) != hipSuccess) fprintf(stderr, "hipFuncSetAttribute(LDS %d) failed\n", LDS_BYTES);
        (void)hipOccupancyMaxActiveBlocksPerMultiprocessor(&per_cu, k_mega, 256, LDS_BYTES);
        if (per_cu > 2) per_cu = 2;
        grid_blocks = cus * per_cu;
    }
    void* args[] = {&p};
    hipError_t e = hipLaunchCooperativeKernel((void*)k_mega, dim3(grid_blocks), dim3(256), args, LDS_BYTES, stream);
    if (e != hipSuccess) fprintf(stderr, "cooperative launch failed: %s (grid %d)\n", hipGetErrorString(e), grid_blocks);
}
```

```cpp
#include <hip/hip_runtime.h>
#include <cstdio>
#include <cstdint>

typedef unsigned short bf16_t;
typedef short bf16x8 __attribute__((ext_vector_type(8)));
typedef float f32x4 __attribute__((ext_vector_type(4)));
typedef unsigned u32x4 __attribute__((ext_vector_type(4)));
typedef float f32x16 __attribute__((ext_vector_type(16)));

constexpr int D = 1024, NB = 4, L = 4096, LC = 256, NLAT = NB * L, NCTX = NB * LC, NTOK = NLAT + NCTX, DEPTH = 4;
constexpr int IN_COLS = 2576, OLD_BDT = 1792;
constexpr int PC = 2560;
constexpr int PCW = 2688;
constexpr int P_AQ = 0, P_AK = 256, P_AV = 384, P_BZ = 512, P_BX = 1024, P_CQ = 1792, P_CK = 2048, P_CV = 2304;
constexpr int NEXP = 32, DEXP = 512, CPAD = 32;
constexpr int NKEY = L + LC;
constexpr int NKT = NKEY / 64;
constexpr float EPS = 1e-6f;

__device__ __forceinline__ int otid() { int t = threadIdx.x; asm volatile("" : "+v"(t)); return t; }
typedef __bf16 bf16n2 __attribute__((ext_vector_type(2)));
__device__ __forceinline__ bf16_t f2bf(float f) { return __builtin_bit_cast(bf16_t, (__bf16)f); }
__device__ __forceinline__ unsigned pack_bf16(float a, float b) { const bf16n2 v = {(__bf16)a, (__bf16)b}; return __builtin_bit_cast(unsigned, v); }
__device__ __forceinline__ float bf2f(bf16_t h) { return __uint_as_float(((unsigned)h) << 16); }
__device__ __forceinline__ float wave_sum(float v) {
#pragma unroll
    for (int o = 32; o > 0; o >>= 1) v += __shfl_xor(v, o);
    return v;
}
__device__ __forceinline__ float siluf(float v) { return v * __builtin_amdgcn_rcpf(1.f + __expf(-v)); }
__device__ __forceinline__ int tok_modrow(int tok) { return tok < NLAT ? tok / L : NB; }

struct P {
    const float *x, *c, *ctx, *c_ctx, *w_mod, *b_mod, *norm1_w, *norm2_w, *w_in, *w_out, *a_sink, *conv_w, *conv_b, *dt_bias, *a_log, *d_skip,
        *b_norm_w, *c_lambda, *c_subln_w, *w_grouter, *w_router, *w_gate, *w_up, *w_down, *final_w;
    float* out;
    float* X; float* MOD; float* DT; float* SSQ; float* gatew; float* ST; float* DEC; float* ROPE;
    bf16_t *H, *PROJ, *WT_IN, *WT_OUT, *WT_G, *WT_U, *WT_D, *MIXO, *HID, *YS, *VT, *VTA, *HS, *WT_R;
    int *cnt, *list, *pos;
    unsigned* bar; unsigned* cuslot;
    unsigned* SYNC;
    unsigned* KMAX;
};

__device__ __forceinline__ void b_convT(float (*t)[65], int bx, int by, int bz, const float* __restrict__ src, bf16_t* __restrict__ dst, int K, int ld_src, int c0, int ncols, int n_dst0,
                                        long src_bstride, long dst_bstride) {
    src += (long)bz * src_bstride; dst += (long)bz * dst_bstride;
    const int kb = by * 64, nb = bx * 64, tid = otid();
    const int c4 = (tid & 15) * 4, kr0 = tid >> 4;
#pragma unroll
    for (int i = 0; i < 4; ++i) {
        const int kr = kr0 + i * 16;
        float4 v = make_float4(0.f, 0.f, 0.f, 0.f);
        if (nb + c4 < ncols) v = *(const float4*)(src + (long)(kb + kr) * ld_src + c0 + nb + c4);
        t[kr][c4] = v.x; t[kr][c4 + 1] = v.y; t[kr][c4 + 2] = v.z; t[kr][c4 + 3] = v.w;
    }
    __syncthreads();
    const int n = tid >> 2, kq = (tid & 3) * 16;
    if (nb + n < ncols) {
        unsigned o[8];
#pragma unroll
        for (int j = 0; j < 8; ++j) o[j] = (unsigned)f2bf(t[kq + 2 * j][n]) | ((unsigned)f2bf(t[kq + 2 * j + 1][n]) << 16);
        bf16_t* d = dst + (long)(n_dst0 + nb + n) * K + kb + kq;
        *(u32x4*)d = (u32x4){o[0], o[1], o[2], o[3]};
        *(u32x4*)(d + 8) = (u32x4){o[4], o[5], o[6], o[7]};
    }
    __syncthreads();
}

__device__ __forceinline__ void b_convT_stream(int vb, const float* __restrict__ src, bf16_t* __restrict__ dst, int K, int N, const float* rowscale = nullptr,
                                               int ld_src = 0, int c0 = 0, int n_dst0 = 0, long src_ms = 0, long dst_ms = 0) {
    const int tid = otid(), lane = tid & 63;
    const int gw = vb * 4 + (tid >> 6);
    const int nbs = N >> 6, kbs = K >> 6;
    const int mat = gw / (nbs * kbs), r = gw % (nbs * kbs), kb = r / nbs, nb = r % nbs;
    const int kq = lane & 3, n4l = lane >> 2;
    if (ld_src == 0) { ld_src = N; src_ms = (long)K * N; dst_ms = (long)K * N; }
    const float* sp = src + mat * src_ms + (long)(kb * 64 + kq * 8) * ld_src + c0 + nb * 64 + n4l * 4;
    float4 v[16];
#pragma unroll
    for (int j = 0; j < 16; ++j) { const f32x4 t = __builtin_nontemporal_load((const f32x4*)(sp + (long)((j & 7) + (j >> 3) * 32) * ld_src)); v[j] = make_float4(t[0], t[1], t[2], t[3]); }
    if (rowscale) {
        const int k0 = kb * 64 + kq * 8;
        if (k0 >= 256 && k0 < 768) {
#pragma unroll
            for (int j = 0; j < 16; ++j) { const float sc = rowscale[mat * 512 + k0 - 256 + (j & 7) + (j >> 3) * 32]; v[j].x *= sc; v[j].y *= sc; v[j].z *= sc; v[j].w *= sc; }
        }
    }
    bf16_t* dp = dst + mat * dst_ms + (long)(n_dst0 + nb * 64 + n4l * 4) * K + kb * 64 + kq * 8;
    u32x4 o0, o1;
#pragma unroll
    for (int j = 0; j < 4; ++j) { o0[j] = pack_bf16(v[2 * j].x, v[2 * j + 1].x); o1[j] = pack_bf16(v[8 + 2 * j].x, v[8 + 2 * j + 1].x); }
    __builtin_nontemporal_store(o0, (u32x4*)dp); __builtin_nontemporal_store(o1, (u32x4*)(dp + 32));
#pragma unroll
    for (int j = 0; j < 4; ++j) { o0[j] = pack_bf16(v[2 * j].y, v[2 * j + 1].y); o1[j] = pack_bf16(v[8 + 2 * j].y, v[8 + 2 * j + 1].y); }
    __builtin_nontemporal_store(o0, (u32x4*)(dp + K)); __builtin_nontemporal_store(o1, (u32x4*)(dp + K + 32));
#pragma unroll
    for (int j = 0; j < 4; ++j) { o0[j] = pack_bf16(v[2 * j].z, v[2 * j + 1].z); o1[j] = pack_bf16(v[8 + 2 * j].z, v[8 + 2 * j + 1].z); }
    __builtin_nontemporal_store(o0, (u32x4*)(dp + 2 * K)); __builtin_nontemporal_store(o1, (u32x4*)(dp + 2 * K + 32));
#pragma unroll
    for (int j = 0; j < 4; ++j) { o0[j] = pack_bf16(v[2 * j].w, v[2 * j + 1].w); o1[j] = pack_bf16(v[8 + 2 * j].w, v[8 + 2 * j + 1].w); }
    __builtin_nontemporal_store(o0, (u32x4*)(dp + 3 * K)); __builtin_nontemporal_store(o1, (u32x4*)(dp + 3 * K + 32));
}

__device__ __forceinline__ void b_rope_table(const P& p, int vb) {
    const int idx = vb * 256 + otid();
    if (idx >= 64 * 24) return;
    const int pos = idx / 24, f = idx % 24;
    const float fr = f < 16 ? __expf(-(float)f * (1.f / 16.f) * 9.210340371976184f) : __expf(-(float)(f - 16) * (1.f / 8.f) * 9.210340371976184f);
    float sn, cs; sincosf((float)pos * fr, &sn, &cs);
    p.ROPE[idx * 2] = cs; p.ROPE[idx * 2 + 1] = sn;
}

__device__ __forceinline__ void b_mod(const P& p, int vb, float* red) {
    const int tid = otid(), lane = tid & 63, kq = tid >> 6, ks = lane >> 4, c4 = (lane & 15) * 4;
    const int idx = vb * 64 + c4;
    const int l = idx / (6 * D), n = idx % (6 * D);
    float acc[5][4];
#pragma unroll
    for (int r = 0; r < 5; ++r)
#pragma unroll
        for (int e = 0; e < 4; ++e) acc[r][e] = 0.f;
    const float* w = p.w_mod + (long)l * D * 6 * D + n;
    float* sc = red + 2048;
    for (int i = tid; i < 5 * D; i += 256) { const int r = i / D, k = i % D; sc[i] = siluf((r < 4) ? p.c[r * D + k] : p.c_ctx[k]); }
    __syncthreads();
#pragma unroll 8
    for (int k = kq * 256 + ks; k < kq * 256 + 256; k += 4) {
        const float4 wv = *(const float4*)(w + (long)k * 6 * D);
#pragma unroll
        for (int r = 0; r < 5; ++r) {
            const float cv = sc[r * D + k];
            acc[r][0] += cv * wv.x; acc[r][1] += cv * wv.y; acc[r][2] += cv * wv.z; acc[r][3] += cv * wv.w;
        }
    }
#pragma unroll
    for (int r = 0; r < 5; ++r)
#pragma unroll
        for (int e = 0; e < 4; ++e) { float v = acc[r][e]; v += __shfl_xor(v, 16); v += __shfl_xor(v, 32); acc[r][e] = v; }
    __syncthreads();
    if (ks == 0) {
#pragma unroll
        for (int r = 0; r < 5; ++r) *(float4*)(red + (kq * 5 + r) * 64 + c4) = make_float4(acc[r][0], acc[r][1], acc[r][2], acc[r][3]);
    }
    __syncthreads();
    if (tid < 64) {
        const int col = tid, i2 = vb * 64 + col, n2 = i2 % (6 * D);
        const float bv = p.b_mod[l * 6 * D + n2];
#pragma unroll
        for (int r = 0; r < 5; ++r) p.MOD[((long)l * 5 + r) * 6 * D + n2] = ((red[(0 * 5 + r) * 64 + col] + red[(1 * 5 + r) * 64 + col]) + (red[(2 * 5 + r) * 64 + col] + red[(3 * 5 + r) * 64 + col])) + bv;
    }
}

__device__ __forceinline__ void wt_store(float* ptr, float v) { __hip_atomic_store(ptr, v, __ATOMIC_RELAXED, __HIP_MEMORY_SCOPE_AGENT); }
__device__ __forceinline__ void wt_store(unsigned* ptr, unsigned v) { __hip_atomic_store(ptr, v, __ATOMIC_RELAXED, __HIP_MEMORY_SCOPE_AGENT); }
__device__ __forceinline__ void wt_store8(void* ptr, unsigned lo, unsigned hi) { __hip_atomic_store((unsigned long long*)ptr, ((unsigned long long)hi << 32) | lo, __ATOMIC_RELAXED, __HIP_MEMORY_SCOPE_AGENT); }
__device__ __forceinline__ void unit_publish(unsigned* cnt) {
    asm volatile("s_waitcnt vmcnt(0)" ::: "memory");
    __syncthreads();
    if (threadIdx.x == 0) (void)__hip_atomic_fetch_add(cnt, 1u, __ATOMIC_RELAXED, __HIP_MEMORY_SCOPE_AGENT);
}
__device__ __forceinline__ void unit_wait(unsigned* cnt, unsigned target) {
    if (threadIdx.x == 0) {
        unsigned sp = 0;
        while (__hip_atomic_load(cnt, __ATOMIC_RELAXED, __HIP_MEMORY_SCOPE_AGENT) < target) { __builtin_amdgcn_s_sleep(2); if (++sp > (1u << 24)) break; }
        __builtin_amdgcn_fence(__ATOMIC_ACQUIRE, "agent");
        asm volatile("s_waitcnt vmcnt(0)" ::: "memory");
    }
    __syncthreads();
}

__device__ __forceinline__ void unit_wait_nf(unsigned* cnt, unsigned target) {
    if (threadIdx.x == 0) {
        unsigned sp = 0;
        while (__hip_atomic_load(cnt, __ATOMIC_RELAXED, __HIP_MEMORY_SCOPE_AGENT) < target) { __builtin_amdgcn_s_sleep(2); if (++sp > (1u << 24)) break; }
    }
    __syncthreads();
    asm volatile("" ::: "memory");
}
constexpr int SY_LAYER = 256, SY_STRIDE = 1024, SY_N1 = 0, SY_OP = 136, SY_N2 = 272, SY_UP = 408;
__device__ __forceinline__ unsigned* sync_ctr(const P& p, int l, int which, int idx) { return p.SYNC + SY_LAYER + l * SY_STRIDE + which + idx; }

__device__ __forceinline__ void b_norm1(const P& p, int l, int vb) {
    const int wave = otid() >> 6, lane = otid() & 63;
#pragma unroll 1
    for (int i4 = 0; i4 < 4; ++i4) {
        const int tok = vb * 16 + wave * 4 + i4;
        float v[16];
        int ps0 = 0, ps1 = 0;
        if (l > 0) { ps0 = p.pos[tok * 2 + 0]; ps1 = p.pos[tok * 2 + 1]; }
        const float* src = (l == 0) ? (tok < NLAT ? p.x + (long)tok * D : p.ctx + (long)(tok - NLAT) * D) : p.X + (long)tok * D;
#pragma unroll
        for (int i = 0; i < 4; ++i) { const float4 t = *(const float4*)(src + i * 256 + lane * 4); v[i * 4 + 0] = t.x; v[i * 4 + 1] = t.y; v[i * 4 + 2] = t.z; v[i * 4 + 3] = t.w; }
        if (l > 0) {
            const bf16_t* ys0 = p.YS + (long)ps0 * D; const bf16_t* ys1 = p.YS + (long)ps1 * D;
            const float* g2 = p.MOD + ((long)(l - 1) * 5 + tok_modrow(tok)) * 6 * D + 5 * D;
#pragma unroll
            for (int i = 0; i < 4; ++i) {
                const uint2 t = *(const uint2*)(ys0 + i * 256 + lane * 4), u = *(const uint2*)(ys1 + i * 256 + lane * 4);
                const float4 g = *(const float4*)(g2 + i * 256 + lane * 4);
                v[i * 4 + 0] += (bf2f((bf16_t)(t.x & 0xffff)) + bf2f((bf16_t)(u.x & 0xffff))) * g.x; v[i * 4 + 1] += (bf2f((bf16_t)(t.x >> 16)) + bf2f((bf16_t)(u.x >> 16))) * g.y;
                v[i * 4 + 2] += (bf2f((bf16_t)(t.y & 0xffff)) + bf2f((bf16_t)(u.y & 0xffff))) * g.z; v[i * 4 + 3] += (bf2f((bf16_t)(t.y >> 16)) + bf2f((bf16_t)(u.y >> 16))) * g.w;
            }
        }
        float* xo = p.X + (long)tok * D;
#pragma unroll
        for (int i = 0; i < 4; ++i) *(float4*)(xo + i * 256 + lane * 4) = make_float4(v[i * 4 + 0], v[i * 4 + 1], v[i * 4 + 2], v[i * 4 + 3]);
        float ss = 0.f;
#pragma unroll
        for (int i = 0; i < 16; ++i) ss += v[i] * v[i];
        ss = wave_sum(ss);
        const float r = rsqrtf(ss * (1.f / D) + EPS);
        const float* m = p.MOD + ((long)l * 5 + tok_modrow(tok)) * 6 * D;
        const float* nw = p.norm1_w + l * D;
        bf16_t* ho = p.H + (long)tok * D;
#pragma unroll
        for (int i = 0; i < 4; ++i) {
            const int k = i * 256 + lane * 4;
            const float4 w4 = *(const float4*)(nw + k), sc = *(const float4*)(m + D + k), sh = *(const float4*)(m + k);
            wt_store8(ho + k, pack_bf16(v[i * 4 + 0] * r * w4.x * (1.f + sc.x) + sh.x, v[i * 4 + 1] * r * w4.y * (1.f + sc.y) + sh.y),
                              pack_bf16(v[i * 4 + 2] * r * w4.z * (1.f + sc.z) + sh.z, v[i * 4 + 3] * r * w4.w * (1.f + sc.w) + sh.w));
        }
    }
    unit_publish(sync_ctr(p, l, SY_N1, vb >> 3));
}

#define LAS __attribute__((address_space(3)))
constexpr int LDS_STRIDE = 72;
constexpr int SMEM_BYTES = 65536;
constexpr int LDS_BYTES = SMEM_BYTES + 256;
struct NoHook { template <class A> __device__ __forceinline__ void operator()(int, A&) const {} };
template <int MI = 4, int NI = 4, class RowA, class RowB, class Epi, class Hook = NoHook>
__device__ __forceinline__ void gemm_tile(const RowA& ra, const RowB& rb, int K, bf16_t* smem, const Epi& epi, const Hook& hook = Hook()) {
    LAS unsigned char* lds = (LAS unsigned char*)smem;
    const int tid = otid(), lane = tid & 63, w = __builtin_amdgcn_readfirstlane(tid >> 6), wm = w >> 1, wn = w & 1, lr = lane & 15, lq = lane >> 4;
    f32x4 acc[MI][NI];
#pragma unroll
    for (int i = 0; i < MI; ++i)
#pragma unroll
        for (int j = 0; j < NI; ++j) acc[i][j] = (f32x4){0.f, 0.f, 0.f, 0.f};
    const bf16_t* pa[MI]; const bf16_t* pb[NI];
    const int kcs = ((lane & 7) ^ ((lane >> 3) & 7)) * 8;
#pragma unroll
    for (int i = 0; i < MI; ++i) pa[i] = ra((i * 4 + w) * 8 + (lane >> 3)) + kcs;
#pragma unroll
    for (int i = 0; i < NI; ++i) pb[i] = rb((i * 4 + w) * 8 + (lane >> 3)) + kcs;
    auto stage = [&](int buf, int k0) {
#pragma unroll
        for (int i = 0; i < MI; ++i) __builtin_amdgcn_global_load_lds((const unsigned*)(pa[i] + k0), (LAS unsigned*)(lds + buf * 32768 + (i * 4 + w) * 1024), 16, 0, 0);
#pragma unroll
        for (int i = 0; i < NI; ++i) __builtin_amdgcn_global_load_lds((const unsigned*)(pb[i] + k0), (LAS unsigned*)(lds + buf * 32768 + 16384 + (i * 4 + w) * 1024), 16, 0, 0);
    };
    const int aoff = (wm * MI * 16 + lr) * 128 + ((lq ^ (lr & 7)) << 4), boff = 16384 + (wn * NI * 16 + lr) * 128 + ((lq ^ (lr & 7)) << 4);
    const int nk = K >> 6;
    __syncthreads();
    stage(0, 0);
    for (int kt = 0; kt < nk; ++kt) {
        asm volatile("s_waitcnt vmcnt(0)" ::: "memory");
        __syncthreads();
        if (kt + 1 < nk) stage((kt + 1) & 1, (kt + 1) * 64);
        hook(kt, acc);
        const LAS unsigned char* bs = lds + (kt & 1) * 32768;
#pragma unroll
        for (int ks = 0; ks < 2; ++ks) {
            bf16x8 xa[MI], wb[NI];
#pragma unroll
            for (int i = 0; i < MI; ++i) xa[i] = *(const LAS bf16x8*)(bs + (aoff ^ (ks << 6)) + i * 2048);
#pragma unroll
            for (int i = 0; i < NI; ++i) wb[i] = *(const LAS bf16x8*)(bs + (boff ^ (ks << 6)) + i * 2048);
#pragma unroll
            for (int mi = 0; mi < MI; ++mi)
#pragma unroll
                for (int ni = 0; ni < NI; ++ni) acc[mi][ni] = __builtin_amdgcn_mfma_f32_16x16x32_bf16(wb[ni], xa[mi], acc[mi][ni], 0, 0, 0);
        }
    }
    epi(acc, wm, wn, lr, lq);
}

template <int MI, int NI, class RowA, class RowB, class Epi>
__device__ __forceinline__ void gemm_tile32(const RowA& ra, const RowB& rb, int K, bf16_t* smem, const Epi& epi) {
    LAS unsigned char* lds = (LAS unsigned char*)smem;
    const int tid = otid(), lane = tid & 63, w = __builtin_amdgcn_readfirstlane(tid >> 6), wm = w >> 1, wn = w & 1, lr = lane & 15, lq = lane >> 4;
    constexpr int ABYTES = MI * 32 * 64, STG = (MI + NI) * 32 * 64, PA = MI / 2, PB = NI / 2;
    f32x4 acc[MI][NI];
#pragma unroll
    for (int i = 0; i < MI; ++i)
#pragma unroll
        for (int j = 0; j < NI; ++j) acc[i][j] = (f32x4){0.f, 0.f, 0.f, 0.f};
    const bf16_t* pa[PA]; const bf16_t* pb[PB];
    const int kcs = ((lane & 3) ^ ((4 - ((lane >> 4) & 3)) & 3)) * 8;
#pragma unroll
    for (int i = 0; i < PA; ++i) pa[i] = ra((i * 4 + w) * 16 + (lane >> 2)) + kcs;
#pragma unroll
    for (int i = 0; i < PB; ++i) pb[i] = rb((i * 4 + w) * 16 + (lane >> 2)) + kcs;
    auto stage = [&](int buf, int k0) {
#pragma unroll
        for (int i = 0; i < PA; ++i) __builtin_amdgcn_global_load_lds((const unsigned*)(pa[i] + k0), (LAS unsigned*)(lds + buf * STG + (i * 4 + w) * 1024), 16, 0, 0);
#pragma unroll
        for (int i = 0; i < PB; ++i) __builtin_amdgcn_global_load_lds((const unsigned*)(pb[i] + k0), (LAS unsigned*)(lds + buf * STG + ABYTES + (i * 4 + w) * 1024), 16, 0, 0);
    };
    const int fsw = (lq ^ ((4 - ((lr >> 2) & 3)) & 3)) << 4;
    const int aoff = (wm * MI * 16 + lr) * 64 + fsw, boff = ABYTES + (wn * NI * 16 + lr) * 64 + fsw;
    const int nk = K >> 5;
    __syncthreads();
    stage(0, 0);
    for (int kt = 0; kt < nk; ++kt) {
        asm volatile("s_waitcnt vmcnt(0)" ::: "memory");
        __syncthreads();
        if (kt + 1 < nk) stage((kt + 1) & 1, (kt + 1) * 32);
        const LAS unsigned char* bs = lds + (kt & 1) * STG;
        bf16x8 xa[MI], wb[NI];
#pragma unroll
        for (int i = 0; i < MI; ++i) xa[i] = *(const LAS bf16x8*)(bs + aoff + i * 1024);
#pragma unroll
        for (int i = 0; i < NI; ++i) wb[i] = *(const LAS bf16x8*)(bs + boff + i * 1024);
#pragma unroll
        for (int mi = 0; mi < MI; ++mi)
#pragma unroll
            for (int ni = 0; ni < NI; ++ni) acc[mi][ni] = __builtin_amdgcn_mfma_f32_16x16x32_bf16(wb[ni], xa[mi], acc[mi][ni], 0, 0, 0);
    }
    epi(acc, wm, wn, lr, lq);
}

struct RowLin { const bf16_t* base; long ld; __device__ __forceinline__ const bf16_t* operator()(int r) const { return base + (long)r * ld; } };

__device__ __forceinline__ void b_inproj(const P& p, int l, int vb, bf16_t* smem) {
    const int mt = vb / (PCW / 128), nt = vb % (PCW / 128);
    RowLin ra{p.H + (long)mt * 128 * D, D}, rb{p.WT_IN + ((long)l * PCW + nt * 128) * D, D};
    unit_wait_nf(sync_ctr(p, l, SY_N1, mt), 8u);
    if (nt == 20) {
        auto epi_dt = [&](const f32x4 (&acc)[4][1], int wm, int wn, int lr, int lq) {
            if (wn == 0) {
#pragma unroll
                for (int mi = 0; mi < 4; ++mi) *(f32x4*)(p.DT + (long)(mt * 128 + wm * 64 + mi * 16 + lr) * 16 + lq * 4) = acc[mi][0];
            }
        };
        gemm_tile<4, 1>(ra, rb, D, smem, epi_dt);
        return;
    }
    const bool latent = mt < NLAT / 128;
    const int kind = (nt == 20) ? 3 : (nt == 3 || nt == 18 || nt == 19) ? 2 : (latent && nt <= 2) ? 0 : (latent && nt >= 14 && nt <= 17) ? 1 : 4;
    constexpr int OS = 136;
    auto epi = [&](f32x4 (&acc)[4][4], int wm, int wn, int lr, int lq) {
        if (kind == 3) {
            if (wn == 0) {
#pragma unroll
                for (int mi = 0; mi < 4; ++mi) *(f32x4*)(p.DT + (long)(mt * 128 + wm * 64 + mi * 16 + lr) * 16 + lq * 4) = acc[mi][0];
            }
            return;
        }
        if (nt == 2 || nt == 16 || nt == 17) {
            const int b = latent ? mt / (L / 128) : (mt - NLAT / 128) / (LC / 128);
#pragma unroll
            for (int half = 0; half < 2; ++half) {
                float mxv = 0.f;
#pragma unroll
                for (int mi = 0; mi < 4; ++mi) {
                    float ssq = 0.f;
#pragma unroll
                    for (int n2 = 0; n2 < 2; ++n2)
#pragma unroll
                        for (int e = 0; e < 4; ++e) { const float v = acc[mi][2 * half + n2][e]; ssq += v * v; }
                    ssq += __shfl_xor(ssq, 16); ssq += __shfl_xor(ssq, 32);
                    mxv = fmaxf(mxv, ssq);
                }
                if (nt == 2) {
                    const float other = mxv;
                    (void)other;
                }
                if (nt != 2) {
#pragma unroll
                    for (int o = 1; o < 16; o <<= 1) mxv = fmaxf(mxv, __shfl_xor(mxv, o));
                    if ((otid() & 63) == 0) atomicMax(&p.KMAX[((l * NB + b) * 10 + (nt - 16) * 4 + wn * 2 + half) * 32], __float_as_uint(mxv));
                }
            }
            if (nt == 2) {
                float mxv = 0.f;
#pragma unroll
                for (int mi = 0; mi < 4; ++mi) {
                    float ssq = 0.f;
#pragma unroll
                    for (int ni = 0; ni < 4; ++ni)
#pragma unroll
                        for (int e = 0; e < 4; ++e) { const float v = acc[mi][ni][e]; ssq += v * v; }
                    ssq += __shfl_xor(ssq, 16); ssq += __shfl_xor(ssq, 32);
                    mxv = fmaxf(mxv, ssq);
                }
#pragma unroll
                for (int o = 1; o < 16; o <<= 1) mxv = fmaxf(mxv, __shfl_xor(mxv, o));
                if ((otid() & 63) == 0) atomicMax(&p.KMAX[((l * NB + b) * 10 + 8 + wn) * 32], __float_as_uint(mxv));
            }
        }
        if (kind == 0) {
#pragma unroll
            for (int mi = 0; mi < 4; ++mi) {
                const int i = (mt * 128 + wm * 64 + mi * 16 + lr) & (L - 1);
#pragma unroll
                for (int hf = 0; hf < 2; ++hf) {
                    const int pos = hf ? (i & 63) : (i >> 6);
                    const float* tb = p.ROPE + (pos * 24 + lq * 4) * 2;
                    const f32x4 t0 = *(const f32x4*)tb, t1 = *(const f32x4*)(tb + 4);
                    const float cs[4] = {t0[0], t0[2], t1[0], t1[2]}, sn[4] = {t0[1], t0[3], t1[1], t1[3]};
#pragma unroll
                    for (int e = 0; e < 4; ++e) {
                        const float u1 = acc[mi][2 * hf][e], u2 = acc[mi][2 * hf + 1][e];
                        acc[mi][2 * hf][e] = u1 * cs[e] - u2 * sn[e]; acc[mi][2 * hf + 1][e] = u1 * sn[e] + u2 * cs[e];
                    }
                }
            }
        } else if (kind == 1) {
#pragma unroll
            for (int mi = 0; mi < 4; ++mi) {
                const int i = (mt * 128 + wm * 64 + mi * 16 + lr) & (L - 1);
#pragma unroll
                for (int hf = 0; hf < 2; ++hf) {
                    const int pos = hf ? (i & 63) : (i >> 6);
                    const float* tb = p.ROPE + (pos * 24 + 16 + (lq & 1) * 4) * 2;
                    const f32x4 t0 = *(const f32x4*)tb, t1 = *(const f32x4*)(tb + 4);
                    const float cs[4] = {t0[0], t0[2], t1[0], t1[2]}, sn[4] = {t0[1], t0[3], t1[1], t1[3]};
#pragma unroll
                    for (int n2 = 0; n2 < 2; ++n2) {
                        const int ni = 2 * n2 + hf;
#pragma unroll
                        for (int e = 0; e < 4; ++e) {
                            const float v = acc[mi][ni][e], pv = __shfl_xor(v, 32);
                            acc[mi][ni][e] = lq < 2 ? v * cs[e] - pv * sn[e] : pv * sn[e] + v * cs[e];
                        }
                    }
                }
            }
        }
        __syncthreads();
        if (kind == 2) {
#pragma unroll
            for (int mi = 0; mi < 4; ++mi) {
                const int m = wm * 64 + mi * 16 + lr, mp = (m & ~12) | ((m & 4) << 1) | ((m & 8) >> 1);
#pragma unroll
                for (int ni = 0; ni < 4; ++ni)
#pragma unroll
                    for (int e = 0; e < 4; ++e) smem[(wn * 64 + ni * 16 + lq * 4 + e) * OS + mp] = f2bf(acc[mi][ni][e]);
            }
        } else {
#pragma unroll
            for (int mi = 0; mi < 4; ++mi)
#pragma unroll
                for (int ni = 0; ni < 4; ++ni) {
                    const f32x4 a = acc[mi][ni];
                    uint2 o; o.x = pack_bf16(a[0], a[1]); o.y = pack_bf16(a[2], a[3]);
                    *(uint2*)(smem + (wm * 64 + mi * 16 + lr) * OS + wn * 64 + ni * 16 + lq * 4) = o;
                }
        }
        __syncthreads();
        const int tid = otid();
        if (kind == 2) {
            const int nh = nt == 3 ? 2 : 4, hbase = nt == 3 ? 0 : (nt - 18) * 2;
            bf16_t* vtb = nt == 3 ? p.VTA : p.VT;
            const int b = latent ? mt / (L / 128) : (mt - NLAT / 128) / (LC / 128);
            const int key0 = latent ? (mt % (L / 128)) * 128 : L + ((mt - NLAT / 128) % (LC / 128)) * 128;
#pragma unroll
            for (int i2 = 0; i2 < 8; ++i2) {
                const int idx = tid + i2 * 256, n = idx >> 4, mc = (idx & 15) * 8;
                const u32x4 v = *(const u32x4*)(smem + n * OS + mc);
                *(u32x4*)(vtb + ((long)(b * nh + hbase + (n >> 6)) * 64 + (n & 63)) * NKEY + key0 + mc) = v;
            }
        } else {
            bf16_t* out = p.PROJ + (long)mt * 128 * PC + nt * 128;
#pragma unroll
            for (int i2 = 0; i2 < 8; ++i2) {
                const int idx = tid + i2 * 256, m = idx >> 4, nc = (idx & 15) * 8;
                *(u32x4*)(out + (long)m * PC + nc) = *(const u32x4*)(smem + m * OS + nc);
            }
        }
    };
    gemm_tile(ra, rb, D, smem, epi);
}

template <int MI, int NI>
__device__ __forceinline__ void b_outproj(const P& p, int l, int row0, int col0, bf16_t* smem) {
    RowLin ra{p.MIXO + (long)row0 * D, D}, rb{p.WT_OUT + ((long)l * D + col0) * D, D};
    auto epi = [&](const f32x4 (&acc)[MI][NI], int wm, int wn, int lr, int lq) {
#pragma unroll
        for (int mi = 0; mi < MI; ++mi) {
            const int tok = row0 + wm * MI * 16 + mi * 16 + lr;
            const float* g1 = p.MOD + ((long)l * 5 + tok_modrow(tok)) * 6 * D + 2 * D;
#pragma unroll
            for (int ni = 0; ni < NI; ++ni) {
                const int n = col0 + wn * NI * 16 + ni * 16 + lq * 4;
                const float4 g = *(const float4*)(g1 + n);
                float4* xp = (float4*)(p.X + (long)tok * D + n);
                float4 xv = *xp; const f32x4 a = acc[mi][ni];
                xv.x += g.x * a[0]; xv.y += g.y * a[1]; xv.z += g.z * a[2]; xv.w += g.w * a[3];
                *xp = xv;
            }
        }
    };
    float rs0[MI], rs1[MI];
    {
        const int lane = otid() & 63, w = otid() >> 6, wm0 = w >> 1, lr0 = lane & 15;
#pragma unroll
        for (int mi = 0; mi < MI; ++mi) {
            const float* sq = p.SSQ + (long)(row0 + wm0 * MI * 16 + mi * 16 + lr0) * 8;
            const f32x4 s0 = *(const f32x4*)sq, s1 = *(const f32x4*)(sq + 4);
            rs0[mi] = rsqrtf(((s0[0] + s0[1]) + (s0[2] + s0[3])) * (1.f / 256.f) + EPS); rs1[mi] = rsqrtf(((s1[0] + s1[1]) + (s1[2] + s1[3])) * (1.f / 256.f) + EPS);
        }
    }
    auto hook = [&](int kt, f32x4 (&acc)[MI][NI]) {
        if (kt == 4 || kt == 8 || kt == 12) {
#pragma unroll
            for (int mi = 0; mi < MI; ++mi) {
                const float f = kt == 4 ? 1.f / rs0[mi] : kt == 8 ? rs0[mi] / rs1[mi] : rs1[mi];
#pragma unroll
                for (int ni = 0; ni < NI; ++ni) acc[mi][ni] *= f;
            }
        }
    };
    gemm_tile<MI, NI>(ra, rb, D, smem, epi, hook);
}


__device__ __forceinline__ void b_attnC(const P& p, int l, int unit, bf16_t* smem) {
    const int tid = otid(), lane = tid & 63, w = tid >> 6, c = lane & 31, h = lane >> 5;
    const bool ctxq = unit >= NB * 4 * (L / 128);
    int b, hh, qb;
    if (!ctxq) { qb = unit & 31; hh = (unit >> 5) & 3; b = unit >> 7; }
    else { const int u = unit - NB * 4 * (L / 128); qb = u & 1; hh = (u >> 1) & 3; b = u >> 3; }
    const int tokq = (ctxq ? NLAT + b * LC : b * L) + qb * 128 + w * 32 + c;
    const int t0 = ctxq ? 64 : 0, nt = ctxq ? 4 : NKT;
    const float lambda_init = 0.8f - 0.6f * expf(-0.3f * (float)l);
    const float* cl = p.c_lambda + l * 128;
    const float d1 = wave_sum(h == 0 ? cl[c] * cl[32 + c] : 0.f), d2 = wave_sum(h == 0 ? cl[64 + c] * cl[96 + c] : 0.f);
    const float lam = expf(d1) - expf(d2) + lambda_init;
    bf16x8 qf[2][2];
    {
        const float qs = 0.17677669529663687f * 1.4426950408889634f;
        const bf16_t* qp = p.PROJ + (long)tokq * PC + P_CQ + hh * 64;
#pragma unroll
        for (int m = 0; m < 2; ++m)
#pragma unroll
            for (int s2 = 0; s2 < 2; ++s2) {
                const u32x4 raw = *(const u32x4*)(qp + m * 32 + s2 * 16 + h * 8);
                u32x4 sc;
#pragma unroll
                for (int e = 0; e < 4; ++e) sc[e] = pack_bf16(bf2f((bf16_t)(raw[e] & 0xffff)) * qs, bf2f((bf16_t)(raw[e] >> 16)) * qs);
                qf[m][s2] = __builtin_bit_cast(bf16x8, sc);
            }
    }
    LAS unsigned char* lds = (LAS unsigned char*)smem;
    const bf16_t* vtb = p.VT + (long)(b * 4 + hh) * 64 * NKEY;
    const int wu = __builtin_amdgcn_readfirstlane(w);
    int srow[2], schk[2];
#pragma unroll
    for (int i = 0; i < 2; ++i) { srow[i] = (wu * 2 + i) * 8 + (lane >> 3); schk[i] = ((lane & 7) ^ ((srow[i] >> 1) & 7)) * 8; }
    auto dma = [&](int buf, int t) {
        const int tok0 = t < 64 ? b * L + t * 64 : NLAT + b * LC + (t - 64) * 64;
#pragma unroll
        for (int i = 0; i < 2; ++i) {
            __builtin_amdgcn_global_load_lds((const unsigned*)(p.PROJ + (long)(tok0 + srow[i]) * PC + P_CK + hh * 64 + schk[i]), (LAS unsigned*)(lds + buf * 16384 + (wu * 2 + i) * 1024), 16, 0, 0);
            __builtin_amdgcn_global_load_lds((const unsigned*)(vtb + (long)srow[i] * NKEY + t * 64 + schk[i]), (LAS unsigned*)(lds + buf * 16384 + 8192 + (wu * 2 + i) * 1024), 16, 0, 0);
        }
    };
    f32x16 o[2][2];
#pragma unroll
    for (int m = 0; m < 2; ++m)
#pragma unroll
        for (int dt = 0; dt < 2; ++dt)
#pragma unroll
            for (int e = 0; e < 16; ++e) o[m][dt][e] = 0.f;
    float negm[2];
    float lsum[2] = {0.f, 0.f};
#pragma unroll
    for (int m = 0; m < 2; ++m) {
        float qn = 0.f;
#pragma unroll
        for (int s2 = 0; s2 < 2; ++s2) { const u32x4 qq = __builtin_bit_cast(u32x4, qf[m][s2]);
#pragma unroll
            for (int e = 0; e < 4; ++e) { const float a = bf2f((bf16_t)(qq[e] & 0xffff)), bq = bf2f((bf16_t)(qq[e] >> 16)); qn += a * a + bq * bq; } }
        qn += __shfl_xor(qn, 32);
        const float km = __uint_as_float(p.KMAX[((l * NB + b) * 10 + hh * 2 + m) * 32]);
        negm[m] = -sqrtf(qn * km);
    }
    f32x16 negv;
    { const float nm = fminf(negm[0], negm[1]);
#pragma unroll
      for (int e = 0; e < 16; ++e) negv[e] = nm; }
    const int swz = (c >> 1) & 7;
    const int krow = c * 128, fo0 = ((0 + h) ^ swz) << 4, fo1 = ((2 + h) ^ swz) << 4, fo2 = ((4 + h) ^ swz) << 4, fo3 = ((6 + h) ^ swz) << 4;
    __syncthreads();
    dma(0, t0);
    for (int it = 0; it < nt; ++it) {
        asm volatile("s_waitcnt vmcnt(0)" ::: "memory");
        __syncthreads();
        if (it + 1 < nt) dma((it + 1) & 1, t0 + it + 1);
        const LAS unsigned char* Ks = lds + (it & 1) * 16384; const LAS unsigned char* Vs = Ks + 8192;
        auto qk = [&](int sub, int m) -> f32x16 {
            const LAS unsigned char* kr = Ks + sub * 4096 + krow;
            const bf16x8 k0 = *(const LAS bf16x8*)(kr + (m ? fo2 : fo0)), k1 = *(const LAS bf16x8*)(kr + (m ? fo3 : fo1));
            const f32x16 sa = __builtin_amdgcn_mfma_f32_32x32x16_bf16(k0, qf[m][0], negv, 0, 0, 0);
            return __builtin_amdgcn_mfma_f32_32x32x16_bf16(k1, qf[m][1], sa, 0, 0, 0);
        };
        f32x16 sa = qk(0, 0);
        bf16x8 vf[2][2];
#pragma unroll
        for (int j = 0; j < 4; ++j) {
            const int sub = j >> 1, m = j & 1;
            if (m == 0) {
#pragma unroll
                for (int dt = 0; dt < 2; ++dt) {
                    const LAS unsigned char* vr = Vs + dt * 4096 + krow;
                    vf[dt][0] = *(const LAS bf16x8*)(vr + (sub ? fo2 : fo0)); vf[dt][1] = *(const LAS bf16x8*)(vr + (sub ? fo3 : fo1));
                }
            }
            f32x16 san;
            if (j < 3) san = qk((j + 1) >> 1, (j + 1) & 1);
            float ps = 0.f;
            u32x4 a0, a1;
#pragma unroll
            for (int e = 0; e < 4; ++e) {
                const float p0 = __builtin_amdgcn_exp2f(sa[2 * e]), p1 = __builtin_amdgcn_exp2f(sa[2 * e + 1]);
                const float p2 = __builtin_amdgcn_exp2f(sa[8 + 2 * e]), p3 = __builtin_amdgcn_exp2f(sa[8 + 2 * e + 1]);
                ps = (((ps + p0) + p1) + p2) + p3;
                a0[e] = pack_bf16(p0, p1); a1[e] = pack_bf16(p2, p3);
            }
            lsum[m] += ps; asm volatile("" : "+v"(lsum[m]));
            const bf16x8 pk0 = __builtin_bit_cast(bf16x8, a0), pk1 = __builtin_bit_cast(bf16x8, a1);
#pragma unroll
            for (int dt = 0; dt < 2; ++dt) {
                o[m][dt] = __builtin_amdgcn_mfma_f32_32x32x16_bf16(vf[dt][0], pk0, o[m][dt], 0, 0, 0);
                o[m][dt] = __builtin_amdgcn_mfma_f32_32x32x16_bf16(vf[dt][1], pk1, o[m][dt], 0, 0, 0);
            }
            if (j < 3) sa = san;
            __builtin_amdgcn_sched_barrier(0);
        }
    }
    __syncthreads();
    const float l0 = lsum[0] + __shfl_xor(lsum[0], 32), l1 = lsum[1] + __shfl_xor(lsum[1], 32);
    const float c0 = 1.f / l0, c1 = -lam / l1;
    float ss = 0.f;
#pragma unroll
    for (int dt = 0; dt < 2; ++dt)
#pragma unroll
        for (int e = 0; e < 16; ++e) { const float v = o[0][dt][e] * c0 + o[1][dt][e] * c1; o[0][dt][e] = v; ss += v * v; }
    ss += __shfl_xor(ss, 32);
    const float r = rsqrtf(ss * (1.f / 64.f) + EPS) * (1.f - lambda_init);
    bf16_t* op = p.MIXO + (long)tokq * D + 768 + hh * 64;
    int lw = l * 64; asm volatile("" : "+v"(lw));
#pragma unroll
    for (int dt = 0; dt < 2; ++dt)
#pragma unroll
        for (int g = 0; g < 4; ++g) {
            const int dv = dt * 32 + 8 * g + 4 * h;
            const float4 wv = *(const float4*)(p.c_subln_w + lw + dv);
            uint2 ov; ov.x = pack_bf16(o[0][dt][4 * g + 0] * r * wv.x, o[0][dt][4 * g + 1] * r * wv.y);
            ov.y = pack_bf16(o[0][dt][4 * g + 2] * r * wv.z, o[0][dt][4 * g + 3] * r * wv.w);
            *(uint2*)(op + dv) = ov;
        }
}


__device__ __forceinline__ void b_attnA(const P& p, int l, int unit, bf16_t* smem) {
    const int tid = otid(), lane = tid & 63, w = tid >> 6, c = lane & 31, h = lane >> 5;
    const bool ctxq = unit >= NB * 4 * (L / 128);
    int b, hd, qb;
    if (!ctxq) { qb = unit & 31; hd = (unit >> 5) & 3; b = unit >> 7; }
    else { const int u = unit - NB * 4 * (L / 128); qb = u & 1; hd = (u >> 1) & 3; b = u >> 3; }
    const int kvh = hd >> 1;
    const int q0 = qb * 128 + w * 32, iq = q0 + c;
    const int tokq = (ctxq ? NLAT + b * LC : b * L) + iq;
    const int tl0 = ctxq ? 0 : max(0, 2 * qb - 2), tl1 = ctxq ? -1 : min(63, 2 * qb + 3), nloc = tl1 - tl0 + 1, nt = nloc + 4;
    bf16x8 qf[4];
    {
        const float qs = 0.125f * 1.4426950408889634f;
        const bf16_t* qp = p.PROJ + (long)tokq * PC + P_AQ + hd * 64;
#pragma unroll
        for (int s2 = 0; s2 < 4; ++s2) {
            const u32x4 raw = *(const u32x4*)(qp + s2 * 16 + h * 8);
            u32x4 sc;
#pragma unroll
            for (int e = 0; e < 4; ++e) sc[e] = pack_bf16(bf2f((bf16_t)(raw[e] & 0xffff)) * qs, bf2f((bf16_t)(raw[e] >> 16)) * qs);
            qf[s2] = __builtin_bit_cast(bf16x8, sc);
        }
    }
    const bf16_t* vtb = p.VTA + (long)(b * 2 + kvh) * 64 * NKEY;
    const int srow0 = tid >> 3, sch = (tid & 7) * 8;
    u32x4 rk[2], rv[2];
    auto tile_of = [&](int it) { return it < nloc ? tl0 + it : 64 + (it - nloc); };
    auto gload = [&](int t) {
        const int tok0 = t < 64 ? b * L + t * 64 : NLAT + b * LC + (t - 64) * 64;
#pragma unroll
        for (int i = 0; i < 2; ++i) {
            rk[i] = *(const u32x4*)(p.PROJ + (long)(tok0 + srow0 + i * 32) * PC + P_AK + kvh * 64 + sch);
            rv[i] = *(const u32x4*)(vtb + (long)(srow0 + i * 32) * NKEY + t * 64 + sch);
        }
    };
    auto lstore = [&](int buf) {
        bf16_t* Ks = smem + buf * (2 * 64 * 72); bf16_t* Vs = Ks + 64 * 72;
#pragma unroll
        for (int i = 0; i < 2; ++i) { *(u32x4*)(Ks + (srow0 + i * 32) * 72 + sch) = rk[i]; *(u32x4*)(Vs + (srow0 + i * 32) * 72 + sch) = rv[i]; }
    };
    f32x16 o[2];
#pragma unroll
    for (int dt = 0; dt < 2; ++dt)
#pragma unroll
        for (int e = 0; e < 16; ++e) o[dt][e] = 0.f;
    f32x16 negm; float lsum;
    {
        float qn = 0.f;
#pragma unroll
        for (int s2 = 0; s2 < 4; ++s2) { const u32x4 qq = __builtin_bit_cast(u32x4, qf[s2]);
#pragma unroll
            for (int e = 0; e < 4; ++e) { const float a = bf2f((bf16_t)(qq[e] & 0xffff)), bq = bf2f((bf16_t)(qq[e] >> 16)); qn += a * a + bq * bq; } }
        qn += __shfl_xor(qn, 32);
        const float km = __uint_as_float(p.KMAX[((l * NB + b) * 10 + 8 + kvh) * 32]);
        const float sk = p.a_sink[l * 4 + hd] * 1.4426950408889634f;
        const float mb = fmaxf(sqrtf(qn * km), sk);
#pragma unroll
        for (int e = 0; e < 16; ++e) negm[e] = -mb;
        lsum = h == 0 ? __builtin_amdgcn_exp2f(sk - mb) : 0.f;
    }
    __syncthreads();
    gload(tile_of(0)); lstore(0);
    __syncthreads();
    for (int it = 0; it < nt; ++it) {
        if (it + 1 < nt) gload(tile_of(it + 1));
        const int t = tile_of(it);
        const bool local = t < 64;
        const bf16_t* Ks = smem + (it & 1) * (2 * 64 * 72); const bf16_t* Vs = Ks + 64 * 72;
#pragma unroll
        for (int sub = 0; sub < 2; ++sub) {
            const int j0 = t * 64 + sub * 32;
            if (local && (j0 + 31 < q0 - 128 || j0 > q0 + 31 + 128)) continue;
            f32x16 sa = negm;
#pragma unroll
            for (int s2 = 0; s2 < 4; ++s2) {
                const bf16x8 kf = *(const bf16x8*)(Ks + (sub * 32 + c) * 72 + s2 * 16 + h * 8);
                sa = __builtin_amdgcn_mfma_f32_32x32x16_bf16(kf, qf[s2], sa, 0, 0, 0);
            }
            if (local) {
#pragma unroll
                for (int e = 0; e < 16; ++e) { const int j = j0 + 8 * (e >> 2) + 4 * h + (e & 3); const int dj = j - iq; if (dj > 128 || dj < -128) sa[e] = -INFINITY; }
            }
            float ps = 0.f;
            u32x4 a0, a1;
#pragma unroll
            for (int e = 0; e < 4; ++e) {
                const float p0 = __builtin_amdgcn_exp2f(sa[2 * e]), p1 = __builtin_amdgcn_exp2f(sa[2 * e + 1]);
                const float p2 = __builtin_amdgcn_exp2f(sa[8 + 2 * e]), p3 = __builtin_amdgcn_exp2f(sa[8 + 2 * e + 1]);
                ps += (p0 + p1) + (p2 + p3);
                a0[e] = pack_bf16(p0, p1); a1[e] = pack_bf16(p2, p3);
            }
            lsum += ps;
            const bf16x8 pk0 = __builtin_bit_cast(bf16x8, a0), pk1 = __builtin_bit_cast(bf16x8, a1);
#pragma unroll
            for (int dt = 0; dt < 2; ++dt) {
                const bf16x8 v0 = *(const bf16x8*)(Vs + (dt * 32 + c) * 72 + sub * 32 + h * 8);
                const bf16x8 v1 = *(const bf16x8*)(Vs + (dt * 32 + c) * 72 + sub * 32 + 16 + h * 8);
                o[dt] = __builtin_amdgcn_mfma_f32_32x32x16_bf16(v0, pk0, o[dt], 0, 0, 0);
                o[dt] = __builtin_amdgcn_mfma_f32_32x32x16_bf16(v1, pk1, o[dt], 0, 0, 0);
            }
        }
        if (it + 1 < nt) lstore((it + 1) & 1);
        __syncthreads();
    }
    const float inv = 1.f / (lsum + __shfl_xor(lsum, 32));
    bf16_t* op = p.MIXO + (long)tokq * D + hd * 64;
#pragma unroll
    for (int dt = 0; dt < 2; ++dt)
#pragma unroll
        for (int g = 0; g < 4; ++g) {
            uint2 ov; ov.x = pack_bf16(o[dt][4 * g + 0] * inv, o[dt][4 * g + 1] * inv); ov.y = pack_bf16(o[dt][4 * g + 2] * inv, o[dt][4 * g + 3] * inv);
            *(uint2*)(op + dt * 32 + 8 * g + 4 * h) = ov;
        }
}

constexpr int NCH = 34;
constexpr int XT_STRIDE = 136;
__device__ __forceinline__ int chunk_tok0(int b, int cc) { return cc < 2 ? NLAT + b * LC + cc * 128 : b * L + (cc - 2) * 128; }
__device__ __forceinline__ float softplusf(float v) { return fmaxf(v, 0.f) + log1pf(expf(-fabsf(v))); }

__device__ __forceinline__ void ssd_dt_cum(const P& p, int l, int tok0, int head, float* cumv, float* dtv) {
    const int lane = otid() & 63, w = otid() >> 6;
    if (w < 2) {
        const int dir = w;
        const float a = -expf(p.a_log[(l * 2 + dir) * 8 + head]), dtb = p.dt_bias[(l * 2 + dir) * 8 + head];
        const int k0 = 2 * lane, k1 = 2 * lane + 1, i0 = dir ? 127 - k0 : k0, i1 = dir ? 127 - k1 : k1;
        const float dt0 = softplusf(p.DT[(long)(tok0 + i0) * 16 + dir * 8 + head] + dtb), dt1 = softplusf(p.DT[(long)(tok0 + i1) * 16 + dir * 8 + head] + dtb);
        const float la0 = dt0 * a, la1 = dt1 * a;
        float sc = la0 + la1;
#pragma unroll
        for (int off = 1; off < 64; off <<= 1) { const float t = __shfl_up(sc, off); if (lane >= off) sc += t; }
        const float excl = sc - (la0 + la1);
        cumv[dir * 128 + i0] = excl + la0; cumv[dir * 128 + i1] = excl + la0 + la1;
        dtv[dir * 128 + i0] = dt0; dtv[dir * 128 + i1] = dt1;
    }
}
__device__ __forceinline__ void ssd_conv_load(const P& p, int tok0, int cpos, int len, int col0, u32x4 (&raw)[8]) {
    const int tid = otid(), ch8 = (tid & 7) * 8, t0 = (tid >> 3) * 4;
#pragma unroll
    for (int r = 0; r < 8; ++r) {
        const int tt = t0 - 2 + r, pos = cpos + tt;
        u32x4 v = (u32x4){0u, 0u, 0u, 0u};
        if (pos >= 0 && pos < len) v = *(const u32x4*)(p.PROJ + (long)(tok0 + tt) * PC + P_BX + col0 + ch8);
        raw[r] = v;
    }
}
template <bool TR>
__device__ __forceinline__ void ssd_conv_apply(const P& p, int l, int col0, const u32x4 (&raw)[8], bf16_t* dst) {
    const int tid = otid(), ch8 = (tid & 7) * 8, t0 = (tid >> 3) * 4;
    float xr[8][8];
#pragma unroll
    for (int r = 0; r < 8; ++r)
#pragma unroll
        for (int e = 0; e < 4; ++e) { xr[r][2 * e] = bf2f((bf16_t)(raw[r][e] & 0xffff)); xr[r][2 * e + 1] = bf2f((bf16_t)(raw[r][e] >> 16)); }
    float acc[4][8];
    { const float4 b0 = *(const float4*)(p.conv_b + l * 768 + col0 + ch8), b1 = *(const float4*)(p.conv_b + l * 768 + col0 + ch8 + 4);
#pragma unroll
      for (int i = 0; i < 4; ++i) { acc[i][0] = b0.x; acc[i][1] = b0.y; acc[i][2] = b0.z; acc[i][3] = b0.w; acc[i][4] = b1.x; acc[i][5] = b1.y; acc[i][6] = b1.z; acc[i][7] = b1.w; } }
#pragma unroll
    for (int tap = 0; tap < 5; ++tap) {
        const float4 w0 = *(const float4*)(p.conv_w + (l * 5 + tap) * 768 + col0 + ch8), w1 = *(const float4*)(p.conv_w + (l * 5 + tap) * 768 + col0 + ch8 + 4);
        const float wv[8] = {w0.x, w0.y, w0.z, w0.w, w1.x, w1.y, w1.z, w1.w};
#pragma unroll
        for (int i = 0; i < 4; ++i)
#pragma unroll
            for (int e = 0; e < 8; ++e) acc[i][e] += wv[e] * xr[i + tap][e];
    }
#pragma unroll
    for (int i = 0; i < 4; ++i) {
        if (TR) {
#pragma unroll
            for (int e = 0; e < 8; ++e) dst[(ch8 + e) * XT_STRIDE + t0 + i] = f2bf(siluf(acc[i][e]));
        } else {
            u32x4 o;
#pragma unroll
            for (int e = 0; e < 4; ++e) o[e] = pack_bf16(siluf(acc[i][2 * e]), siluf(acc[i][2 * e + 1]));
            *(u32x4*)(dst + (t0 + i) * 72 + ch8) = o;
        }
    }
}

__device__ __forceinline__ void b_ssd_states(const P& p, int l, int unit, bf16_t* smem) {
    const int head = unit & 7, cc = (unit >> 3) % NCH, b = unit / (8 * NCH), g = head >> 2;
    const int tok0 = chunk_tok0(b, cc);
    const int tid = otid(), lane = tid & 63, w = tid >> 6, c = lane & 31, h = lane >> 5;
    bf16_t* xT = smem; bf16_t* BT = smem + 64 * XT_STRIDE;
    float* cumv = (float*)(smem + 2 * 64 * XT_STRIDE); float* dtv = cumv + 256; float* wdt = dtv + 256;
    __syncthreads();
    const int cpos = cc < 2 ? cc * 128 : (cc - 2) * 128, slen = cc < 2 ? LC : L;
    {
        u32x4 rx[8], rb[8];
        ssd_conv_load(p, tok0, cpos, slen, head * 64, rx);
        ssd_conv_load(p, tok0, cpos, slen, 512 + g * 64, rb);
        ssd_dt_cum(p, l, tok0, head, cumv, dtv);
        ssd_conv_apply<true>(p, l, head * 64, rx, xT);
        ssd_conv_apply<true>(p, l, 512 + g * 64, rb, BT);
    }
    __syncthreads();
    { const int dir = tid >> 7, t = tid & 127; const float ce = cumv[dir * 128 + (dir ? 0 : 127)];
      wdt[tid] = __expf(ce - cumv[tid]) * dtv[tid];
      if (t == 0) wt_store(&p.DEC[((long)(b * NCH + cc) * 8 + head) * 2 + dir], __expf(ce)); }
    __syncthreads();
    const int dir = w >> 1, pt = w & 1;
    f32x16 acc[2];
#pragma unroll
    for (int nt = 0; nt < 2; ++nt)
#pragma unroll
        for (int e = 0; e < 16; ++e) acc[nt][e] = 0.f;
#pragma unroll
    for (int ks = 0; ks < 8; ++ks) {
        const u32x4 xr = *(const u32x4*)(xT + (pt * 32 + c) * XT_STRIDE + ks * 16 + h * 8);
        const f32x4 w0 = *(const f32x4*)(wdt + dir * 128 + ks * 16 + h * 8), w1 = *(const f32x4*)(wdt + dir * 128 + ks * 16 + h * 8 + 4);
        u32x4 xs;
        xs[0] = pack_bf16(bf2f((bf16_t)(xr[0] & 0xffff)) * w0[0], bf2f((bf16_t)(xr[0] >> 16)) * w0[1]);
        xs[1] = pack_bf16(bf2f((bf16_t)(xr[1] & 0xffff)) * w0[2], bf2f((bf16_t)(xr[1] >> 16)) * w0[3]);
        xs[2] = pack_bf16(bf2f((bf16_t)(xr[2] & 0xffff)) * w1[0], bf2f((bf16_t)(xr[2] >> 16)) * w1[1]);
        xs[3] = pack_bf16(bf2f((bf16_t)(xr[3] & 0xffff)) * w1[2], bf2f((bf16_t)(xr[3] >> 16)) * w1[3]);
        const bf16x8 xa = __builtin_bit_cast(bf16x8, xs);
#pragma unroll
        for (int nt = 0; nt < 2; ++nt) {
            const bf16x8 bb = *(const bf16x8*)(BT + (nt * 32 + c) * XT_STRIDE + ks * 16 + h * 8);
            acc[nt] = __builtin_amdgcn_mfma_f32_32x32x16_bf16(xa, bb, acc[nt], 0, 0, 0);
        }
    }
    float* st = p.ST + (((long)(b * NCH + cc) * 8 + head) * 2 + dir) * 4096;
#pragma unroll
    for (int nt = 0; nt < 2; ++nt)
#pragma unroll
        for (int e = 0; e < 16; ++e) { const int pr = pt * 32 + 8 * (e >> 2) + 4 * h + (e & 3); wt_store(&st[pr * 64 + nt * 32 + c], acc[nt][e]); }
    unit_publish(p.SYNC + (l * 2 + 0) * 32);
}

__device__ __forceinline__ void b_ssd_scan(const P& p, int l, int vb) {
    unit_wait_nf(p.SYNC + (l * 2 + 0) * 32, (unsigned)(NB * NCH * 8));
    const int idx = vb * 256 + otid();
    const int e = idx & 4095, dir = (idx >> 12) & 1, head = (idx >> 13) & 7, b = idx >> 16;
    float stv[NCH], dcv[NCH];
#pragma unroll
    for (int k = 0; k < NCH; ++k) {
        const int cc = dir ? (k < 2 ? 1 - k : 35 - k) : k;
        const long base = ((long)(b * NCH + cc) * 8 + head) * 2 + dir;
        stv[k] = p.ST[base * 4096 + e]; dcv[k] = p.DEC[base];
    }
    float hst = 0.f;
#pragma unroll
    for (int k = 0; k < NCH; ++k) {
        const int cc = dir ? (k < 2 ? 1 - k : 35 - k) : k;
        const long base = ((long)(b * NCH + cc) * 8 + head) * 2 + dir;
        { const float oth = __shfl_xor(hst, 1); if ((e & 1) == 0) wt_store((unsigned*)(p.HS + base * 4096 + e), pack_bf16(hst, oth)); }
        hst = dcv[k] * hst + stv[k];
    }
    unit_publish(p.SYNC + (l * 2 + 1) * 32);
}

__device__ __forceinline__ void b_ssd_out(const P& p, int l, int unit, bf16_t* smem) {
    const int head = unit & 7, cc = (unit >> 3) % NCH, b = unit / (8 * NCH), g = head >> 2;
    const int tok0 = chunk_tok0(b, cc);
    const int tid = otid(), lane = tid & 63, w = tid >> 6, c = lane & 31, h = lane >> 5;
    bf16_t* Cs = smem; bf16_t* Bs = smem + 128 * 72; bf16_t* xT = smem + 2 * 128 * 72;
    float* cumv = (float*)(smem + 2 * 128 * 72 + 64 * XT_STRIDE); float* dtv = cumv + 256;
    __syncthreads();
    const int cpos = cc < 2 ? cc * 128 : (cc - 2) * 128, slen = cc < 2 ? LC : L;
    const int t = 32 * w + c;
    const bf16_t* zp = p.PROJ + (long)(tok0 + t) * PC + P_BZ + head * 64;
    {
        u32x4 rc[8], rb[8], rx[8];
        ssd_conv_load(p, tok0, cpos, slen, 640 + g * 64, rc);
        ssd_conv_load(p, tok0, cpos, slen, 512 + g * 64, rb);
        ssd_dt_cum(p, l, tok0, head, cumv, dtv);
        ssd_conv_apply<false>(p, l, 640 + g * 64, rc, Cs);
        ssd_conv_load(p, tok0, cpos, slen, head * 64, rx);
        ssd_conv_apply<false>(p, l, 512 + g * 64, rb, Bs);
        ssd_conv_apply<true>(p, l, head * 64, rx, xT);
    }
    unit_wait_nf(p.SYNC + (l * 2 + 1) * 32, (unsigned)(NB * 8 * 2 * 4096 / 256));
    bf16x8 cf[4];
#pragma unroll
    for (int ks = 0; ks < 4; ++ks) cf[ks] = *(const bf16x8*)(Cs + t * 72 + ks * 16 + h * 8);
    f32x16 gT[4];
#pragma unroll
    for (int st = 0; st < 4; ++st) {
#pragma unroll
        for (int e = 0; e < 16; ++e) gT[st][e] = 0.f;
#pragma unroll
        for (int ks = 0; ks < 4; ++ks) {
            const bf16x8 bfr = *(const bf16x8*)(Bs + (st * 32 + c) * 72 + ks * 16 + h * 8);
            gT[st] = __builtin_amdgcn_mfma_f32_32x32x16_bf16(bfr, cf[ks], gT[st], 0, 0, 0);
        }
    }
    f32x16 tot[2];
#pragma unroll
    for (int pt = 0; pt < 2; ++pt)
#pragma unroll
        for (int e = 0; e < 16; ++e) tot[pt][e] = 0.f;
#pragma unroll
    for (int dir = 0; dir < 2; ++dir) {
        const float ct = cumv[dir * 128 + t];
        bf16x8 hsf[4][2];
        {
            const bf16_t* hs = p.HS + (((long)(b * NCH + cc) * 8 + head) * 2 + dir) * 4096;
#pragma unroll
            for (int ks = 0; ks < 4; ++ks)
#pragma unroll
                for (int pt = 0; pt < 2; ++pt) hsf[ks][pt] = *(const bf16x8*)(hs + (pt * 32 + c) * 64 + ks * 16 + h * 8);
        }
#pragma unroll
        for (int st = 0; st < 4; ++st) {
            const bool need = dir ? (st >= w) : (st <= w);
            if (need) {
#pragma unroll
                for (int k2 = 0; k2 < 2; ++k2) {
                    float mv[8];
#pragma unroll
                    for (int j = 0; j < 8; ++j) {
                        const int sidx = st * 32 + 16 * k2 + 8 * (j >> 2) + 4 * h + (j & 3);
                        const float cs = cumv[dir * 128 + sidx], ds = dtv[dir * 128 + sidx];
                        const bool ok = (st != w) || (dir ? (sidx >= t) : (sidx <= t));
                        const float arg = ok ? ct - cs : -__builtin_inff();
                        mv[j] = gT[st][8 * k2 + j] * __expf(arg) * ds;
                    }
                    u32x4 pm; pm[0] = pack_bf16(mv[0], mv[1]); pm[1] = pack_bf16(mv[2], mv[3]); pm[2] = pack_bf16(mv[4], mv[5]); pm[3] = pack_bf16(mv[6], mv[7]);
                    const bf16x8 pmb = __builtin_bit_cast(bf16x8, pm);
#pragma unroll
                    for (int pt = 0; pt < 2; ++pt) {
                        const bf16_t* xr = xT + (pt * 32 + c) * XT_STRIDE + st * 32 + 16 * k2 + 4 * h;
                        const uint2 lo = *(const uint2*)xr, hi = *(const uint2*)(xr + 8);
                        const u32x4 xa = (u32x4){lo.x, lo.y, hi.x, hi.y};
                        tot[pt] = __builtin_amdgcn_mfma_f32_32x32x16_bf16(__builtin_bit_cast(bf16x8, xa), pmb, tot[pt], 0, 0, 0);
                    }
                }
            }
        }
        const float et = __expf(ct);
#pragma unroll
        for (int ks = 0; ks < 4; ++ks) {
            const u32x4 cr = __builtin_bit_cast(u32x4, cf[ks]);
            u32x4 cs4;
#pragma unroll
            for (int e = 0; e < 4; ++e) cs4[e] = pack_bf16(bf2f((bf16_t)(cr[e] & 0xffff)) * et, bf2f((bf16_t)(cr[e] >> 16)) * et);
            const bf16x8 cfs = __builtin_bit_cast(bf16x8, cs4);
#pragma unroll
            for (int pt = 0; pt < 2; ++pt) {
                tot[pt] = __builtin_amdgcn_mfma_f32_32x32x16_bf16(hsf[ks][pt], cfs, tot[pt], 0, 0, 0);
            }
        }
    }
    const float dsk = p.d_skip[(l * 2 + 0) * 8 + head] + p.d_skip[(l * 2 + 1) * 8 + head];
    bf16_t* gp = p.MIXO + (long)(tok0 + t) * D + 256 + head * 64;
    uint2 zr[2][4];
#pragma unroll
    for (int pt = 0; pt < 2; ++pt)
#pragma unroll
        for (int gq = 0; gq < 4; ++gq) zr[pt][gq] = *(const uint2*)(zp + pt * 32 + 8 * gq + 4 * h);
    float ss = 0.f;
#pragma unroll
    for (int pt = 0; pt < 2; ++pt)
#pragma unroll
        for (int gq = 0; gq < 4; ++gq) {
            const int p0 = pt * 32 + 8 * gq + 4 * h;
            const uint2 zq = zr[pt][gq];
            const float zv[4] = {bf2f((bf16_t)(zq.x & 0xffff)), bf2f((bf16_t)(zq.x >> 16)), bf2f((bf16_t)(zq.y & 0xffff)), bf2f((bf16_t)(zq.y >> 16))};
            float gv[4];
#pragma unroll
            for (int e = 0; e < 4; ++e) { const float y = tot[pt][4 * gq + e] + bf2f(xT[(p0 + e) * XT_STRIDE + t]) * dsk; gv[e] = y * siluf(zv[e]); ss += gv[e] * gv[e]; }
            uint2 ov; ov.x = pack_bf16(gv[0], gv[1]); ov.y = pack_bf16(gv[2], gv[3]);
            *(uint2*)(gp + p0) = ov;
        }
    ss += __shfl_xor(ss, 32);
    if (h == 0) p.SSQ[(long)(tok0 + t) * 8 + head] = ss;
}

__device__ __forceinline__ void b_norm2r(const P& p, int l, int vb, bf16_t* smem) {
    const int tid = otid(), wave = tid >> 6, lane = tid & 63;
    constexpr int HST = D + 16;
    bf16_t* Hs = smem;
    float* red = (float*)(smem + 16 * HST);
    float* lgs = red + 4 * 16 * 48;
    __syncthreads();
#pragma unroll 1
    for (int i4 = 0; i4 < 4; ++i4) {
        const int tl = wave * 4 + i4, tok = vb * 16 + tl;
        float v[16];
        const float* src = p.X + (long)tok * D;
#pragma unroll
        for (int i = 0; i < 4; ++i) { const float4 t = *(const float4*)(src + i * 256 + lane * 4); v[i * 4 + 0] = t.x; v[i * 4 + 1] = t.y; v[i * 4 + 2] = t.z; v[i * 4 + 3] = t.w; }
        float ss = 0.f;
#pragma unroll
        for (int i = 0; i < 16; ++i) ss += v[i] * v[i];
        ss = wave_sum(ss);
        const float r = rsqrtf(ss * (1.f / D) + EPS);
        const float* m = p.MOD + ((long)l * 5 + tok_modrow(tok)) * 6 * D;
        const float* nw = p.norm2_w + l * D;
        bf16_t* ho = p.H + (long)tok * D;
#pragma unroll
        for (int i = 0; i < 4; ++i) {
            const int k = i * 256 + lane * 4;
            const float4 w4 = *(const float4*)(nw + k), sc = *(const float4*)(m + 4 * D + k), sh = *(const float4*)(m + 3 * D + k);
            uint2 o;
            o.x = pack_bf16(v[i * 4 + 0] * r * w4.x * (1.f + sc.x) + sh.x, v[i * 4 + 1] * r * w4.y * (1.f + sc.y) + sh.y);
            o.y = pack_bf16(v[i * 4 + 2] * r * w4.z * (1.f + sc.z) + sh.z, v[i * 4 + 3] * r * w4.w * (1.f + sc.w) + sh.w);
            *(uint2*)(ho + k) = o;
            *(uint2*)(Hs + tl * HST + k) = o;
        }
    }
    __syncthreads();
    {
        const int lr = lane & 15, lq = lane >> 4;
        const bf16_t* wr = p.WT_R + ((long)l * 128 + lr) * D + wave * 256 + lq * 8;
        const bf16_t* hr = Hs + lr * HST + wave * 256 + lq * 8;
        f32x4 acc[3];
#pragma unroll
        for (int ni = 0; ni < 3; ++ni) acc[ni] = (f32x4){0.f, 0.f, 0.f, 0.f};
#pragma unroll
        for (int half = 0; half < 2; ++half) {
            bf16x8 wb[4][3];
#pragma unroll
            for (int ks = 0; ks < 4; ++ks)
#pragma unroll
                for (int ni = 0; ni < 3; ++ni) wb[ks][ni] = *(const bf16x8*)(wr + (long)ni * 16 * D + (half * 4 + ks) * 32);
#pragma unroll
            for (int ks = 0; ks < 4; ++ks) {
                const bf16x8 xa = *(const bf16x8*)(hr + (half * 4 + ks) * 32);
#pragma unroll
                for (int ni = 0; ni < 3; ++ni) acc[ni] = __builtin_amdgcn_mfma_f32_16x16x32_bf16(wb[ks][ni], xa, acc[ni], 0, 0, 0);
            }
        }
#pragma unroll
        for (int ni = 0; ni < 3; ++ni) *(f32x4*)(red + (wave * 16 + lr) * 48 + ni * 16 + lq * 4) = acc[ni];
    }
    __syncthreads();
#pragma unroll
    for (int i = 0; i < 3; ++i) {
        const int idx = tid + i * 256, t = idx / 48, j = idx % 48;
        lgs[t * 49 + j] = (red[(0 * 16 + t) * 48 + j] + red[(1 * 16 + t) * 48 + j]) + (red[(2 * 16 + t) * 48 + j] + red[(3 * 16 + t) * 48 + j]);
    }
    __syncthreads();
    if (tid < 16) {
        const int tok = vb * 16 + tid;
        const float* lg = lgs + tid * 49;
        int gs = 0; float gm = lg[0];
#pragma unroll
        for (int j = 1; j < 4; ++j) { const float v = lg[j]; if (v > gm) { gm = v; gs = j; } }
        float den = 0.f;
#pragma unroll
        for (int j = 0; j < 4; ++j) den += expf(lg[j] - gm);
        const float gp = 1.f / den;
        float e0 = -3.4e38f, e1 = -3.4e38f; int i0 = 0, i1 = 0;
#pragma unroll
        for (int j = 0; j < 8; ++j) {
            const float val = lg[4 + gs * 8 + j];
            if (val > e0) { e1 = e0; i1 = i0; e0 = val; i0 = j; }
            else if (val > e1) { e1 = val; i1 = j; }
        }
        const float x1 = expf(e1 - e0), w0 = gp / (1.f + x1), w1 = gp * x1 / (1.f + x1);
        const int ex0 = gs * 8 + i0, ex1 = gs * 8 + i1;
        int* cnt = p.cnt + l * NEXP * CPAD;
        const int rk0 = atomicAdd(&cnt[ex0 * CPAD], 1); p.list[(long)ex0 * NTOK + rk0] = tok * 2 + 0; p.gatew[tok * 2 + 0] = w0;
        const int rk1 = atomicAdd(&cnt[ex1 * CPAD], 1); p.list[(long)ex1 * NTOK + rk1] = tok * 2 + 1; p.gatew[tok * 2 + 1] = w1;
    }
}

struct MoeTile { int e, mt, cnt, off; };
__device__ __forceinline__ int moe_row_tiles(const int* cnt) { int t = 0; for (int e = 0; e < NEXP; ++e) t += (cnt[e * CPAD] + 127) >> 7; return t; }
__device__ __forceinline__ MoeTile moe_find_tile(const int* cnt, int tile) {
    MoeTile t; t.e = -1; t.mt = 0; t.cnt = 0; t.off = 0;
    int acc_t = 0, off = 0;
    for (int e = 0; e < NEXP; ++e) {
        const int c = cnt[e * CPAD], nt = (c + 127) >> 7;
        if (t.e < 0 && tile < acc_t + nt) { t.e = e; t.mt = tile - acc_t; t.cnt = c; t.off = off; }
        acc_t += nt; off += c;
    }
    return t;
}
struct RowGather { const bf16_t* base; const int* lst; int n; __device__ __forceinline__ const bf16_t* operator()(int r) const { return base + (long)(lst[r < n ? r : n - 1] >> 1) * D; } };
struct RowLimit { const bf16_t* base; long ld; int n; __device__ __forceinline__ const bf16_t* operator()(int r) const { return base + (long)(r < n ? r : n - 1) * ld; } };
template <int NI> struct RowGateUp { const bf16_t* wg; const bf16_t* wu; __device__ __forceinline__ const bf16_t* operator()(int n) const {
    const int wn = n / (NI * 16), f = (n >> 4) % NI, j = n & 15, col = wn * (NI * 8) + (f % (NI / 2)) * 16 + j; return wg + (long)(f / (NI / 2)) * (wu - wg) + (long)col * D; } };

template <int NI>
__device__ __forceinline__ void b_moe_up(const P& p, int l, int rt, int h0, bf16_t* smem) {
    const MoeTile t = moe_find_tile(p.cnt + l * NEXP * CPAD, rt);
    if (t.e < 0) return;
    const int nrow = min(128, t.cnt - t.mt * 128);
    RowGather ra{p.H, p.list + (long)t.e * NTOK + t.mt * 128, nrow};
    const long wofs = (((long)l * NEXP + t.e) * DEXP + h0) * D;
    RowGateUp<NI> rb{p.WT_G + wofs, p.WT_U + wofs};
    bf16_t* out = p.HID + (long)(t.off + t.mt * 128) * DEXP + h0;
    auto epi = [&](const f32x4 (&acc)[4][NI], int wm, int wn, int lr, int lq) {
#pragma unroll
        for (int mi = 0; mi < 4; ++mi) {
            const int r = wm * 64 + mi * 16 + lr;
            if (r < nrow) {
#pragma unroll
                for (int f = 0; f < NI / 2; ++f) {
                    const f32x4 gt = acc[mi][f], up = acc[mi][NI / 2 + f];
                    float hv[4];
#pragma unroll
                    for (int e = 0; e < 4; ++e) hv[e] = siluf(gt[e]) * up[e];
                    uint2 o; o.x = pack_bf16(hv[0], hv[1]); o.y = pack_bf16(hv[2], hv[3]);
                    *(uint2*)(out + (long)r * DEXP + wn * (NI * 8) + f * 16 + lq * 4) = o;
                }
            }
        }
    };
    if constexpr (NI == 8) gemm_tile32<4, 8>(ra, rb, D, smem, epi); else gemm_tile<4, NI>(ra, rb, D, smem, epi);
}

template <int NI>
__device__ __forceinline__ void b_moe_down(const P& p, int l, int rt, int n0, bf16_t* smem) {
    const MoeTile t = moe_find_tile(p.cnt + l * NEXP * CPAD, rt);
    if (t.e < 0) return;
    const int nrow = min(128, t.cnt - t.mt * 128);
    const int slot0 = t.off + t.mt * 128;
    RowLimit ra{p.HID + (long)slot0 * DEXP, DEXP, nrow};
    RowLin rb{p.WT_D + (((long)l * NEXP + t.e) * D + n0) * DEXP, DEXP};
    const int* lst = p.list + (long)t.e * NTOK + t.mt * 128;
    int asg[4]; float gwv[4];
    {
        const int lane = otid() & 63, w = otid() >> 6;
#pragma unroll
        for (int mi = 0; mi < 4; ++mi) { const int r = (w >> 1) * 64 + mi * 16 + (lane & 15); asg[mi] = lst[r < nrow ? r : nrow - 1]; gwv[mi] = p.gatew[asg[mi]]; }
    }
    auto epi = [&](const f32x4 (&acc)[4][NI], int wm, int wn, int lr, int lq) {
#pragma unroll
        for (int mi = 0; mi < 4; ++mi) {
            const int r = wm * 64 + mi * 16 + lr;
            if (r < nrow) {
                const float gw = gwv[mi];
                if (n0 == 0 && wn == 0 && lq == 0) p.pos[asg[mi]] = slot0 + r;
#pragma unroll
                for (int ni = 0; ni < NI; ++ni) {
                    const int n = n0 + wn * (NI * 16) + ni * 16 + lq * 4;
                    const f32x4 a = acc[mi][ni];
                    uint2 o; o.x = pack_bf16(a[0] * gw, a[1] * gw); o.y = pack_bf16(a[2] * gw, a[3] * gw);
                    *(uint2*)(p.YS + (long)(slot0 + r) * D + n) = o;
                }
            }
        }
    };
    if constexpr (NI == 8) gemm_tile32<4, 8>(ra, rb, DEXP, smem, epi); else gemm_tile<4, NI>(ra, rb, DEXP, smem, epi);
}

__device__ __forceinline__ void b_final(const P& p, int vb) {
    const int wave = otid() >> 6, lane = otid() & 63;
    const int tok = vb * 4 + wave;
    if (tok >= NLAT) return;
    float v[16];
    const float* src = p.X + (long)tok * D;
#pragma unroll
    for (int i = 0; i < 4; ++i) { const float4 t = *(const float4*)(src + i * 256 + lane * 4); v[i * 4 + 0] = t.x; v[i * 4 + 1] = t.y; v[i * 4 + 2] = t.z; v[i * 4 + 3] = t.w; }
    {
        const bf16_t* ys0 = p.YS + (long)p.pos[tok * 2 + 0] * D; const bf16_t* ys1 = p.YS + (long)p.pos[tok * 2 + 1] * D;
        const float* g2 = p.MOD + ((long)(DEPTH - 1) * 5 + tok_modrow(tok)) * 6 * D + 5 * D;
#pragma unroll
        for (int i = 0; i < 4; ++i) {
            const uint2 t = *(const uint2*)(ys0 + i * 256 + lane * 4), u = *(const uint2*)(ys1 + i * 256 + lane * 4);
            const float4 g = *(const float4*)(g2 + i * 256 + lane * 4);
            v[i * 4 + 0] += (bf2f((bf16_t)(t.x & 0xffff)) + bf2f((bf16_t)(u.x & 0xffff))) * g.x; v[i * 4 + 1] += (bf2f((bf16_t)(t.x >> 16)) + bf2f((bf16_t)(u.x >> 16))) * g.y;
            v[i * 4 + 2] += (bf2f((bf16_t)(t.y & 0xffff)) + bf2f((bf16_t)(u.y & 0xffff))) * g.z; v[i * 4 + 3] += (bf2f((bf16_t)(t.y >> 16)) + bf2f((bf16_t)(u.y >> 16))) * g.w;
        }
    }
    float ss = 0.f;
#pragma unroll
    for (int i = 0; i < 16; ++i) ss += v[i] * v[i];
    ss = wave_sum(ss);
    const float r = rsqrtf(ss * (1.f / D) + EPS);
    float* o = p.out + (long)tok * D;
#pragma unroll
    for (int i = 0; i < 4; ++i) { const float4 w = *(const float4*)(p.final_w + i * 256 + lane * 4);
        f32x4 ov; ov[0] = v[i * 4 + 0] * r * w.x; ov[1] = v[i * 4 + 1] * r * w.y; ov[2] = v[i * 4 + 2] * r * w.z; ov[3] = v[i * 4 + 3] * r * w.w;
        __builtin_nontemporal_store(ov, (f32x4*)(o + i * 256 + lane * 4)); }
}


#define XB_TMO      128
#define XB_XCNT(j)  (256  + 64 * (j))
#define XB_XSUB(j)  (1280 + 64 * (j))
#define XB_XGEN(j)  (2304 + 64 * (j))
#define XB_TOP      3328
#define XB_TOPGEN   3392
#define XB_LSUB(j)  (3456 + 64 * (j))
#define XB_LGEN(j)  (3968 + 64 * (j))
#define XCD_BAR_WORDS 4480
#define XB_SPIN_CAP (1u << 22)
__device__ __forceinline__ unsigned xb_ld(unsigned* p)              { return __hip_atomic_load(p, __ATOMIC_RELAXED, __HIP_MEMORY_SCOPE_AGENT); }
__device__ __forceinline__ unsigned xb_add(unsigned* p, unsigned v) { return __hip_atomic_fetch_add(p, v, __ATOMIC_RELAXED, __HIP_MEMORY_SCOPE_AGENT); }
__device__ __forceinline__ unsigned xb_xcc_id() { return (unsigned)__builtin_amdgcn_s_getreg((3 << 11) | 20) & 0xFu; }
#define XB_SPIN(cond, bar) do { unsigned _sp = 0; while (cond) { __builtin_amdgcn_s_sleep(1); \
    if ((++_sp & 255u) == 0u) { if (xb_ld(&(bar)[XB_TMO])) break; if (_sp > XB_SPIN_CAP) { atomicAdd(&(bar)[XB_TMO], 1u); break; } } } } while (0)
struct XcdBarrier { unsigned* bar; unsigned x; volatile LAS unsigned* st; };
__device__ __forceinline__ XcdBarrier xcd_barrier_post(unsigned* bar, volatile LAS unsigned* st) {
    XcdBarrier b; b.bar = bar; b.x = xb_xcc_id(); b.st = st;
    if (threadIdx.x == 0) (void)xb_add(&bar[XB_XCNT(b.x)], 1u);
    return b;
}
__device__ __forceinline__ void xcd_barrier_complete(unsigned* bar, unsigned x, unsigned& nloc, unsigned& nx) {
    const unsigned G = gridDim.x * gridDim.y * gridDim.z;
    unsigned sum, cnt, mine, sp = 0u;
    for (;;) {
        sum = 0u; cnt = 0u; mine = 0u;
#pragma unroll
        for (unsigned j = 0; j < 16; ++j) { const unsigned c = xb_ld(&bar[XB_XCNT(j)]); sum += c; cnt += (c > 0u) ? 1u : 0u; mine = (j == x) ? c : mine; }
        if (sum == G) break;
        __builtin_amdgcn_s_sleep(1);
        if ((++sp & 255u) == 0u) { if (xb_ld(&bar[XB_TMO])) break; if (sp > XB_SPIN_CAP) { atomicAdd(&bar[XB_TMO], 1u); break; } }
    }
    nloc = mine > 0u ? mine : 1u; nx = cnt > 0u ? cnt : 1u;
}
__device__ __forceinline__ void xcd_barrier(const XcdBarrier& b) {
    asm volatile("s_waitcnt vmcnt(0)" ::: "memory");
    __syncthreads();
    if (threadIdx.x == 0) {
        unsigned* bar = b.bar;
        __builtin_amdgcn_s_waitcnt(0);
        unsigned bx = __builtin_amdgcn_readfirstlane(b.x); asm volatile("" : "+s"(bx));
        unsigned nloc = b.st[0], nx = b.st[1];
        if (nloc == 0u) { xcd_barrier_complete(bar, bx, nloc, nx); b.st[0] = nloc; b.st[1] = nx; }
        const unsigned old = xb_add(&bar[XB_XSUB(bx)], 1u);
        const unsigned gen = old / nloc;
        if (old + 1u == (gen + 1u) * nloc) {
            __builtin_amdgcn_fence(__ATOMIC_RELEASE, "agent");
            asm volatile("s_waitcnt vmcnt(0)" ::: "memory");
            const unsigned og = xb_add(&bar[XB_TOP], 1u);
            const unsigned tg = og / nx;
            if (og + 1u == (tg + 1u) * nx) xb_add(&bar[XB_TOPGEN], 1u);
            else XB_SPIN(xb_ld(&bar[XB_TOPGEN]) == tg, bar);
            __builtin_amdgcn_fence(__ATOMIC_ACQUIRE, "agent");
            xb_add(&bar[XB_XGEN(bx)], 1u);
            asm volatile("s_waitcnt vmcnt(0)" ::: "memory");
        } else {
            { const unsigned pos = old - gen * nloc; if (pos == (nloc >> 1) || pos == nloc - (nloc >> 3)) { __builtin_amdgcn_fence(__ATOMIC_RELEASE, "agent"); } }
            XB_SPIN(xb_ld(&bar[XB_XGEN(bx)]) == gen, bar);
            asm volatile("buffer_inv sc0\n\ts_waitcnt vmcnt(0)" ::: "memory");
        }
    }
    __syncthreads();
}

__device__ __forceinline__ void xcd_local_barrier(const XcdBarrier& b) {
    asm volatile("s_waitcnt vmcnt(0)" ::: "memory");
    __syncthreads();
    if (threadIdx.x == 0) {
        unsigned* bar = b.bar;
        __builtin_amdgcn_s_waitcnt(0);
        unsigned bx = __builtin_amdgcn_readfirstlane(b.x); asm volatile("" : "+s"(bx));
        const unsigned nloc = b.st[0];
        const unsigned old = xb_add(&bar[XB_LSUB(bx)], 1u), gen = old / nloc;
        if (old + 1u == (gen + 1u) * nloc) xb_add(&bar[XB_LGEN(bx)], 1u);
        else XB_SPIN(xb_ld(&bar[XB_LGEN(bx)]) == gen, bar);
        asm volatile("buffer_inv sc0\n\ts_waitcnt vmcnt(0)" ::: "memory");
    }
    __syncthreads();
}

#define FOR_VB(n) for (int vb = blockIdx.x; vb < (n); vb += gridDim.x)
#define FOR_VB_XCD(n) for (int _ch = ((n) + 7) >> 3, _j = (int)blockIdx.x >> 3, vb = ((int)blockIdx.x & 7) * _ch + _j; _j < _ch; _j += (int)gridDim.x >> 3, vb += (int)gridDim.x >> 3) if (vb < (n))
#define FOR_VB_OFF(n, off) for (int vb = (int)((blockIdx.x + gridDim.x - ((off) % gridDim.x)) % gridDim.x); vb < (n); vb += gridDim.x)
#define FOR_VB_OFFG(n, off, G) for (int vb = ((int)blockIdx.x < (G)) ? (int)(((int)blockIdx.x + (G) - ((off) % (G))) % (G)) : (n); vb < (n); vb += (G))
__global__ void __launch_bounds__(256, 2) k_mega(P p) {
    extern __shared__ __attribute__((aligned(16))) unsigned char dynlds[];
    bf16_t* smem = (bf16_t*)dynlds;
    uint4* xbw = (uint4*)(dynlds + SMEM_BYTES);
    float (*tt)[65] = (float (*)[65])smem;
    if (threadIdx.x == 0) *xbw = make_uint4(0u, 0u, 0u, 0u);
    __syncthreads();
    const XcdBarrier xb = xcd_barrier_post(p.bar, (volatile LAS unsigned*)xbw);
    if (threadIdx.x == 0) {
        const unsigned key = (xb.x << 8) | ((unsigned)__builtin_amdgcn_s_getreg((7 << 11) | (8 << 6) | 4) & 0xFFu);
        ((volatile LAS unsigned*)xbw)[4] = xb_add(&p.cuslot[key], 1u) & 1u;
    }
    __syncthreads();
    const int slot = __builtin_amdgcn_readfirstlane((int)((volatile LAS unsigned*)xbw)[4]);
    if (threadIdx.x == 0 && ((unsigned)blockIdx.x & 7u) == xb.x) (void)xb_add(&p.cuslot[2048], 1u);
    if (blockIdx.x == 0 && otid() < DEPTH * NEXP) p.cnt[otid() * CPAD] = 0;
    if (blockIdx.x == 1 && otid() < DEPTH * NB * 10) p.KMAX[otid() * 32] = 0u;
    if (blockIdx.x == 2) for (int i = otid(); i < SY_LAYER + DEPTH * SY_STRIDE; i += 256) p.SYNC[i] = 0u;
    FOR_VB(6) b_rope_table(p, vb);
    FOR_VB_OFF(DEPTH * 6 * D / 64, 128) b_mod(p, vb, (float*)smem);
    __syncthreads();
    constexpr int CI1 = 28 * 16 / 4, CI2 = 12 * 16 / 4, CVO = (D / 64) * (D / 64) / 4;
    auto prep_in = [&](int bz, int off, int G) {
        FOR_VB_OFFG(CI1, off, G) b_convT_stream(bz * CI1 + vb, p.w_in, p.WT_IN, D, 1792, nullptr, IN_COLS, 0, 0, (long)D * IN_COLS, (long)PCW * D);
        FOR_VB_OFFG(CI2, off + CI1, G) b_convT_stream(bz * CI2 + vb, p.w_in, p.WT_IN, D, 768, nullptr, IN_COLS, 1808, 1792, (long)D * IN_COLS, (long)PCW * D);
        FOR_VB_OFFG(16, off + CI1 + CI2, G) b_convT(tt, 0, vb, bz, p.w_in, p.WT_IN, D, IN_COLS, OLD_BDT, 16, PC, (long)D * IN_COLS, (long)PCW * D);
    };
    prep_in(0, 0, 128);
    FOR_VB_OFFG(CVO, 176, 128) b_convT_stream(vb, p.w_out, p.WT_OUT, D, D, p.b_norm_w);
    FOR_VB_OFFG(1 * 16 * DEPTH, 240, 128) b_convT(tt, 0, vb % 16, vb / 16, p.w_grouter, p.WT_R, D, 4, 0, 4, 0, (long)D * 4, (long)128 * D);
    FOR_VB_OFFG(1 * 16 * DEPTH, 304, 128) b_convT(tt, 0, vb % 16, vb / 16, p.w_router, p.WT_R, D, 32, 0, 32, 4, (long)D * 32, (long)128 * D);
    xcd_barrier(xb);
    if (threadIdx.x == 0) {
        const unsigned nl = ((volatile LAS unsigned*)xbw)[0], nxx = ((volatile LAS unsigned*)xbw)[1];
        unsigned ok = (nxx == 8u && gridDim.x == 512u && nl * 8u == gridDim.x && xb_ld(&p.cuslot[2048]) == gridDim.x) ? 1u : 0u;
        for (int j = 0; j < 8; ++j) ok &= (xb_ld(&p.bar[XB_XCNT(j)]) == nl) ? 1u : 0u;
        ((volatile LAS unsigned*)xbw)[6] = ok;
    }
    __syncthreads();
    const bool useloc = __builtin_amdgcn_readfirstlane((int)((volatile LAS unsigned*)xbw)[6]) != 0;
    for (int l = 0; l < DEPTH; ++l) {
        const bool last = (l == DEPTH - 1);
        const int ntok = last ? NLAT : NTOK;
        FOR_VB(NTOK / 16) b_norm1(p, l, vb);
        {
            constexpr int NT = PCW / 128, MPX = (NTOK / 128) / 8, CH = MPX * NT, M0 = (MPX + 1) / 2, M1 = MPX - M0;
            __builtin_amdgcn_s_setprio(2);
            for (int j = (int)blockIdx.x >> 3; j < CH; j += (int)gridDim.x >> 3) {
                int m, n;
                if (j < 6 * NT) { m = j % 6; n = j / 6; } else if (j < 12 * NT) { m = 6 + (j - 6 * NT) % 6; n = (j - 6 * NT) / 6; } else { m = 12 + (j - 12 * NT) % 5; n = (j - 12 * NT) / 5; }
                b_inproj(p, l, (((int)blockIdx.x & 7) * MPX + m) * NT + n, smem);
            }
            __builtin_amdgcn_s_setprio(0);
        }
        xcd_barrier(xb);
        {
            const int nst = NB * NCH * 8, nsc = NB * 8 * 2 * 4096 / 256;
            const int ncu = NB * 4 * (L / 128) + (last ? 0 : NB * 4 * 2);
#pragma unroll 1
            for (int k = 0; k < 64; ++k) {
                int unit;
                if (useloc) {
                    const int xj = (int)blockIdx.x >> 3, xc = (int)blockIdx.x & 7, u = ((xj + 48) & 63) + 64 * k; if (u >= 17 * 8) break;
                    const int cl = u >> 3, bb = cl < 16 ? cl >> 2 : xc >> 1, cc = cl < 16 ? 2 + xc + 8 * (cl & 3) : xc & 1;
                    unit = (bb * NCH + cc) * 8 + (u & 7);
                } else { unit = (int)blockIdx.x + k * (int)gridDim.x; if (unit >= nst) break; }
                b_ssd_states(p, l, unit, smem);
            }
            constexpr int CVL = NEXP * (D / 64) * (DEXP / 64) / 4;
#pragma unroll 1
            for (int step = 0; step < 2; ++step) {
                if ((step ^ slot) == 0) {
                    __builtin_amdgcn_s_setprio(2);
#pragma unroll 1
                    for (int k = 0; k < 64; ++k) {
                        const int xj = (int)blockIdx.x >> 3, xc = (int)blockIdx.x & 7;
                        int unit;
                        if (useloc) {
                            if (k == 0) unit = (xj >> 4) * 128 + ((xj >> 2) & 3) * 32 + xc + 8 * (xj & 3);
                            else if (k == 1 && !last && xj >= 8 && xj < 12) unit = NB * 4 * (L / 128) + (xc >> 1) * 8 + (xj - 8) * 2 + (xc & 1);
                            else break;
                        } else { unit = (int)((blockIdx.x + gridDim.x - (nst % gridDim.x)) % gridDim.x) + k * (int)gridDim.x; if (unit >= ncu) break; }
                        b_attnC(p, l, unit, smem);
                    }
                    __builtin_amdgcn_s_setprio(0);
                } else {
                    for (int vb = l * CVL + (int)blockIdx.x; vb < (l + 1) * CVL; vb += (int)gridDim.x) b_convT_stream(vb, p.w_gate, p.WT_G, D, DEXP);
                    for (int vb = l * CVL + (int)blockIdx.x; vb < (l + 1) * CVL; vb += (int)gridDim.x) b_convT_stream(vb, p.w_up, p.WT_U, D, DEXP);
                    {
                        const int G = (int)gridDim.x, xj = (int)blockIdx.x >> 3, nown = (useloc && !last && xj >= 56) ? 0 : (CVL - (int)blockIdx.x + G - 1) / G, nex = (useloc && !last && xj < 8) ? CVL / 512 : 0;
#pragma unroll 1
                        for (int i = 0; i < nown + nex; ++i) {
                            const int vb = l * CVL + (i < nown ? (int)blockIdx.x + i * G : (int)blockIdx.x + 448 + (i - nown) * 512);
                            b_convT_stream(vb, p.w_down, p.WT_D, DEXP, D);
                        }
                    }
                    if (l + 1 < DEPTH) { FOR_VB_OFF(CVO, 192) b_convT_stream((l + 1) * CVO + vb, p.w_out, p.WT_OUT, D, D, p.b_norm_w); }
                    if (l + 1 < DEPTH) prep_in(l + 1, 192 + CVO, (int)gridDim.x);
                }
                if (step == 0) {
                    const int G = (int)gridDim.x, xj = (int)blockIdx.x >> 3, off = (nst + ncu) % G;
                    const bool give = useloc && !last && xj >= 56, take = useloc && !last && xj < 8;
                    const int v0 = ((int)blockIdx.x + G - off) % G, v1 = ((int)blockIdx.x + 448 + G - off) % G;
                    const int n0 = give ? 0 : (nsc - v0 + G - 1) / G, n1 = take ? (nsc - v1 + G - 1) / G : 0;
#pragma unroll 1
                    for (int i = 0; i < n0 + n1; ++i) { const int vb = i < n0 ? v0 + i * G : v1 + (i - n0) * G; b_ssd_scan(p, l, vb); }
                }
            }
            {
                const int xj = (int)blockIdx.x >> 3, xc = (int)blockIdx.x & 7, G = (int)gridDim.x;
#pragma unroll 1
                for (int k = 0; k < 64; ++k) {
                    int unit;
                    if (useloc) {
                        if (k == 0) unit = (xj >> 4) * 128 + ((xj >> 2) & 3) * 32 + xc + 8 * (xj & 3);
                        else if (k == 1 && !last && xj >= 12 && xj < 16) unit = NB * 4 * (L / 128) + (xc >> 1) * 8 + (xj - 12) * 2 + (xc & 1);
                        else break;
                    } else { unit = (int)((blockIdx.x + G - ((nst + nsc + ncu) % G)) % G) + k * G; if (unit >= ncu) break; }
                    b_attnA(p, l, unit, smem);
                }
#pragma unroll 1
                for (int k = 0; k < 64; ++k) {
                    int unit;
                    if (useloc) {
                        if (k > 2) break;
                        const int u = k < 2 ? xj + 64 * k : 128 + xj - 56; if (u < 128 && k == 2) break;
                        const int cl = u >> 3, bb = cl < 16 ? cl >> 2 : xc >> 1, cc = cl < 16 ? 2 + xc + 8 * (cl & 3) : xc & 1;
                        unit = (bb * NCH + cc) * 8 + (u & 7);
                    } else { unit = (int)((blockIdx.x + G - ((nst + nsc + 2 * ncu) % G)) % G) + k * G; if (unit >= nst) break; }
                    if (last && ((unit >> 3) % NCH) < 2) continue;
                    b_ssd_out(p, l, unit, smem);
                }
            }
        }
        if (useloc) xcd_local_barrier(xb); else xcd_barrier(xb);
        {
            const int ch = (ntok / 128) * (D / 128) / 8, bpx = (int)gridDim.x >> 3, j = (int)blockIdx.x >> 3, xc = (int)blockIdx.x & 7;
            const int rem = ch % bpx, nfull = (rem * 8 <= bpx) ? ch - rem : ch;
            auto mt_of = [&](int mloc) { return !useloc ? xc * (ch >> 3) + mloc : mloc < 16 ? (mloc >> 2) * 32 + xc + 8 * (mloc & 3) : NLAT / 128 + xc; };
            for (int t = j; t < nfull; t += bpx) { b_outproj<4, 4>(p, l, mt_of(t >> 3) * 128, (t & 7) * 128, smem); }
            for (int q = j; q < (ch - nfull) * 8; q += bpx) { const int t = nfull + (q >> 3), sub = q & 7; b_outproj<2, 1>(p, l, mt_of(t >> 3) * 128 + (sub >> 2) * 64, (t & 7) * 128 + (sub & 3) * 32, smem); }
        }
        if (useloc) {
            xcd_local_barrier(xb);
            const int upx = (ntok / 128 / 8) * 8, xc = (int)blockIdx.x & 7;
            for (int u = (int)blockIdx.x >> 3; u < upx; u += (int)gridDim.x >> 3) {
                const int mloc = u >> 3, mt = mloc < 16 ? (mloc >> 2) * 32 + xc + 8 * (mloc & 3) : NLAT / 128 + xc;
                b_norm2r(p, l, mt * 8 + (u & 7), smem);
            }
        } else {
            xcd_barrier(xb);
            FOR_VB(ntok / 16) b_norm2r(p, l, vb, smem);
        }
        xcd_barrier(xb);
        const int mrt = moe_row_tiles(p.cnt + l * NEXP * CPAD), nbig = mrt * 4, mch = ((mrt + 7) >> 3) * 4, bpx = (int)gridDim.x >> 3;
        const int mj = (int)blockIdx.x >> 3, mxc = (int)blockIdx.x & 7;
        const int mlo = mxc * mch, mcnt = max(min(mlo + mch, nbig) - mlo, 0), mrem = mcnt % bpx;
        const int msplit = (mrem == 0) ? 1 : (mrem * 4 <= bpx) ? 4 : (mrem * 2 <= bpx) ? 2 : 1, mfull = msplit > 1 ? mcnt - mrem : mcnt;
        for (int t = mj; t < mfull; t += bpx) { const int bt = mlo + t; b_moe_up<8>(p, l, bt >> 2, (bt & 3) * 128, smem); }
        if (msplit == 4) { for (int q = mj; q < mrem * 4; q += bpx) { const int bt = mlo + mfull + (q >> 2); b_moe_up<2>(p, l, bt >> 2, (bt & 3) * 128 + (q & 3) * 32, smem); } }
        else if (msplit == 2) { for (int q = mj; q < mrem * 2; q += bpx) { const int bt = mlo + mfull + (q >> 1); b_moe_up<4>(p, l, bt >> 2, (bt & 3) * 128 + (q & 1) * 64, smem); } }
        if (useloc) xcd_local_barrier(xb); else xcd_barrier(xb);
        for (int t = mj; t < mfull; t += bpx) { const int bt = mlo + t; b_moe_down<8>(p, l, bt >> 2, (bt & 3) * 256, smem); }
        if (msplit == 4) { for (int q = mj; q < mrem * 4; q += bpx) { const int bt = mlo + mfull + (q >> 2); b_moe_down<2>(p, l, bt >> 2, (bt & 3) * 256 + (q & 3) * 64, smem); } }
        else if (msplit == 2) { for (int q = mj; q < mrem * 2; q += bpx) { const int bt = mlo + mfull + (q >> 1); b_moe_down<4>(p, l, bt >> 2, (bt & 3) * 256 + (q & 1) * 128, smem); } }
        xcd_barrier(xb);
    }
    FOR_VB(NLAT / 4) b_final(p, vb);
}

extern "C" void kernel_launch(void* const* d_in, const int* in_sizes, int n_in, void* d_out, int out_size, void* d_ws, size_t ws_size, hipStream_t stream) {
    P p{};
    const float** f = (const float**)&p;
    for (int i = 0; i < 25; ++i) f[i] = (const float*)d_in[i];
    p.out = (float*)d_out;
    char* w = (char*)d_ws; size_t off = 0;
    auto take = [&](size_t bytes) { char* r = w + off; off += (bytes + 255) & ~(size_t)255; return r; };
    p.X = (float*)take((size_t)NTOK * D * 4);
    p.MOD = (float*)take((size_t)DEPTH * 5 * 6 * D * 4);
    p.DT = (float*)take((size_t)NTOK * 16 * 4);
    p.SSQ = (float*)take((size_t)NTOK * 8 * 4);
    p.SYNC = (unsigned*)take((size_t)(SY_LAYER + DEPTH * SY_STRIDE) * 4);
    p.ST = (float*)take((size_t)NB * NCH * 16 * 4096 * 4);
    p.DEC = (float*)take((size_t)NB * NCH * 16 * 4);
    p.HS = (bf16_t*)take((size_t)NB * NCH * 16 * 4096 * 2);
    p.gatew = (float*)take((size_t)NTOK * 2 * 4);
    p.H = (bf16_t*)take((size_t)NTOK * D * 2);
    p.PROJ = (bf16_t*)take((size_t)NTOK * PC * 2);
    p.WT_IN = (bf16_t*)take((size_t)DEPTH * PCW * D * 2);
    p.WT_R = (bf16_t*)take((size_t)DEPTH * 128 * D * 2);
    p.WT_OUT = (bf16_t*)take((size_t)DEPTH * D * D * 2);
    p.WT_G = (bf16_t*)take((size_t)DEPTH * NEXP * DEXP * D * 2);
    p.WT_U = (bf16_t*)take((size_t)DEPTH * NEXP * DEXP * D * 2);
    p.WT_D = (bf16_t*)take((size_t)DEPTH * NEXP * DEXP * D * 2);
    p.MIXO = (bf16_t*)take((size_t)NTOK * D * 2);
    p.HID = (bf16_t*)take((size_t)(NTOK * 2 + 128) * DEXP * 2);
    p.YS = (bf16_t*)take((size_t)(NTOK * 2 + 128) * D * 2);
    p.cnt = (int*)take((size_t)DEPTH * NEXP * CPAD * 4);
    p.list = (int*)take((size_t)NEXP * NTOK * 4);
    p.pos = (int*)take((size_t)NTOK * 2 * 4);
    p.VT = (bf16_t*)take((size_t)NB * 4 * 64 * NKEY * 2);
    p.VTA = (bf16_t*)take((size_t)NB * 2 * 64 * NKEY * 2);
    p.bar = (unsigned*)take((size_t)(XCD_BAR_WORDS + 4096) * 4); p.cuslot = p.bar + XCD_BAR_WORDS;
    p.ROPE = (float*)take((size_t)64 * 24 * 2 * 4);
    p.KMAX = (unsigned*)take((size_t)DEPTH * NB * 10 * 32 * 4);
    if (off > ws_size) { fprintf(stderr, "workspace too small: need %zu have %zu\n", off, ws_size); return; }

    (void)hipMemsetAsync(p.bar, 0, (XCD_BAR_WORDS + 4096) * 4, stream);
    static int grid_blocks = 0;
    if (!grid_blocks) {
        int dev = 0, cus = 0, per_cu = 0;
        (void)hipGetDevice(&dev);
        (void)hipDeviceGetAttribute(&cus, hipDeviceAttributeMultiprocessorCount, dev);
        if (hipFuncSetAttribute((const void*)k_mega, hipFuncAttributeMaxDynamicSharedMemorySize, LDS_BYTES) != hipSuccess) fprintf(stderr, "hipFuncSetAttribute(LDS %d) failed\n", LDS_BYTES);
        (void)hipOccupancyMaxActiveBlocksPerMultiprocessor(&per_cu, k_mega, 256, LDS_BYTES);
        if (per_cu > 2) per_cu = 2;
        grid_blocks = cus * per_cu;
    }
    void* args[] = {&p};
    hipError_t e = hipLaunchCooperativeKernel((void*)k_mega, dim3(grid_blocks), dim3(256), args, LDS_BYTES, stream);
    if (e != hipSuccess) fprintf(stderr, "cooperative launch failed: %s (grid %d)\n", hipGetErrorString(e), grid_blocks);
}
```
